# Optimizing an MI355X kernel written in HIP

```python
import math
import jax, jax.numpy as jnp
from jax import lax
import numpy as np

D_MODEL = 1024
BATCH = 2
SEQ = 8192
DEPTH = 2
DEC_BATCH = 32
DEC_SEQ = 4
PAST_LEN = 16384
PAGE_SIZE = 128

N_MIXERS = 4
MIX_W = D_MODEL // N_MIXERS
N_HEADS_MIX = 4
HEAD_DIM = MIX_W // N_HEADS_MIX
DILATIONS = ((128, 1), (512, 4), (2048, 16))
MAX_WINDOW = max(w for w, _ in DILATIONS)
ATTN_BLOCK = 128
N_BUCKETS = 32
MAX_DISTANCE = MAX_WINDOW
MLSTM_CHUNK = 128
HGRN_CHUNK = 16
MLP_CHUNK = 128
D_FF = 4 * D_MODEL
EPS = 1e-6
NEG = -1e30
LB_FLOOR = 1e-30

SPLIT_SIZES = (MIX_W, MIX_W, MIX_W,
               MIX_W, MIX_W, MIX_W, MIX_W, N_HEADS_MIX, N_HEADS_MIX,
               MIX_W, MIX_W,
               MIX_W, MIX_W, MIX_W, MIX_W)
D_IN = sum(SPLIT_SIZES)
SPLIT_POINTS = tuple(int(c) for c in np.cumsum(SPLIT_SIZES)[:-1])

kernel_name = 'hybrid_dilated_mlstm_gmlp_hgrn2_step'


def rmsnorm(x, g):
    xf = x.astype(jnp.float32)
    y = xf * lax.rsqrt(jnp.mean(xf * xf, axis=-1, keepdims=True) + EPS)
    return (y * g.astype(jnp.float32)).astype(x.dtype)


def headnorm(h, g):
    return rmsnorm(h, g.reshape(N_HEADS_MIX, HEAD_DIM))


def rel_bucket(dist):
    max_exact = N_BUCKETS // 2
    d = jnp.maximum(dist, 1).astype(jnp.float32)
    large = max_exact + (jnp.log(d / max_exact) / math.log(MAX_DISTANCE / max_exact)
                         * (N_BUCKETS - max_exact)).astype(jnp.int32)
    large = jnp.clip(large, max_exact, N_BUCKETS - 1)
    return jnp.where(dist < max_exact, dist, large)


def _to_chunks(a, L):
    B, T, H = a.shape[:3]
    a = a.astype(jnp.float32).reshape((B, T // L, L, H) + a.shape[3:])
    return jnp.moveaxis(a, (1, 3), (0, 2))


def _from_chunks(a):
    nc, B, H, L = a.shape[:4]
    a = jnp.moveaxis(a, (0, 2), (1, 3))
    return a.reshape((B, nc * L, H) + a.shape[4:])


def dilated_window_attention(q, k, v, k_past, v_past, rel_bias):
    B, T, H, dh = q.shape
    P = k_past.shape[1]
    pad = MAX_WINDOW - P
    f32 = jnp.float32
    zeros = jnp.zeros((B, pad, H, dh), f32)
    kp = jnp.concatenate([zeros, k_past.astype(f32), k.astype(f32)], axis=1)
    vp = jnp.concatenate([zeros, v_past.astype(f32), v.astype(f32)], axis=1)
    qf = q.astype(f32) * (HEAD_DIM ** -0.5)
    qb = ATTN_BLOCK if T % ATTN_BLOCK == 0 else T
    nb = T // qb
    patterns = []
    for w, d in DILATIONS:
        offs = jnp.arange(w // d + 1, dtype=jnp.int32) * d
        bias = rel_bias[rel_bucket(offs)].T.astype(f32)
        patterns.append((offs, bias))

    def block(s):
        qblk = lax.dynamic_slice_in_dim(qf, s, qb, axis=1)
        qpos = MAX_WINDOW + s + jnp.arange(qb, dtype=jnp.int32)
        lses, outs = [], []
        for offs, bias in patterns:
            idx = qpos[:, None] - offs[None, :]
            kg = jnp.take(kp, idx, axis=1, mode='clip')
            vg = jnp.take(vp, idx, axis=1, mode='clip')
            logits = jnp.einsum('bqhd,bqjhd->bhqj', qblk, kg) + bias[None, :, None, :]
            logits = jnp.where((idx >= pad)[None, None], logits, NEG)
            m = jnp.max(logits, axis=-1, keepdims=True)
            p = jnp.exp(logits - m)
            den = jnp.sum(p, axis=-1)
            o = jnp.einsum('bhqj,bqjhd->bqhd', p, vg) / jnp.transpose(den, (0, 2, 1))[..., None]
            lses.append(jnp.transpose(m[..., 0] + jnp.log(den), (0, 2, 1)))
            outs.append(o)
        wts = jax.nn.softmax(jnp.stack(lses, 0), axis=0)
        return jnp.einsum('pbqh,pbqhd->bqhd', wts, jnp.stack(outs, 0))

    out = lax.map(block, jnp.arange(nb, dtype=jnp.int32) * qb)
    return jnp.moveaxis(out, 0, 1).reshape(B, T, H, dh)


def mlstm_chunkwise(q, k, v, i_pre, log_f, C0, n0, m0):
    B, T, H, dh = q.shape
    L = MLSTM_CHUNK if T % MLSTM_CHUNK == 0 else T
    qc, kc, vc = _to_chunks(q, L), _to_chunks(k, L) * (dh ** -0.5), _to_chunks(v, L)
    ic, fc = _to_chunks(i_pre, L), _to_chunks(log_f, L)
    causal = jnp.tril(jnp.ones((L, L), bool))

    def step(carry, xs):
        C, n, m = carry
        qt, kt, vt, it, ft = xs
        b = jnp.cumsum(ft, axis=-1)
        D = jnp.where(causal, b[..., :, None] - b[..., None, :] + it[..., None, :], NEG)
        g = b + m[..., None]
        m_t = jnp.maximum(g, jnp.max(D, axis=-1))
        Dexp = jnp.exp(D - m_t[..., None])
        gexp = jnp.exp(g - m_t)
        S = jnp.einsum('bhtd,bhsd->bhts', qt, kt) * Dexp
        num = jnp.einsum('bhts,bhsd->bhtd', S, vt) + gexp[..., None] * jnp.einsum('bhvk,bhtk->bhtv', C, qt)
        nq = jnp.sum(S, axis=-1) + gexp * jnp.einsum('bhk,bhtk->bht', n, qt)
        h = num / jnp.maximum(jnp.abs(nq), jnp.exp(-m_t))[..., None]
        m_new = m_t[..., -1]
        wk = jnp.exp(b[..., -1:] - b + it - m_new[..., None])
        dc = jnp.exp(b[..., -1] + m - m_new)
        C_new = dc[..., None, None] * C + jnp.einsum('bhs,bhsv,bhsk->bhvk', wk, vt, kt)
        n_new = dc[..., None] * n + jnp.einsum('bhs,bhsk->bhk', wk, kt)
        return (C_new, n_new, m_new), h

    f32 = jnp.float32
    (C, n, m), h = lax.scan(step, (C0.astype(f32), n0.astype(f32), m0.astype(f32)), (qc, kc, vc, ic, fc))
    return _from_chunks(h), C, n, m


def hgrn2_chunkwise(q, log_f, k, v, S0):
    B, T, H, dk = q.shape
    L = HGRN_CHUNK if T % HGRN_CHUNK == 0 else T
    qc, fc, kc, vc = _to_chunks(q, L), _to_chunks(log_f, L), _to_chunks(k, L), _to_chunks(v, L)
    causal = jnp.tril(jnp.ones((L, L), bool))

    def step(S, xs):
        qt, ft, kt, vt = xs
        b = jnp.cumsum(ft, axis=2)
        diff = jnp.where(causal[..., None], b[:, :, :, None, :] - b[:, :, None, :, :], NEG)
        A = jnp.einsum('bhtd,bhsd,bhtsd->bhts', qt, kt, jnp.exp(diff))
        o = jnp.einsum('bhts,bhsv->bhtv', A, vt) + jnp.einsum('bhtd,bhdv->bhtv', qt * jnp.exp(b), S)
        bL = b[:, :, -1:, :]
        S_new = jnp.exp(bL[:, :, 0, :])[..., None] * S + jnp.einsum('bhsd,bhsv->bhdv', kt * jnp.exp(bL - b), vt)
        return S_new, o

    S, o = lax.scan(step, S0.astype(jnp.float32), (qc, fc, kc, vc))
    return _from_chunks(o), S


def chunk_spatial_gate(u, v, w_s, b_s):
    B, T, H, c = v.shape
    nc = -(-T // MLP_CHUNK)
    Tp = nc * MLP_CHUNK
    vp = jnp.pad(v, ((0, 0), (0, Tp - T), (0, 0), (0, 0))).reshape(B, nc, MLP_CHUNK, H, c)
    w = jnp.where(jnp.tril(jnp.ones((MLP_CHUNK, MLP_CHUNK), bool)), w_s, 0)
    s = jnp.einsum('hts,bnshc->bnthc', w, vp) + b_s.T[None, None, :, :, None]
    return u * s.reshape(B, Tp, H, c)[:, :T]


def layer(x, k_past, v_past, C0, n0, m0, S0, keep,
          w_in, w_out, g_attn, g_mlp, w_up, w_down, b_i, b_f, g_mlstm, g_cv, w_s, b_s, lb, g_hgrn, rel_bias):
    B, T, _ = x.shape
    H, dh = N_HEADS_MIX, HEAD_DIM
    f32 = jnp.float32
    z = rmsnorm(x, g_attn) @ w_in
    aq, ak, av, bq, bk, bv, bo, bi, bf, cu, cv, dq, df, di, dg = jnp.split(z, SPLIT_POINTS, axis=-1)
    heads = lambda a: a.reshape(B, T, H, dh)
    ka, va = heads(ak), heads(av)
    out_a = dilated_window_attention(heads(aq), ka, va, k_past, v_past, rel_bias).reshape(B, T, MIX_W)
    k_keep = jnp.concatenate([k_past.astype(ka.dtype), ka], axis=1)[:, -keep:]
    v_keep = jnp.concatenate([v_past.astype(va.dtype), va], axis=1)[:, -keep:]
    i_pre = bi.astype(f32) + b_i.astype(f32)
    log_fb = jax.nn.log_sigmoid(bf.astype(f32) + b_f.astype(f32))
    hb, C1, n1, m1 = mlstm_chunkwise(heads(bq), heads(bk), heads(bv), i_pre, log_fb, C0, n0, m0)
    out_b = jax.nn.sigmoid(bo.astype(f32)) * headnorm(hb, g_mlstm).reshape(B, T, MIX_W)
    v_rows = heads(rmsnorm(jax.nn.gelu(cv), g_cv))
    out_c = chunk_spatial_gate(heads(jax.nn.gelu(cu)), v_rows, w_s, b_s).reshape(B, T, MIX_W)
    lbf = lb.astype(f32)
    dff = df.astype(f32)
    log_fd = jnp.logaddexp(jnp.log(jnp.maximum(lbf, LB_FLOOR)), jnp.log1p(-lbf) + jax.nn.log_sigmoid(dff))
    kd = (1.0 - lbf) * jax.nn.sigmoid(-dff)
    hd, S1 = hgrn2_chunkwise(heads(dq), heads(log_fd), heads(kd), heads(di), S0)
    out_d = headnorm(hd, g_hgrn).reshape(B, T, MIX_W) * jax.nn.silu(dg.astype(f32))
    mix = jnp.concatenate([out_a.astype(x.dtype), out_b.astype(x.dtype),
                           out_c.astype(x.dtype), out_d.astype(x.dtype)], axis=-1)
    x = x + mix @ w_out
    hm = rmsnorm(x, g_mlp) @ w_up
    x = x + jnp.square(jax.nn.relu(hm)) @ w_down
    return x, k_keep, v_keep, C1, n1, m1, S1, v_rows


def setup_inputs(seed: int = 0) -> dict:
    key = jax.random.key(seed)
    ks = jax.random.split(key, 24)
    H, dh = N_HEADS_MIX, HEAD_DIM
    wb = min(MAX_WINDOW, PAST_LEN)
    nrm = lambda k, shape, s: jax.random.normal(k, shape, jnp.float32) * s
    b_f = jnp.broadcast_to(jnp.linspace(3.0, 6.0, H, dtype=jnp.float32), (DEPTH, H)) + nrm(ks[14], (DEPTH, H), 0.1)
    return {
        'x_prompt': nrm(ks[0], (BATCH, SEQ, D_MODEL), 1.0),
        'x_sample': nrm(ks[1], (DEC_BATCH, DEC_SEQ, D_MODEL), 1.0),
        'cache_k_win': nrm(ks[2], (DEPTH, DEC_BATCH, wb, H, dh), 1.0),
        'cache_v_win': nrm(ks[3], (DEPTH, DEC_BATCH, wb, H, dh), 1.0),
        'state_mlstm_C': nrm(ks[4], (DEPTH, DEC_BATCH, H, dh, dh), 0.1),
        'state_mlstm_n': nrm(ks[5], (DEPTH, DEC_BATCH, H, dh), 0.1),
        'state_mlstm_m': nrm(ks[6], (DEPTH, DEC_BATCH, H), 1.0),
        'state_hgrn_S': nrm(ks[7], (DEPTH, DEC_BATCH, H, dh, dh), 0.5),
        'rel_bias': nrm(ks[8], (N_BUCKETS, H), 0.5),
        'w_in': nrm(ks[9], (DEPTH, D_MODEL, D_IN), D_MODEL ** -0.5),
        'w_out': nrm(ks[10], (DEPTH, D_MODEL, D_MODEL), D_MODEL ** -0.5),
        'g_attn': 1.0 + nrm(ks[11], (DEPTH, D_MODEL), 0.01),
        'g_mlp': 1.0 + nrm(ks[12], (DEPTH, D_MODEL), 0.01),
        'w_up': nrm(ks[13], (DEPTH, D_MODEL, D_FF), D_MODEL ** -0.5),
        'w_down': nrm(ks[15], (DEPTH, D_FF, D_MODEL), D_FF ** -0.5),
        'b_i': nrm(ks[16], (DEPTH, H), 0.1),
        'b_f': b_f,
        'g_mlstm': 1.0 + nrm(ks[17], (DEPTH, MIX_W), 0.01),
        'g_cv': 1.0 + nrm(ks[18], (DEPTH, MIX_W), 0.01),
        'w_s': nrm(ks[19], (DEPTH, H, MLP_CHUNK, MLP_CHUNK), MLP_CHUNK ** -0.5),
        'b_s': 1.0 + nrm(ks[20], (DEPTH, H, MLP_CHUNK), 0.01),
        'hgrn_lb': nrm(ks[21], (DEPTH, MIX_W), 0.5),
        'g_hgrn': 1.0 + nrm(ks[22], (DEPTH, MIX_W), 0.01),
        'g_final': 1.0 + nrm(ks[23], (D_MODEL,), 0.01),
    }


def reference(x_prompt, x_sample, cache_k_win, cache_v_win, state_mlstm_C, state_mlstm_n, state_mlstm_m,
              state_hgrn_S, rel_bias, w_in, w_out, g_attn, g_mlp, w_up, w_down, b_i, b_f, g_mlstm, g_cv,
              w_s, b_s, hgrn_lb, g_hgrn, g_final):
    f32 = jnp.float32
    H, dh = N_HEADS_MIX, HEAD_DIM
    B, T = x_prompt.shape[:2]
    keep_prompt = min(MAX_WINDOW, T)
    keep_sample = cache_k_win.shape[2]
    sm = jax.nn.softmax(hgrn_lb.astype(f32), axis=0)
    lb_all = jnp.cumsum(sm, axis=0) - sm[0:1]
    empty = jnp.zeros((B, 0, H, dh), x_prompt.dtype)
    zC = jnp.zeros((B, H, dh, dh), f32)
    zn = jnp.zeros((B, H, dh), f32)
    zm = jnp.zeros((B, H), f32)
    xp, xs = x_prompt, x_sample
    kwp, vwp, kws, vws = [], [], [], []
    Cp, np_, mp, Cs, ns, ms = [], [], [], [], [], []
    Sp, Ss, cvs = [], [], []
    for l in range(DEPTH):
        wl = (w_in[l], w_out[l], g_attn[l], g_mlp[l], w_up[l], w_down[l], b_i[l], b_f[l],
              g_mlstm[l], g_cv[l], w_s[l], b_s[l], lb_all[l], g_hgrn[l], rel_bias)
        xp, k1, v1, C1, n1, m1, S1, _ = layer(xp, empty, empty, zC, zn, zm, zC, keep_prompt, *wl)
        kwp.append(k1); vwp.append(v1); Cp.append(C1); np_.append(n1); mp.append(m1); Sp.append(S1)
        xs, k2, v2, C2, n2, m2, S2, cv2 = layer(xs, cache_k_win[l], cache_v_win[l], state_mlstm_C[l],
                                                state_mlstm_n[l], state_mlstm_m[l], state_hgrn_S[l],
                                                keep_sample, *wl)
        kws.append(k2); vws.append(v2); Cs.append(C2); ns.append(n2); ms.append(m2); Ss.append(S2); cvs.append(cv2)
    y_prompt = rmsnorm(xp, g_final)
    y_sample = rmsnorm(xs, g_final)
    return (y_prompt, y_sample,
            jnp.stack(kwp), jnp.stack(vwp), jnp.stack(kws), jnp.stack(vws),
            jnp.stack(Cp), jnp.stack(np_), jnp.stack(mp),
            jnp.stack(Cs), jnp.stack(ns), jnp.stack(ms),
            jnp.stack(Sp), jnp.stack(Ss), jnp.stack(cvs))
```

```cpp
#include <hip/hip_runtime.h>
#include <hip/hip_cooperative_groups.h>
#include <cstdio>
#include <cstdint>
namespace cg = cooperative_groups;

namespace pg8 {
#define PG8_LAS __attribute__((address_space(3)))
typedef unsigned short bf16_t;
typedef short bf16x8 __attribute__((ext_vector_type(8)));
typedef float f32x4 __attribute__((ext_vector_type(4)));
typedef unsigned u32x4 __attribute__((ext_vector_type(4)));
constexpr int BM = 256, BK = 64, HALF = 128, HTB = HALF * BK * 2  , STAGE_BYTES = 8 * HTB, NXCD = 8, WGM = 8;

__host__ __device__ __forceinline__ int lds_byte(int r, int c) { const int st = (r >> 4) * 2 + (c >> 5), rr = r & 15, cc = c & 31, ob = rr * 64 + cc * 2; return st * 1024 + (ob ^ (((ob >> 9) & 1) << 5)); }
__host__ __device__ __forceinline__ void stage_rc(int b, int& R, int& C) { const int st = b / 1024, sb = b % 1024, swz = sb ^ (((sb >> 9) & 1) << 5); R = (st >> 1) * 16 + swz / 64; C = (st & 1) * 32 + (swz % 64) / 2; }
__host__ __device__ __forceinline__ int perm32(int rho) { const int n = rho >> 4, i = rho & 15; return 8 * (i >> 2) + 4 * n + (i & 3); }

struct Unit { int pm, pn; };
struct Gemm { const bf16_t* A; const bf16_t* Bt; int M, N, K; };

struct StaticOrder {
    int nM, nN, nwg, G, c;
    __host__ __device__ void init(int M, int N, int G_, int c_) { nM = M / BM; nN = N / BM; nwg = nM * nN; G = G_; c = c_; }
    __host__ __device__ bool next(int i, Unit& u) const {
        const long L = (long)i * G + c; if (L >= nwg) return false;
        int wgid = (int)L; { const int q = nwg / NXCD, r = nwg % NXCD, xcd = wgid % NXCD, off = wgid / NXCD; wgid = (xcd < r ? xcd * (q + 1) : r * (q + 1) + (xcd - r) * q) + off; }
        const int nig = WGM * nN, gid = wgid / nig, fm = gid * WGM, gsz = (nM - fm) < WGM ? (nM - fm) : WGM;
        u.pm = fm + ((wgid % nig) % gsz); u.pn = (wgid % nig) / gsz; return true;
    }
    __device__ __forceinline__ void a_ready(const Unit&) const {}
    __device__ __forceinline__ void done(const Unit&) const {}
};

template <class Epi, class Sched>
__device__ __forceinline__ void gemm_prestage(PG8_LAS unsigned char* lds, const Gemm g, const Sched& S, int tid_in) {
    int tid_ = tid_in; asm volatile("" : "+v"(tid_));
    const int tid = tid_, wid = __builtin_amdgcn_readfirstlane(tid >> 6);
    const int K = g.K;
    unsigned voffA[2], voffB[2];
#pragma unroll
    for (int i = 0; i < 2; ++i) { int R, C; stage_rc(tid * 16 + i * 8192, R, C); const int Rb = Epi::WIDE ? ((R >> 5) * 64 + perm32(R & 31)) : (Epi::PERM ? ((R & ~31) + perm32(R & 31)) : R);
        voffA[i] = (unsigned)(R * K + C) * 2u; voffB[i] = (unsigned)(Rb * K + C) * 2u; }
    const size_t hstep = (size_t)HALF * K * 2; const size_t hstepB = Epi::WIDE ? (size_t)32 * K * 2 : hstep; const size_t tstep = 2 * hstep;
    const unsigned ldsw = (unsigned)wid * 1024u;
    Unit cur; if (!S.next(0, cur)) return;
    const char* cA = (const char*)g.A + (size_t)cur.pm * tstep; const char* cB = (const char*)g.Bt + (size_t)cur.pn * tstep;
#define PG8_SA(b, h) (((b) * 2 + (h)) * HTB)
#define PG8_SB(b, h) ((4 + (b) * 2 + (h)) * HTB)
#define PG8_STAGE(bufoff, gbase, voff) do { _Pragma("unroll") for (int _i = 0; _i < 2; ++_i) \
        __builtin_amdgcn_global_load_lds((const unsigned*)((const char*)(gbase) + (voff)[_i]), (PG8_LAS unsigned*)(lds + (bufoff) + ldsw + _i * 8192), 16, 0, 0); } while (0)
    PG8_STAGE(PG8_SB(0, 0), cB, voffB); PG8_STAGE(PG8_SB(0, 1), cB + hstepB, voffB); PG8_STAGE(PG8_SA(0, 0), cA, voffA); PG8_STAGE(PG8_SA(0, 1), cA + hstep, voffA);
#undef PG8_SA
#undef PG8_SB
#undef PG8_STAGE
}
template <class Epi, class Sched, bool ALIGN_EPI = false, bool SP2 = false, bool PRE = false>
__device__ __forceinline__ void gemm_phase(PG8_LAS unsigned char* lds, const Gemm g, const Sched& S, const Epi& E, int tid_in) {
    int tid_ = tid_in; asm volatile("" : "+v"(tid_));
    const int tid = tid_, wid = __builtin_amdgcn_readfirstlane(tid >> 6), lane = tid & 63, wr = wid >> 2, wc = wid & 3, fr = lane & 15, fq = lane >> 4;
    const int K = g.K, nt = K / BK;
    unsigned voffA[2], voffB[2];
#pragma unroll
    for (int i = 0; i < 2; ++i) { int R, C; stage_rc(tid * 16 + i * 8192, R, C); const int Rb = Epi::WIDE ? ((R >> 5) * 64 + perm32(R & 31)) : (Epi::PERM ? ((R & ~31) + perm32(R & 31)) : R);
        voffA[i] = (unsigned)(R * K + C) * 2u; voffB[i] = (unsigned)(Rb * K + C) * 2u; }
    const size_t kstep = (size_t)(BK * 2);
    const size_t hstep = (size_t)HALF * K * 2;
    const size_t hstepB = Epi::WIDE ? (size_t)32 * K * 2 : hstep;
    const size_t tstep = 2 * hstep;
    const unsigned ldsw = (unsigned)wid * 1024u;
    const int aoff = lds_byte(wr * 64 + fr, fq * 8), boff = lds_byte(wc * 32 + fr, fq * 8);
#define PG8_SA(b, h) (((b) * 2 + (h)) * HTB)
#define PG8_SB(b, h) ((4 + (b) * 2 + (h)) * HTB)
#define PG8_STAGE(bufoff, gbase, voff) do { _Pragma("unroll") for (int _i = 0; _i < 2; ++_i) \
        __builtin_amdgcn_global_load_lds((const unsigned*)((const char*)(gbase) + (voff)[_i]), (PG8_LAS unsigned*)(lds + (bufoff) + ldsw + _i * 8192), 16, 0, 0); } while (0)
#define PG8_LDA(dst, b, h) do { _Pragma("unroll") for (int m = 0; m < 4; ++m) _Pragma("unroll") for (int k = 0; k < 2; ++k) dst[m][k] = *(const PG8_LAS bf16x8*)(lds + PG8_SA(b, h) + aoff + m * 2048 + k * 1024); } while (0)
#define PG8_LDB(dst, b, h) do { _Pragma("unroll") for (int n = 0; n < 2; ++n) _Pragma("unroll") for (int k = 0; k < 2; ++k) dst[n][k] = *(const PG8_LAS bf16x8*)(lds + PG8_SB(b, h) + boff + n * 2048 + k * 1024); } while (0)
#define PG8_MMA(ai, bj, At, Bt) do { __builtin_amdgcn_s_setprio(1); _Pragma("unroll") for (int m = 0; m < 4; ++m) _Pragma("unroll") for (int n = 0; n < 2; ++n) _Pragma("unroll") for (int k = 0; k < 2; ++k) \
        acc[ai][bj][m][n] = __builtin_amdgcn_mfma_f32_16x16x32_bf16(Bt[n][k], At[m][k], acc[ai][bj][m][n], 0, 0, 0); __builtin_amdgcn_s_setprio(0); } while (0)
#define PG8_WAIT_V(n) asm volatile("s_waitcnt vmcnt(" #n ")" ::: "memory")
#define PG8_WAIT_L(n) asm volatile("s_waitcnt lgkmcnt(" #n ")" ::: "memory")
#define PG8_BAR __builtin_amdgcn_s_barrier()
#define PG8_SCHED __builtin_amdgcn_sched_barrier(0)
    Unit cur, nxt; int ui = 0;
    if (!S.next(0, cur)) return;
    f32x4 acc[2][2][4][2];
#pragma unroll
    for (int a = 0; a < 2; ++a)
#pragma unroll
        for (int b = 0; b < 2; ++b)
#pragma unroll
            for (int m = 0; m < 4; ++m)
#pragma unroll
                for (int n = 0; n < 2; ++n) acc[a][b][m][n] = (f32x4){0.f, 0.f, 0.f, 0.f};
    bf16x8 At[4][2], B0[2][2], B1[2][2];
    const char* cA = (const char*)g.A + (size_t)cur.pm * tstep; const char* cB = (const char*)g.Bt + (size_t)cur.pn * tstep;
    S.a_ready(cur);
    if constexpr (SP2) {
        if constexpr (!PRE) { PG8_STAGE(PG8_SB(0, 0), cB, voffB); PG8_STAGE(PG8_SB(0, 1), cB + hstepB, voffB); PG8_STAGE(PG8_SA(0, 0), cA, voffA); PG8_STAGE(PG8_SA(0, 1), cA + hstep, voffA); }
        if (wr == 1) PG8_BAR;
        PG8_WAIT_V(2); PG8_BAR;
        PG8_STAGE(PG8_SB(1, 0), cB + kstep, voffB); PG8_STAGE(PG8_SA(1, 0), cA + kstep, voffA); PG8_STAGE(PG8_SB(1, 1), cB + hstepB + kstep, voffB);
        PG8_WAIT_V(6); PG8_BAR;
    } else {
        PG8_STAGE(PG8_SB(0, 0), cB, voffB); PG8_STAGE(PG8_SA(0, 0), cA, voffA); PG8_STAGE(PG8_SB(0, 1), cB + hstepB, voffB); PG8_STAGE(PG8_SA(0, 1), cA + hstep, voffA);
        if (wr == 1) PG8_BAR;
        PG8_WAIT_V(4); PG8_BAR;
        PG8_STAGE(PG8_SB(1, 0), cB + kstep, voffB); PG8_STAGE(PG8_SA(1, 0), cA + kstep, voffA); PG8_STAGE(PG8_SB(1, 1), cB + hstepB + kstep, voffB);
        PG8_WAIT_V(6); PG8_BAR;
    }
    for (;;) {
        const bool has_next = S.next(ui + 1, nxt);
        const char* nA = has_next ? (const char*)g.A + (size_t)nxt.pm * tstep : cA; const char* nB = has_next ? (const char*)g.Bt + (size_t)nxt.pn * tstep : cB;
        for (int t = 0; t < nt; t += 2) {
            const bool last = (t == nt - 2);
            const char* a1 = cA + (size_t)(t + 1) * kstep;
            const char* a2 = last ? nA : cA + (size_t)(t + 2) * kstep; const char* b2 = last ? nB : cB + (size_t)(t + 2) * kstep;
            const char* a3 = a2 + kstep; const char* b3 = b2 + kstep;
            if (last && has_next) S.a_ready(nxt);
            if constexpr (SP2) {
            PG8_LDB(B0, 0, 0); PG8_LDB(B1, 0, 1); PG8_SCHED; PG8_LDA(At, 0, 0); PG8_STAGE(PG8_SA(1, 1), a1 + hstep, voffA);
            PG8_WAIT_V(8); PG8_WAIT_L(0); PG8_BAR; PG8_MMA(0, 0, At, B0); PG8_MMA(0, 1, At, B1); PG8_BAR; PG8_SCHED;
            PG8_LDA(At, 0, 1); PG8_STAGE(PG8_SB(0, 0), b2, voffB); PG8_STAGE(PG8_SB(0, 1), b2 + hstepB, voffB); PG8_STAGE(PG8_SA(0, 0), a2, voffA);
            PG8_WAIT_V(8); PG8_WAIT_L(0); PG8_BAR; PG8_MMA(1, 0, At, B0); PG8_MMA(1, 1, At, B1); PG8_BAR; PG8_SCHED;
            PG8_LDB(B0, 1, 0); PG8_LDB(B1, 1, 1); PG8_SCHED; PG8_LDA(At, 1, 0); PG8_STAGE(PG8_SA(0, 1), a2 + hstep, voffA);
            PG8_WAIT_V(8); PG8_WAIT_L(0); PG8_BAR; PG8_MMA(0, 0, At, B0); PG8_MMA(0, 1, At, B1); PG8_BAR; PG8_SCHED;
            PG8_LDA(At, 1, 1); PG8_STAGE(PG8_SB(1, 0), b3, voffB); PG8_STAGE(PG8_SB(1, 1), b3 + hstepB, voffB); PG8_STAGE(PG8_SA(1, 0), a3, voffA);
            PG8_WAIT_V(8); PG8_WAIT_L(0); PG8_BAR; PG8_MMA(1, 0, At, B0); PG8_MMA(1, 1, At, B1); PG8_BAR; PG8_SCHED;
            } else {
            PG8_LDB(B0, 0, 0); PG8_SCHED; PG8_LDA(At, 0, 0); PG8_STAGE(PG8_SA(1, 1), a1 + hstep, voffA);
            PG8_WAIT_L(8); PG8_BAR; PG8_WAIT_L(0); PG8_MMA(0, 0, At, B0); PG8_BAR; PG8_SCHED;
            PG8_LDB(B1, 0, 1); PG8_STAGE(PG8_SB(0, 0), b2, voffB);
            PG8_BAR; PG8_WAIT_L(0); PG8_MMA(0, 1, At, B1); PG8_BAR;
            PG8_LDA(At, 0, 1); PG8_STAGE(PG8_SA(0, 0), a2, voffA);
            PG8_BAR; PG8_WAIT_L(0); PG8_MMA(1, 0, At, B0); PG8_BAR; PG8_SCHED;
            PG8_STAGE(PG8_SB(0, 1), b2 + hstepB, voffB);
            PG8_WAIT_V(6); PG8_BAR; PG8_MMA(1, 1, At, B1); PG8_BAR;
            PG8_LDB(B0, 1, 0); PG8_SCHED; PG8_LDA(At, 1, 0); PG8_STAGE(PG8_SA(0, 1), a2 + hstep, voffA);
            PG8_WAIT_L(8); PG8_BAR; PG8_WAIT_L(0); PG8_MMA(0, 0, At, B0); PG8_BAR; PG8_SCHED;
            PG8_LDB(B1, 1, 1); PG8_STAGE(PG8_SB(1, 0), b3, voffB);
            PG8_BAR; PG8_WAIT_L(0); PG8_MMA(0, 1, At, B1); PG8_BAR;
            PG8_LDA(At, 1, 1); PG8_STAGE(PG8_SA(1, 0), a3, voffA);
            PG8_BAR; PG8_WAIT_L(0); PG8_MMA(1, 0, At, B0); PG8_BAR; PG8_SCHED;
            PG8_STAGE(PG8_SB(1, 1), b3 + hstepB, voffB);
            PG8_WAIT_V(6); PG8_BAR; PG8_MMA(1, 1, At, B1); PG8_BAR;
            }
        }
        if constexpr (ALIGN_EPI) { if (wr == 0) PG8_BAR; }
        if constexpr (!Epi::AFTER_DRAIN) { E(acc, cur, wr, wc, fr, fq); S.done(cur); }
        if (!has_next) break;
#pragma unroll
        for (int a = 0; a < 2; ++a)
#pragma unroll
            for (int b = 0; b < 2; ++b)
#pragma unroll
                for (int m = 0; m < 4; ++m)
#pragma unroll
                    for (int n = 0; n < 2; ++n) acc[a][b][m][n] = (f32x4){0.f, 0.f, 0.f, 0.f};
        cur = nxt; cA = nA; cB = nB; ++ui;
        if constexpr (ALIGN_EPI) { if (wr == 1) PG8_BAR; }
    }
    PG8_WAIT_V(0);
    if constexpr (!ALIGN_EPI) { if (wr == 0) PG8_BAR; }
    PG8_BAR;
    if constexpr (Epi::AFTER_DRAIN) { E.fused(acc, cur, wr, wc, fr, fq, lds, wid, lane); S.done(cur); }
#undef PG8_SA
#undef PG8_SB
#undef PG8_STAGE
#undef PG8_LDA
#undef PG8_LDB
#undef PG8_MMA
#undef PG8_WAIT_V
#undef PG8_WAIT_L
#undef PG8_BAR
#undef PG8_SCHED
}
}

#define LAS __attribute__((address_space(3)))
#define DEVI __device__ __forceinline__
typedef unsigned short bf16_t;
typedef float f32x4 __attribute__((ext_vector_type(4)));
typedef unsigned u32x4 __attribute__((ext_vector_type(4)));
typedef unsigned u32x2 __attribute__((ext_vector_type(2)));
typedef short bf16x8_t __attribute__((ext_vector_type(8)));

constexpr int DM = 1024, TSEQ = 8192, NPR = 16384  , NSR = 128  , NTOK = NPR + NSR, MPAD = 16640  ;
constexpr int DIN = 3336, NZ = 3584, FF = 4096, NH = 4, DH = 64, NLAYER = 2, WB = 2048, DECB = 32, DECT = 4;
constexpr float EPSN = 1e-6f, NEGV = -1e30f;
constexpr int ZC_AQ = 0, ZC_AK = 256, ZC_AV = 512, ZC_BQ = 768, ZC_BK = 1024, ZC_BV = 1280, ZC_BO = 1536, ZC_CU = 1792, ZC_CV = 2048, ZC_DQ = 2304, ZC_DF = 2560, ZC_DI = 2816, ZC_DG = 3072;
constexpr int SRC_GATE = 1792, ZC_GI = 3328, ZC_GF = 3332;
enum { I_XP = 0, I_XS, I_CK, I_CV, I_MC, I_MN, I_MM, I_HS, I_RB, I_WIN, I_WOUT, I_GATTN, I_GMLP, I_WUP, I_WDN, I_BI, I_BF, I_GML, I_GCV, I_WS, I_BS, I_LB, I_GHG, I_GFIN, N_IN };
constexpr size_t O_YP = 0, O_YS = O_YP + (size_t)NPR * DM, O_KWP = O_YS + (size_t)NSR * DM, O_VWP = O_KWP + (size_t)NLAYER * 2 * WB * 256, O_KWS = O_VWP + (size_t)NLAYER * 2 * WB * 256,
                 O_VWS = O_KWS + (size_t)NLAYER * DECB * WB * 256, O_CP = O_VWS + (size_t)NLAYER * DECB * WB * 256, O_NP = O_CP + (size_t)NLAYER * 2 * NH * 4096, O_MP = O_NP + (size_t)NLAYER * 2 * NH * 64,
                 O_CS = O_MP + (size_t)NLAYER * 2 * NH, O_NS = O_CS + (size_t)NLAYER * DECB * NH * 4096, O_MS = O_NS + (size_t)NLAYER * DECB * NH * 64, O_SP = O_MS + (size_t)NLAYER * DECB * NH,
                 O_SS = O_SP + (size_t)NLAYER * 2 * NH * 4096, O_CVS = O_SS + (size_t)NLAYER * DECB * NH * 4096, O_END = O_CVS + (size_t)NLAYER * DECB * DECT * 256;
constexpr size_t MiB = 1u << 20;
constexpr size_t WS_CTL = 0, CTL_ZERO_BYTES = 64 * 1024;
constexpr size_t WS_WIN = 1 * MiB, WS_WOUT = 15 * MiB, WS_WUP = 19 * MiB, WS_WDN = 35 * MiB;
constexpr size_t WS_XN = 51 * MiB;
constexpr size_t WS_SMALL = 84 * MiB;
constexpr size_t WS_Z = 86 * MiB, WS_MIX = 200 * MiB, WS_H = WS_Z;
constexpr size_t WS_X1 = 233 * MiB, WS_X2 = 298 * MiB;
constexpr size_t WS_MU = 363 * MiB, WS_MCS = 372 * MiB, WS_HU = 381 * MiB, WS_HSS = 390 * MiB, WS_END = 399 * MiB;
static_assert(WS_Z + (size_t)MPAD * NZ * 2 <= WS_MIX && WS_MIX + (size_t)MPAD * DM * 2 <= WS_X1 && WS_H + (size_t)MPAD * FF * 2 <= WS_X1, "ws map");
static_assert(WS_WIN + 2 * (size_t)NZ * DM * 2 <= WS_WOUT && WS_XN + (size_t)MPAD * DM * 2 <= WS_SMALL, "ws map 2");
constexpr size_t SM_SSQ = 0, SM_BT = 1280 * 1024;
constexpr int NCHUNK = 64, NITEM_REC = 2 * NH * NCHUNK;
constexpr size_t REC_N_OFF = (size_t)NITEM_REC * 4096 * 4, REC_M_OFF = REC_N_OFF + (size_t)NITEM_REC * 64 * 4, REC_B_OFF = REC_M_OFF + (size_t)NITEM_REC * 4;
static_assert(REC_B_OFF + NITEM_REC * 4 <= 9 * MiB, "rec scratch");

constexpr int LDS_BYTES = 148480, NTHREADS = 512, EPI_STG = 131072;
#ifndef REP_ATT
#define REP_ATT 1
#endif
#ifndef REP_GMLP
#define REP_GMLP 1
#endif
#ifndef REP_STATE
#define REP_STATE 1
#endif
#ifndef REP_OUT
#define REP_OUT 1
#endif
#ifndef REP_COPY
#define REP_COPY 1
#endif
#ifndef REP_SATT
#define REP_SATT 1
#endif
#ifndef REP_SREC
#define REP_SREC 1
#endif


struct Params { const float* in[N_IN]; float* out; unsigned char* ws; int ph_lo, ph_hi; };

DEVI float bf2f(unsigned v) { return __uint_as_float(v << 16); }
DEVI unsigned pk2(float lo, float hi) { unsigned r; asm("v_cvt_pk_bf16_f32 %0, %1, %2" : "=v"(r) : "v"(lo), "v"(hi)); return r; }
DEVI unsigned f2bf(float f) { return pk2(f, 0.f) & 0xffffu; }
DEVI float bflo(unsigned u) { return __uint_as_float(u << 16); }
DEVI float bfhi(unsigned u) { return __uint_as_float(u & 0xffff0000u); }
DEVI void unpack8(const u32x4 u, float* f) { f[0] = bflo(u.x); f[1] = bfhi(u.x); f[2] = bflo(u.y); f[3] = bfhi(u.y); f[4] = bflo(u.z); f[5] = bfhi(u.z); f[6] = bflo(u.w); f[7] = bfhi(u.w); }
DEVI int lane_opaque() { unsigned z = 0u; asm volatile("" : "+s"(z)); return (int)__builtin_amdgcn_mbcnt_hi(~0u, __builtin_amdgcn_mbcnt_lo(~0u, z)); }
DEVI float shfl_xor_f(float v, int m) {
    const unsigned b = __builtin_bit_cast(unsigned, v);
    if (m == 32) { const auto r = __builtin_amdgcn_permlane32_swap(b, b, false, false); return __builtin_bit_cast(float, (lane_opaque() & 32) ? r[0] : r[1]); }
    if (m == 16) { const auto r = __builtin_amdgcn_permlane16_swap(b, b, false, false); return __builtin_bit_cast(float, (lane_opaque() & 16) ? r[0] : r[1]); }
    return __builtin_bit_cast(float, __builtin_amdgcn_ds_bpermute((lane_opaque() ^ m) << 2, __builtin_bit_cast(int, v)));
}
DEVI float shfl_up_f(float v, int o) { const int l = lane_opaque(); const int s = l - o; return __builtin_bit_cast(float, __builtin_amdgcn_ds_bpermute((s < 0 ? l : s) << 2, __builtin_bit_cast(int, v))); }
typedef short v4i16_t __attribute__((ext_vector_type(4)));
template <int PITCH = 144> DEVI bf16x8_t lds_tfrag(const LAS unsigned char* stage, int ks, int col, int gq) {
    const int i = col & 15, q = i >> 2, p = i & 3;
    const LAS unsigned char* a0 = stage + (32 * ks + 4 * gq + q) * PITCH + ((col - i) + 4 * p) * 2;
    const v4i16_t lo = __builtin_amdgcn_ds_read_tr16_b64_v4i16((LAS v4i16_t*)a0), hi = __builtin_amdgcn_ds_read_tr16_b64_v4i16((LAS v4i16_t*)(a0 + 16 * PITCH));
    return (bf16x8_t){lo[0], lo[1], lo[2], lo[3], hi[0], hi[1], hi[2], hi[3]};
}
DEVI float wave_sum(float v) {
#pragma unroll
    for (int o = 1; o < 64; o <<= 1) v += shfl_xor_f(v, o);
    return v;
}
DEVI float wave_max(float v) {
#pragma unroll
    for (int o = 1; o < 64; o <<= 1) v = fmaxf(v, shfl_xor_f(v, o));
    return v;
}
DEVI float sum8(float v) {
    v += __builtin_bit_cast(float, __builtin_amdgcn_update_dpp(0, __builtin_bit_cast(int, v), 0xB1, 0xF, 0xF, true));
    v += __builtin_bit_cast(float, __builtin_amdgcn_update_dpp(0, __builtin_bit_cast(int, v), 0x4E, 0xF, 0xF, true));
    v += __builtin_bit_cast(float, __builtin_amdgcn_update_dpp(0, __builtin_bit_cast(int, v), 0x141, 0xF, 0xF, true));
    return v;
}
DEVI float sum16(float v) {
    v = sum8(v);
    v += __builtin_bit_cast(float, __builtin_amdgcn_update_dpp(0, __builtin_bit_cast(int, v), 0x140, 0xF, 0xF, true));
    return v;
}
DEVI float frcp(float x) { return __builtin_amdgcn_rcpf(x); }
DEVI float sigmoidf_(float x) { return frcp(1.0f + __expf(-x)); }
DEVI float log1pexp_neg(float a) { return __logf(1.0f + __expf(-a)); }
DEVI float log_sigmoid(float x) { return fminf(x, 0.f) - log1pexp_neg(fabsf(x)); }
DEVI float gelu_tanh(float x) { const float u = 0.7978845608028654f * (x + 0.044715f * x * x * x); return x * frcp(1.0f + __expf(-2.0f * u)); }

#define GAS __attribute__((address_space(1)))
struct InPtrs { GAS const float* const __attribute__((address_space(4)))* p; DEVI const float* operator[](int i) const { return (const float*)p[i]; } };
struct ParamsDev { GAS const float* in[N_IN]; GAS float* out; GAS unsigned char* ws; int ph_lo, ph_hi; };
struct Ctx {
    InPtrs in; float* out; unsigned char* ws;
    LAS unsigned char* lds; int tid, lane, wave, G, bid;
    DEVI bf16_t* Z() const { return (bf16_t*)(ws + WS_Z); }
    DEVI bf16_t* MIX() const { return (bf16_t*)(ws + WS_MIX); }
    DEVI bf16_t* Hb() const { return (bf16_t*)(ws + WS_H); }
    DEVI bf16_t* X1() const { return (bf16_t*)(ws + WS_X1); }
    DEVI bf16_t* X2() const { return (bf16_t*)(ws + WS_X2); }
    DEVI float* SSQ() const { return (float*)(ws + WS_SMALL + SM_SSQ); }
    DEVI float* BT() const { return (float*)(ws + WS_SMALL + SM_BT); }
};

DEVI Ctx relaunder(const Ctx& c0) {
    Ctx c = c0; int t = c0.wave * 64 + lane_opaque(); asm volatile("" : "+v"(t)); c.tid = t; c.lane = t & 63; c.wave = c0.wave;
    auto inp = c0.in.p; asm volatile("" : "+s"(inp)); c.in.p = inp; GAS unsigned char* w = (GAS unsigned char*)c0.ws; asm volatile("" : "+s"(w)); c.ws = (unsigned char*)w; GAS float* o = (GAS float*)c0.out; asm volatile("" : "+s"(o)); c.out = (float*)o; return c;
}
constexpr int CW_QUEUE = 4096;
struct WorkQueue {
    unsigned* ctr; int nxt;
    DEVI void prefetch(const Ctx& c) { int t = 0; if (c.wave == 0 && lane_opaque() == 0) t = (int)__hip_atomic_fetch_add(ctr, 1u, __ATOMIC_RELAXED, __HIP_MEMORY_SCOPE_AGENT); nxt = t; }
    DEVI void start(const Ctx& c, unsigned* counter) { ctr = counter; nxt = 0; prefetch(c); }
    DEVI int pop(const Ctx& c) {
        LAS int* slot = (LAS int*)(c.lds + LDS_BYTES - 32);
        __syncthreads();
        if (c.wave == 0 && lane_opaque() == 0) *slot = nxt;
        __syncthreads();
        return *slot;
    }
};

DEVI float row_rs(const float* ssq, int row) {
    const f32x4* p = (const f32x4*)(ssq + (size_t)row * 16); const f32x4 a = p[0], b = p[1], c2 = p[2], d = p[3];
    const float s = ((a[0] + a[1]) + (a[2] + a[3])) + ((b[0] + b[1]) + (b[2] + b[3])) + ((c2[0] + c2[1]) + (c2[2] + c2[3])) + ((d[0] + d[1]) + (d[2] + d[3]));
    return rsqrtf(s * (1.0f / DM) + EPSN);
}
template <int ACT  > struct EpiRowScaleBf16 {
    static constexpr bool PERM = true, WIDE = true, AFTER_DRAIN = false;
    bf16_t* O; int ldc; const float* ssq; LAS unsigned char* stg;
    __device__ __forceinline__ void operator()(const pg8::f32x4 (&acc)[2][2][4][2], const pg8::Unit& u, int wr, int wc, int fr, int fq) const {
        const int row0 = u.pm * 256 + wr * 64 + fr;
        const int lane = fr + 16 * fq, rr = lane >> 3, sg = lane & 7;
        LAS unsigned char* my = stg + (wr * 4 + wc) * 2048;
        float rsv[2];
#pragma unroll
        for (int j = 0; j < 2; ++j) { const int row = row0 + (fq >> 1) * 128 + (2 * (fq & 1) + j) * 16; rsv[j] = row_rs(ssq, row < NTOK ? row : NTOK - 1); }
        bf16_t* obase = O + (size_t)(u.pm * 256 + wr * 64 + rr) * ldc + u.pn * 256 + wc * 64 + sg * 8;
#pragma unroll
        for (int ai = 0; ai < 2; ++ai)
#pragma unroll
            for (int m = 0; m < 4; ++m) {
                const float s = __builtin_bit_cast(float, __builtin_amdgcn_ds_bpermute((fr + 16 * (2 * ai + (m >> 1))) << 2, __builtin_bit_cast(int, rsv[m & 1])));
#pragma unroll
                for (int bj = 0; bj < 2; ++bj) {
                    pg8::f32x4 v0 = acc[ai][bj][m][0] * s, v1 = acc[ai][bj][m][1] * s;
                    if (ACT == 1) {
#pragma unroll
                        for (int e = 0; e < 4; ++e) { const float a = fmaxf(v0[e], 0.f), b = fmaxf(v1[e], 0.f); v0[e] = a * a; v1[e] = b * b; }
                    }
                    u32x4 w; w.x = pk2(v0[0], v0[1]); w.y = pk2(v0[2], v0[3]); w.z = pk2(v1[0], v1[1]); w.w = pk2(v1[2], v1[3]);
                    *(LAS u32x4*)(my + fr * 128 + (((bj * 4 + fq) ^ (fr & 7)) * 16)) = w;
                }
#pragma unroll
                for (int k = 0; k < 2; ++k) { const int r = rr + 8 * k; const u32x4 w = *(const LAS u32x4*)(my + r * 128 + ((sg ^ (r & 7)) * 16));
                    *(u32x4*)(obase + (size_t)(ai * 128 + m * 16 + 8 * k) * ldc) = w; }
            }
    }
};
struct EpiResidualNorm {
    static constexpr bool PERM = false, WIDE = false, AFTER_DRAIN = false;
    const bf16_t* base; bf16_t* out; float* ssq; LAS unsigned char* stg;
    __device__ __forceinline__ void operator()(const pg8::f32x4 (&acc)[2][2][4][2], const pg8::Unit& u, int wr, int wc, int fr, int fq) const {
        const int lane = fr + 16 * fq, rr = lane >> 3, sg = lane & 7;
        LAS unsigned char* my = stg + (wr * 4 + wc) * 2048;
        const int rbase = u.pm * 256 + wr * 64, cb = u.pn * 256 + wc * 32 + 4 * sg;
        u32x2 pre[4][2][2];
#define RN_LOAD(G) do { _Pragma("unroll") for (int k = 0; k < 2; ++k) _Pragma("unroll") for (int bj = 0; bj < 2; ++bj) \
            pre[(G) & 3][k][bj] = *(const u32x2*)(base + (size_t)(rbase + ((G) >> 2) * 128 + ((G) & 3) * 16 + rr + 8 * k) * DM + cb + bj * 128); } while (0)
        RN_LOAD(0); RN_LOAD(1); RN_LOAD(2); RN_LOAD(3);
        __builtin_amdgcn_sched_barrier(0);
#pragma unroll
        for (int G = 0; G < 8; ++G) {
            const int ai = G >> 2, m = G & 3; float ss[2] = {0.f, 0.f};
#pragma unroll
            for (int bj = 0; bj < 2; ++bj) {
#pragma unroll
                for (int n = 0; n < 2; ++n) *(LAS pg8::f32x4*)(my + fr * 128 + (((n * 4 + fq) ^ (fr & 7)) * 16)) = acc[ai][bj][m][n];
#pragma unroll
                for (int k = 0; k < 2; ++k) { const int r = rr + 8 * k; const pg8::f32x4 v = *(const LAS pg8::f32x4*)(my + r * 128 + ((sg ^ (r & 7)) * 16));
                    const u32x2 pb = pre[G & 3][k][bj]; const pg8::f32x4 x = (pg8::f32x4){bflo(pb.x), bfhi(pb.x), bflo(pb.y), bfhi(pb.y)} + v; const size_t o = (size_t)(rbase + ai * 128 + m * 16 + r) * DM + cb + bj * 128;
                    { u32x2 xb; xb.x = pk2(x[0], x[1]); xb.y = pk2(x[2], x[3]); *(u32x2*)(out + o) = xb; } ss[k] += (x[0] * x[0] + x[1] * x[1]) + (x[2] * x[2] + x[3] * x[3]); }
            }
            if (G + 4 < 8) RN_LOAD(G + 4);
#pragma unroll
            for (int k = 0; k < 2; ++k) { const float s = sum8(ss[k]); if (sg == 0) ssq[(size_t)(rbase + ai * 128 + m * 16 + rr + 8 * k) * 16 + u.pn * 4 + wc] = s; }
        }
#undef RN_LOAD
    }
};

template <class E> DEVI void skinny_gemm(const Ctx& c, const bf16_t* A, const bf16_t* Bt, int N, int K, const E& epi) {
    const int lane = c.lane, fr = lane & 15, gq = lane >> 4, ngrp = N >> 6, total = ngrp * 8, kw = K >> 3;
    LAS float* red = (LAS float*)(c.lds + 32768);
    bf16x8_t a0[4], b0[4][4], a1[4], b1[4][4];
    const bf16_t* ap = A; const bf16_t* bp = Bt;
#define SK_PTRS(T) { const int ng_ = (T) % ngrp, mg_ = (T) / ngrp; ap = A + (size_t)(mg_ * 16 + fr) * K + c.wave * kw + 8 * gq; bp = Bt + (size_t)(ng_ * 64 + fr) * K + c.wave * kw + 8 * gq; }
#define SK_LOAD(AF, BF, KC) { _Pragma("unroll") for (int s4 = 0; s4 < 4; ++s4) { AF[s4] = *(const bf16x8_t*)(ap + (KC) + 32 * s4); _Pragma("unroll") for (int e = 0; e < 4; ++e) BF[s4][e] = *(const bf16x8_t*)(bp + (size_t)(16 * e) * K + (KC) + 32 * s4); } }
#define SK_MMA(AF, BF) { _Pragma("unroll") for (int s4 = 0; s4 < 4; ++s4) { _Pragma("unroll") for (int e = 0; e < 4; ++e) acc[e] = __builtin_amdgcn_mfma_f32_16x16x32_bf16(BF[s4][e], AF[s4], acc[e], 0, 0, 0); } }
    if (c.bid < total) { SK_PTRS(c.bid); SK_LOAD(a0, b0, 0); }
    for (int task = c.bid; task < total; task += c.G) {
        const int ng = task % ngrp, mg = task / ngrp;
        f32x4 acc[4];
#pragma unroll
        for (int e = 0; e < 4; ++e) acc[e] = (f32x4){0.f, 0.f, 0.f, 0.f};
#pragma unroll 1
        for (int kc = 0; kc < kw; kc += 256) {
            const bool h1 = kc + 128 < kw;
            if (h1) SK_LOAD(a1, b1, kc + 128);
            __builtin_amdgcn_sched_barrier(0);
            SK_MMA(a0, b0);
            __builtin_amdgcn_sched_barrier(0);
            if (h1) {
                if (kc + 256 < kw) SK_LOAD(a0, b0, kc + 256);
                __builtin_amdgcn_sched_barrier(0);
                SK_MMA(a1, b1);
                __builtin_amdgcn_sched_barrier(0);
            }
        }
        if (task + c.G < total) { SK_PTRS(task + c.G); SK_LOAD(a0, b0, 0); }
        __builtin_amdgcn_sched_barrier(0);
        __syncthreads();
#pragma unroll
        for (int e = 0; e < 4; ++e) *(LAS f32x4*)(red + ((c.wave * 4 + e) * 64 + lane) * 4) = acc[e];
        __syncthreads();
        { const int row = c.tid >> 5, cp = c.tid & 31, col = 2 * cp, e = col >> 4, g2 = (col >> 2) & 3, r = col & 3; float s0 = 0.f, s1 = 0.f;
#pragma unroll
          for (int w = 0; w < 8; ++w) { const LAS float* p = red + ((w * 4 + e) * 64 + (g2 * 16 + row)) * 4 + r; s0 += p[0]; s1 += p[1]; }
          float ss = epi.pair(mg * 16 + row, ng * 64 + col, s0, s1);
          ss += shfl_xor_f(ss, 1); ss += shfl_xor_f(ss, 2); ss += shfl_xor_f(ss, 4); ss += shfl_xor_f(ss, 8); ss += shfl_xor_f(ss, 16);
          if (cp == 0) epi.rowsum(mg * 16 + row, ng, ss); }
    }
#undef SK_PTRS
#undef SK_LOAD
#undef SK_MMA
    __syncthreads();
}
struct SkEpiResidualNorm {
    const bf16_t* base; bf16_t* out; float* ssq;
    DEVI float pair(int row, int col, float v0, float v1) const { const size_t o = (size_t)row * DM + col; const unsigned bb = *(const unsigned*)(base + o); const float x0 = bflo(bb) + v0, x1 = bfhi(bb) + v1; *(unsigned*)(out + o) = pk2(x0, x1); return x0 * x0 + x1 * x1; }
    DEVI void rowsum(int row, int slot, float s) const { ssq[(size_t)row * 16 + slot] = s; }
};
struct SkEpiRelu2 { bf16_t* H; const float* ssq;
    DEVI float pair(int row, int col, float v0, float v1) const { const float rs = row_rs(ssq, row); const float a = fmaxf(v0 * rs, 0.f), b = fmaxf(v1 * rs, 0.f); *(unsigned*)(H + (size_t)row * FF + col) = pk2(a * a, b * b); return 0.f; }
    DEVI void rowsum(int, int, float) const {}
};

DEVI void transpose_item(const float* W, int ldw, int src_col0, int K, bf16_t* WT, int dst_row0, LAS float* scr, int k0, int lane, const float* gk) {
    float wv[32];
#pragma unroll
    for (int i = 0; i < 32; ++i) wv[i] = __builtin_nontemporal_load(W + (size_t)(k0 + 2 * i + (lane >> 5)) * ldw + src_col0 + (lane & 31));
#pragma unroll
    for (int i = 0; i < 32; ++i) scr[(2 * i + (lane >> 5)) * 33 + (lane & 31)] = gk ? wv[i] * gk[k0 + 2 * i + (lane >> 5)] : wv[i];
    asm volatile("s_waitcnt lgkmcnt(0)" ::: "memory");
    const int c = lane & 7;
#pragma unroll
    for (int j = 0; j < 4; ++j) { const int n = (lane >> 3) + 8 * j; const LAS float* s = scr + (8 * c) * 33 + n;
        u32x4 o; o.x = pk2(s[0 * 33], s[1 * 33]); o.y = pk2(s[2 * 33], s[3 * 33]); o.z = pk2(s[4 * 33], s[5 * 33]); o.w = pk2(s[6 * 33], s[7 * 33]);
        *(u32x4*)(WT + (size_t)(dst_row0 + n) * K + k0 + 8 * c) = o; }
    asm volatile("s_waitcnt lgkmcnt(0)" ::: "memory");
}
DEVI int rel_bucket(int dist) {
    if (dist < 16) return dist;
    int large = 16 + (int)(log((double)dist / 16.0) / log(128.0) * 16.0);
    large = large < 16 ? 16 : (large > 31 ? 31 : large);
    return large;
}
DEVI void phase_prologue(const Ctx& c) {
    LAS float* scr = (LAS float*)(c.lds + c.wave * 16384);
    const int gw = c.bid * 8 + c.wave, NGW = c.G * 8;
    constexpr int NZS = 3328 + 32;
    constexpr int I_IN = 16 * (NZS / 32), I_OUT = 16 * 32, I_UP = 16 * (FF / 32), I_DN = 64 * 32, I_L = I_IN + I_OUT + I_UP + I_DN;
    for (int it = gw; it < NLAYER * I_L; it += NGW) {
        const int l = it / I_L; int r = it % I_L;
        if (r < I_IN) { const int kb = r / (NZS / 32), nb = r % (NZS / 32), n0 = nb * 32;
            transpose_item(c.in[I_WIN] + (size_t)l * DM * DIN, DIN, n0 == 3328 ? SRC_GATE : n0 + (n0 >= SRC_GATE ? 8 : 0), DM, (bf16_t*)(c.ws + WS_WIN) + (size_t)l * NZ * DM, n0, scr, kb * 64, c.lane, c.in[I_GATTN] + l * DM); continue; }
        r -= I_IN;
        if (r < I_OUT) { const int kb = r / 32, nb = r % 32; transpose_item(c.in[I_WOUT] + (size_t)l * DM * DM, DM, nb * 32, DM, (bf16_t*)(c.ws + WS_WOUT) + (size_t)l * DM * DM, nb * 32, scr, kb * 64, c.lane, nullptr); continue; }
        r -= I_OUT;
        if (r < I_UP) { const int kb = r / (FF / 32), nb = r % (FF / 32); transpose_item(c.in[I_WUP] + (size_t)l * DM * FF, FF, nb * 32, DM, (bf16_t*)(c.ws + WS_WUP) + (size_t)l * FF * DM, nb * 32, scr, kb * 64, c.lane, c.in[I_GMLP] + l * DM); continue; }
        r -= I_UP;
        { const int kb = r / 32, nb = r % 32; transpose_item(c.in[I_WDN] + (size_t)l * FF * DM, DM, nb * 32, FF, (bf16_t*)(c.ws + WS_WDN) + (size_t)l * DM * FF, nb * 32, scr, kb * 64, c.lane, nullptr); }
    }
    for (int idx = c.bid * NTHREADS + c.tid; idx < NLAYER * 224 * (DM / 8); idx += c.G * NTHREADS) { const int l = idx / (224 * (DM / 8)), r = idx % (224 * (DM / 8));
        *(u32x4*)((bf16_t*)(c.ws + WS_WIN) + (size_t)l * NZ * DM + (size_t)3360 * DM + (size_t)r * 8) = (u32x4){0u, 0u, 0u, 0u}; }
    for (int row0 = gw; row0 < NTOK; row0 += 3 * NGW) {
        f32x4 v[3][4];
#pragma unroll
        for (int r = 0; r < 3; ++r) { const int row = row0 + r * NGW < NTOK ? row0 + r * NGW : row0;
            const float* xr = (row < NPR) ? c.in[I_XP] + (size_t)row * DM : c.in[I_XS] + (size_t)(row - NPR) * DM;
#pragma unroll
            for (int j = 0; j < 4; ++j) v[r][j] = __builtin_nontemporal_load((const f32x4*)(xr + 256 * j + 4 * c.lane)); }
        __builtin_amdgcn_sched_barrier(0);
#pragma unroll
        for (int r = 0; r < 3; ++r) { const int row = row0 + r * NGW; if (row < NTOK) {
            float ss = 0.f; u32x2* xb = (u32x2*)(c.X2() + (size_t)row * DM);
#pragma unroll
            for (int j = 0; j < 4; ++j) { ss += (v[r][j][0] * v[r][j][0] + v[r][j][1] * v[r][j][1]) + (v[r][j][2] * v[r][j][2] + v[r][j][3] * v[r][j][3]);
                u32x2 w2; w2.x = pk2(v[r][j][0], v[r][j][1]); w2.y = pk2(v[r][j][2], v[r][j][3]); xb[64 * j + c.lane] = w2; }
            ss = wave_sum(ss);
            if (c.lane < 16) c.SSQ()[(size_t)row * 16 + c.lane] = c.lane == 0 ? ss : 0.f; } }
    }
    if (c.bid == 0) {
        for (int i = c.tid; i < 3 * 129 * 4; i += NTHREADS) { const int h = i & 3, j = (i >> 2) % 129, pat = (i >> 2) / 129; const int d = pat == 0 ? 1 : (pat == 1 ? 4 : 16);
            c.BT()[i] = c.in[I_RB][rel_bucket(j * d) * 4 + h]; }
    }
}

DEVI void attn_sample_qh(const Ctx& c, int layer, int b, int h, int t) {
    const bf16_t* Z = c.Z(); const int lane = c.lane, kg = lane >> 4, c4 = lane & 15;
    const size_t rbase = (size_t)(NPR + b * DECT);
    const size_t qrow = rbase + t;
    LAS float* pl = (LAS float*)(c.lds + c.wave * 1024);
    const u32x2 qu = *(const u32x2*)(Z + qrow * NZ + ZC_AQ + h * 64 + 4 * c4);
    const f32x4 q4 = (f32x4){bflo(qu.x), bfhi(qu.x), bflo(qu.y), bfhi(qu.y)};
    const float* bt = c.BT() + h;
    const float* ck = c.in[I_CK] + ((size_t)(layer * DECB + b) * WB) * 256 + h * 64;
    const float* cv = c.in[I_CV] + ((size_t)(layer * DECB + b) * WB) * 256 + h * 64;
    float Mx = NEGV, wsum = 0.f; f32x4 accv = (f32x4){0.f, 0.f, 0.f, 0.f};
#pragma unroll 1
    for (int pat = 0; pat < 3; ++pat) {
        const int d = 1 << (2 * pat);
        const float* btp = bt + pat * 129 * 4;
        const int pos0 = t - kg * d; const bool isz = pos0 >= 0; const int zp = isz ? pos0 : 0, cp = isz ? -1 : pos0;
        const unsigned loff = (unsigned)((3 - kg) * d * 256 + 4 * c4), loff0 = (unsigned)((WB + cp) * 256 + 4 * c4), loff32 = (unsigned)(4 * c4);
        float lg[33]; f32x4 kv[33];
        const u32x2 uk = *(const u32x2*)(Z + (rbase + zp) * NZ + ZC_AK + h * 64 + 4 * c4);
        kv[0] = *(const f32x4*)(ck + loff0);
#pragma unroll
        for (int it = 1; it < 32; ++it) kv[it] = *(const f32x4*)(ck + (size_t)(WB + t - (4 * it + 3) * d) * 256 + loff);
        kv[32] = *(const f32x4*)(ck + (size_t)(WB + t - 128 * d) * 256 + loff32);
        { const float b0 = btp[lane * 4], b1 = btp[(64 + lane) * 4], b2 = btp[128 * 4]; pl[lane] = b0; pl[64 + lane] = b1; pl[128 + lane] = b2; }
        __builtin_amdgcn_sched_barrier(0);
        kv[0] = (f32x4){isz ? bflo(uk.x) : kv[0][0], isz ? bfhi(uk.x) : kv[0][1], isz ? bflo(uk.y) : kv[0][2], isz ? bfhi(uk.y) : kv[0][3]};
#pragma unroll
        for (int it = 0; it < 33; ++it) {
            const float dot = sum16((q4[0] * kv[it][0] + q4[1] * kv[it][1]) + (q4[2] * kv[it][2] + q4[3] * kv[it][3]));
            lg[it] = (it < 32 || kg == 0) ? dot * 0.125f + pl[4 * it + kg] : NEGV;
        }
        __builtin_amdgcn_sched_barrier(0);
        const u32x2 uv = *(const u32x2*)(Z + (rbase + zp) * NZ + ZC_AV + h * 64 + 4 * c4);
        kv[0] = *(const f32x4*)(cv + loff0);
#pragma unroll
        for (int it = 1; it < 32; ++it) kv[it] = *(const f32x4*)(cv + (size_t)(WB + t - (4 * it + 3) * d) * 256 + loff);
        kv[32] = *(const f32x4*)(cv + (size_t)(WB + t - 128 * d) * 256 + loff32);
        __builtin_amdgcn_sched_barrier(0);
        float m = lg[0];
#pragma unroll
        for (int it = 1; it < 33; ++it) m = fmaxf(m, lg[it]);
        m = fmaxf(m, shfl_xor_f(m, 16)); m = fmaxf(m, shfl_xor_f(m, 32));
        float den = 0.f;
#pragma unroll
        for (int it = 0; it < 33; ++it) { lg[it] = __expf(lg[it] - m); den += lg[it]; }
        den += shfl_xor_f(den, 16); den += shfl_xor_f(den, 32);
        __builtin_amdgcn_sched_barrier(0);
        f32x4 o4 = (f32x4){isz ? bflo(uv.x) : kv[0][0], isz ? bfhi(uv.x) : kv[0][1], isz ? bflo(uv.y) : kv[0][2], isz ? bfhi(uv.y) : kv[0][3]} * lg[0];
#pragma unroll
        for (int it = 1; it < 33; ++it) o4 += kv[it] * lg[it];
#pragma unroll
        for (int e = 0; e < 4; ++e) { o4[e] += shfl_xor_f(o4[e], 16); o4[e] += shfl_xor_f(o4[e], 32); }
        const float lse = m + __logf(den), Mn = fmaxf(Mx, lse), sc = __expf(Mx - Mn), wp = __expf(lse - Mn);
        accv = accv * sc + o4 * (wp / den); wsum = wsum * sc + wp; Mx = Mn;
    }
    if (kg == 0) { const f32x4 r = accv * (1.0f / wsum); u32x2 w; w.x = pk2(r[0], r[1]); w.y = pk2(r[2], r[3]); *(u32x2*)(c.MIX() + qrow * DM + h * 64 + 4 * c4) = w; }
}

constexpr int AT_LBW = 192;
constexpr int AT_OA = 0, AT_LM = 65536, AT_LW = AT_LM + 1024, AT_LB = AT_LW + 1024, AT_VS = AT_LB + 3 * AT_LBW * 4, AT_VS_WAVE = 32 * 144;
static_assert(AT_VS % 16 == 0 && AT_VS + 8 * AT_VS_WAVE <= LDS_BYTES - 64, "attention LDS map");
DEVI void attn_block_item(const Ctx& c, int layer, int b, int h, int blk, WorkQueue& q) {
    const int lane = c.lane, i = lane & 15, gq = lane >> 4;
    LAS float* OA = (LAS float*)(c.lds + AT_OA); LAS float* LM = (LAS float*)(c.lds + AT_LM); LAS float* LW = (LAS float*)(c.lds + AT_LW); LAS float* LB = (LAS float*)(c.lds + AT_LB);
    LAS unsigned char* VS = c.lds + AT_VS + c.wave * AT_VS_WAVE;
    __syncthreads();
    for (int idx = c.tid; idx < 3 * AT_LBW; idx += NTHREADS) { const int pat = idx / AT_LBW, x = idx % AT_LBW - 16, j = 128 - x; LB[idx] = (j >= 0 && j <= 128) ? 1.4426950408889634f * c.BT()[(pat * 129 + j) * 4 + h] : 0.f; }
    __syncthreads();
    const int base = blk * 256;
    const char* zb = (const char*)(c.Z() + (size_t)b * TSEQ * NZ + h * 64);
#define AT_T0(PAT, TK) (base + ((PAT) == 0 ? 16 * (TK) : ((PAT) == 1 ? 64 * ((TK) >> 2) + ((TK) & 3) : (TK))))
    bf16x8_t qf[2], kfr[9][2];
#define AT_KQLOAD(PAT, TK) do { const int d_ = 1 << (2 * (PAT)), t0_ = AT_T0(PAT, TK); const unsigned lk_ = (unsigned)((d_ * i * NZ + 8 * gq) * 2); \
        { const char* qb = zb + ((size_t)(unsigned)t0_ * NZ + ZC_AQ) * 2; qf[0] = *(const bf16x8_t*)(qb + lk_); qf[1] = *(const bf16x8_t*)(qb + lk_ + 64); } \
        _Pragma("unroll") for (int kt = 0; kt < 9; ++kt) { int u_ = t0_ + d_ * (16 * kt - 128); u_ = u_ < 0 ? 0 : u_;     \
            const char* kb = zb + ((size_t)(unsigned)u_ * NZ + ZC_AK) * 2; kfr[kt][0] = *(const bf16x8_t*)(kb + lk_); kfr[kt][1] = *(const bf16x8_t*)(kb + lk_ + 64); } } while (0)
    AT_KQLOAD(0, c.wave);
#pragma unroll 1
    for (int ti = 0; ti < 6; ++ti) {
        {
            const int pat = ti >> 1, tk = c.wave + 8 * (ti & 1), d = 1 << (2 * pat);
            const int t0 = AT_T0(pat, tk);
            const int tq = t0 + d * i;
            const int kmin = 128 - (t0 >> (2 * pat));
            const int vrow0 = lane >> 3;
            u32x4 vr[5][4];
            const unsigned lv = (unsigned)((d * vrow0 * NZ + 8 * (lane & 7)) * 2);
#define AT_VLOAD(S5) do { _Pragma("unroll") for (int n = 0; n < ((S5) == 4 ? 2 : 4); ++n) { int uv = t0 + d * (32 * (S5) + 8 * n - 128); uv = uv < 0 ? 0 : uv;     \
                vr[(S5)][n] = *(const u32x4*)(zb + ((size_t)(unsigned)uv * NZ + ZC_AV) * 2 + lv); } } while (0)
            AT_VLOAD(0); AT_VLOAD(1); AT_VLOAD(2); AT_VLOAD(3); AT_VLOAD(4);
            __builtin_amdgcn_sched_barrier(0);
            f32x4 s[10];
#pragma unroll
            for (int kt = 0; kt < 9; ++kt) {
                f32x4 a = (f32x4){0.f, 0.f, 0.f, 0.f};
                a = __builtin_amdgcn_mfma_f32_16x16x32_bf16(kfr[kt][0], qf[0], a, 0, 0, 0);
                a = __builtin_amdgcn_mfma_f32_16x16x32_bf16(kfr[kt][1], qf[1], a, 0, 0, 0);
                s[kt] = a;
            }
            s[9] = (f32x4){0.f, 0.f, 0.f, 0.f};
            const LAS float* lb = LB + pat * AT_LBW + 16 + 4 * gq - i;
            float mx = NEGV;
#pragma unroll
            for (int half = 0; half < 2; ++half) {
                float bz[5][4];
#pragma unroll
                for (int k5 = 0; k5 < 5; ++k5) { const int kt = 5 * half + k5; if (kt < 9) {
#pragma unroll
                    for (int r = 0; r < 4; ++r) bz[k5][r] = lb[16 * kt + r]; } }
                __builtin_amdgcn_sched_barrier(0);
#pragma unroll
                for (int k5 = 0; k5 < 5; ++k5) { const int kt = 5 * half + k5; if (kt < 9) {
#pragma unroll
                    for (int r = 0; r < 4; ++r) {
                        const bool valid = kt == 0 ? (kmin <= 0 && 4 * gq + r >= i) : (kt == 8 ? (4 * gq + r <= i) : (16 * kt >= kmin));
                        const float lg = valid ? s[kt][r] * (0.125f * 1.4426950408889634f) + bz[k5][r] : NEGV;
                        s[kt][r] = lg; mx = fmaxf(mx, lg);
                    } } }
                __builtin_amdgcn_sched_barrier(0);
            }
            mx = fmaxf(mx, shfl_xor_f(mx, 16)); mx = fmaxf(mx, shfl_xor_f(mx, 32));
            float den = 0.f;
#pragma unroll
            for (int kt = 0; kt < 9; ++kt)
#pragma unroll
                for (int r = 0; r < 4; ++r) { const float pv = __builtin_amdgcn_exp2f(s[kt][r] - mx); s[kt][r] = pv; den += pv; }
            den += shfl_xor_f(den, 16); den += shfl_xor_f(den, 32);
            u32x4 pf[5];
#pragma unroll
            for (int s5 = 0; s5 < 5; ++s5) { pf[s5].x = pk2(s[2 * s5][0], s[2 * s5][1]); pf[s5].y = pk2(s[2 * s5][2], s[2 * s5][3]); pf[s5].z = pk2(s[2 * s5 + 1][0], s[2 * s5 + 1][1]); pf[s5].w = pk2(s[2 * s5 + 1][2], s[2 * s5 + 1][3]); }
            f32x4 o[4];
#pragma unroll
            for (int dt = 0; dt < 4; ++dt) o[dt] = (f32x4){0.f, 0.f, 0.f, 0.f};
#pragma unroll
            for (int s5 = 0; s5 < 5; ++s5) {
                __builtin_amdgcn_sched_barrier(0);
                if (s5 == 2 && ti == 5) q.prefetch(c);
                if (s5 == 2 && ti + 1 < 6) { const int np_ = (ti + 1) >> 1, ntk_ = c.wave + 8 * ((ti + 1) & 1); AT_KQLOAD(np_, ntk_); }
#pragma unroll
                for (int n = 0; n < 4; ++n) *(LAS u32x4*)(VS + (vrow0 + 8 * n) * 144 + (lane & 7) * 16) = (s5 == 4 && n >= 2) ? vr[4][n - 2] : vr[s5][n];
#pragma unroll
                for (int dt = 0; dt < 4; ++dt) {
                    union { u32x4 u; bf16x8_t v; } pp; pp.u = pf[s5];
                    o[dt] = __builtin_amdgcn_mfma_f32_16x16x32_bf16(lds_tfrag<144>(VS, 0, 16 * dt + i, gq), pp.v, o[dt], 0, 0, 0);
                }
            }
#undef AT_VLOAD
            const float inv = frcp(den), lse = mx + __builtin_amdgcn_logf(den); const int tok = tq - base;
            if (pat == 0) {
#pragma unroll
                for (int dt = 0; dt < 4; ++dt) *(LAS f32x4*)(OA + tok * 64 + 16 * dt + 4 * gq) = o[dt] * inv;
                if (gq == 0) { LM[tok] = lse; LW[tok] = 1.0f; }
            } else {
                const float Mo = LM[tok], Wo = LW[tok]; const float Mn = fmaxf(Mo, lse), sc = __builtin_amdgcn_exp2f(Mo - Mn), wl = __builtin_amdgcn_exp2f(lse - Mn), wp = wl * inv; const float wn = Wo * sc + wl;
                if (pat == 1) {
#pragma unroll
                    for (int dt = 0; dt < 4; ++dt) o[dt] = (*(const LAS f32x4*)(OA + tok * 64 + 16 * dt + 4 * gq)) * sc + o[dt] * wp;
#pragma unroll
                    for (int dt = 0; dt < 4; ++dt) *(LAS f32x4*)(OA + tok * 64 + 16 * dt + 4 * gq) = o[dt];
                    asm volatile("s_waitcnt lgkmcnt(0)" ::: "memory");
                    if (gq == 0) { LM[tok] = Mn; LW[tok] = wn; }
                } else {
                    const float rw = frcp(wn);
#pragma unroll
                    for (int dt = 0; dt < 4; ++dt) o[dt] = ((*(const LAS f32x4*)(OA + tok * 64 + 16 * dt + 4 * gq)) * sc + o[dt] * wp) * rw;
#pragma unroll
                    for (int dt = 0; dt < 4; ++dt) { const f32x4 r = o[dt];
                        u32x2 w; w.x = pk2(r[0], r[1]); w.y = pk2(r[2], r[3]); *(u32x2*)(c.MIX() + ((size_t)b * TSEQ + tq) * DM + h * 64 + 16 * dt + 4 * gq) = w; }
                }
            }
        }
        if (ti & 1) __syncthreads();
    }
#undef AT_KQLOAD
#undef AT_T0
}

DEVI void gmlp_item(const Ctx& c, int layer, size_t row0, int nrows, float* chunk_v_out) {
    LAS float* vr = (LAS float*)c.lds;
    const bf16_t* Z = c.Z(); const int lane = c.lane;
    const float* gcv = c.in[I_GCV] + layer * 256;
    __syncthreads();
    for (int r = c.wave; r < nrows; r += 8) {
        const u32x2 u = *(const u32x2*)(Z + (row0 + r) * NZ + ZC_CV + 4 * lane);
        float e0 = gelu_tanh(bflo(u.x)), e1 = gelu_tanh(bfhi(u.x)), e2 = gelu_tanh(bflo(u.y)), e3 = gelu_tanh(bfhi(u.y));
        const float ss = wave_sum((e0 * e0 + e1 * e1) + (e2 * e2 + e3 * e3));
        const float rs = rsqrtf(ss * (1.0f / 256.0f) + EPSN);
        const f32x4 gv = *(const f32x4*)(gcv + 4 * lane);
        f32x4 o; o[0] = e0 * rs * gv[0]; o[1] = e1 * rs * gv[1]; o[2] = e2 * rs * gv[2]; o[3] = e3 * rs * gv[3];
        *(LAS f32x4*)(vr + r * 260 + 4 * lane) = o;
        if (chunk_v_out) *(f32x4*)(chunk_v_out + (size_t)r * 256 + 4 * lane) = o;
    }
    __syncthreads();
    const int t = c.tid >> 2, hh = c.tid & 3;
    const float* wrow = c.in[I_WS] + ((size_t)(layer * NH + hh) * 128 + t) * 128;
    int smax = c.wave * 16 + 15; if (smax > nrows - 1) smax = nrows - 1;
    const float bsv = (t < nrows) ? c.in[I_BS][(layer * NH + hh) * 128 + t] : 0.f;
#pragma unroll 1
    for (int half = 0; half < 2; ++half) {
        float acc[32];
#pragma unroll
        for (int i = 0; i < 32; ++i) acc[i] = 0.f;
#pragma unroll 1
        for (int s = 0; s <= smax; ++s) {
            const float w = (s <= t && t < nrows) ? wrow[s] : 0.f;
            const LAS f32x4* vp = (const LAS f32x4*)(vr + s * 260 + hh * 64 + half * 32);
#pragma unroll
            for (int i = 0; i < 8; ++i) { const f32x4 v = vp[i]; acc[4 * i] += w * v[0]; acc[4 * i + 1] += w * v[1]; acc[4 * i + 2] += w * v[2]; acc[4 * i + 3] += w * v[3]; }
        }
        if (t < nrows) {
            const u32x4* up = (const u32x4*)(Z + (row0 + t) * NZ + ZC_CU + hh * 64 + half * 32);
            u32x4* mp = (u32x4*)(c.MIX() + (row0 + t) * DM + 512 + hh * 64 + half * 32);
#pragma unroll
            for (int i = 0; i < 4; ++i) { float uf[8]; unpack8(up[i], uf); float o[8];
#pragma unroll
                for (int e = 0; e < 8; ++e) o[e] = gelu_tanh(uf[e]) * (acc[8 * i + e] + bsv);
                u32x4 w; w.x = pk2(o[0], o[1]); w.y = pk2(o[2], o[3]); w.z = pk2(o[4], o[5]); w.w = pk2(o[6], o[7]); mp[i] = w; }
        }
    }
    __syncthreads();
}

constexpr int L_A0 = 0, L_A1 = 4096, L_A2 = 8192, L_A3 = 12288, L_HB = 16384, L_SC = 20480;
struct RecIO {
    const float* st_in;
    const float* n_in; const float* m_in;
    float* st_out; float* n_out; float* m_out; float* b_out;
    bool native_in, native_out;
};
template <bool OUT> DEVI void mlstm_item(const Ctx& c, int layer, int hh, size_t row0, int nt, const RecIO& io, float m_init) {
    LAS float* L = (LAS float*)c.lds; const bf16_t* Z = c.Z(); const int tid = c.tid, v = tid >> 3, g = tid & 7;
    float C[8], n[8], m;
    if (io.st_in) { const f32x4 a = *(const f32x4*)(io.st_in + tid * 8), b = *(const f32x4*)(io.st_in + tid * 8 + 4); C[0] = a[0]; C[1] = a[1]; C[2] = a[2]; C[3] = a[3]; C[4] = b[0]; C[5] = b[1]; C[6] = b[2]; C[7] = b[3];
        const f32x4 na = *(const f32x4*)(io.n_in + g * 8), nb = *(const f32x4*)(io.n_in + g * 8 + 4); n[0] = na[0]; n[1] = na[1]; n[2] = na[2]; n[3] = na[3]; n[4] = nb[0]; n[5] = nb[1]; n[6] = nb[2]; n[7] = nb[3]; m = io.m_in[0]; }
    else {
#pragma unroll
        for (int j = 0; j < 8; ++j) { C[j] = 0.f; n[j] = 0.f; } m = m_init; }
    float bsum = 0.f;
    const float gbi = c.in[I_BI][layer * 4 + hh], gbf = c.in[I_BF][layer * 4 + hh];
    for (int seg = 0; seg < nt; seg += 64) {
        const int ns = (nt - seg) < 64 ? (nt - seg) : 64;
        __syncthreads();
        { const int tt = tid >> 3;
          if (tt < ns) { const size_t zr = (row0 + seg + tt) * NZ + hh * 64 + g * 8; float f[8];
            if (OUT) { unpack8(*(const u32x4*)(Z + zr + ZC_BQ), f); *(LAS f32x4*)(L + L_A0 + tt * 64 + g * 8) = (f32x4){f[0], f[1], f[2], f[3]}; *(LAS f32x4*)(L + L_A0 + tt * 64 + g * 8 + 4) = (f32x4){f[4], f[5], f[6], f[7]}; }
            unpack8(*(const u32x4*)(Z + zr + ZC_BK), f); *(LAS f32x4*)(L + L_A1 + tt * 64 + g * 8) = (f32x4){f[0], f[1], f[2], f[3]} * 0.125f; *(LAS f32x4*)(L + L_A1 + tt * 64 + g * 8 + 4) = (f32x4){f[4], f[5], f[6], f[7]} * 0.125f;
            unpack8(*(const u32x4*)(Z + zr + ZC_BV), f); *(LAS f32x4*)(L + L_A2 + tt * 64 + g * 8) = (f32x4){f[0], f[1], f[2], f[3]}; *(LAS f32x4*)(L + L_A2 + tt * 64 + g * 8 + 4) = (f32x4){f[4], f[5], f[6], f[7]}; }
          if (tid < ns) { L[L_SC + tid] = bf2f(Z[(row0 + seg + tid) * NZ + ZC_GI + hh]) + gbi; L[L_SC + 64 + tid] = log_sigmoid(bf2f(Z[(row0 + seg + tid) * NZ + ZC_GF + hh]) + gbf); } }
        __syncthreads();
#pragma unroll 2
        for (int tt = 0; tt < ns; ++tt) {
            const float ii = L[L_SC + tt], lf = L[L_SC + 64 + tt];
            const float mn = fmaxf(lf + m, ii);
            const float a = __expf(lf + m - mn), bb = __expf(ii - mn);
            bsum += lf; m = mn;
            const float bv = bb * L[L_A2 + tt * 64 + v];
            const f32x4 k0 = *(const LAS f32x4*)(L + L_A1 + tt * 64 + g * 8), k1 = *(const LAS f32x4*)(L + L_A1 + tt * 64 + g * 8 + 4);
            const float kk[8] = {k0[0], k0[1], k0[2], k0[3], k1[0], k1[1], k1[2], k1[3]};
#pragma unroll
            for (int j = 0; j < 8; ++j) { C[j] = a * C[j] + bv * kk[j]; n[j] = a * n[j] + bb * kk[j]; }
            if (OUT) {
                const f32x4 q0 = *(const LAS f32x4*)(L + L_A0 + tt * 64 + g * 8), q1 = *(const LAS f32x4*)(L + L_A0 + tt * 64 + g * 8 + 4);
                const float qq[8] = {q0[0], q0[1], q0[2], q0[3], q1[0], q1[1], q1[2], q1[3]};
                float num = 0.f, nq = 0.f;
#pragma unroll
                for (int j = 0; j < 8; ++j) { num += C[j] * qq[j]; nq += n[j] * qq[j]; }
                num = sum8(num); nq = sum8(nq);
                const float den = fmaxf(fabsf(nq), __expf(-mn));
                if (g == 0) L[L_HB + tt * 64 + v] = num / den;
            }
        }
        if (OUT) {
            __syncthreads();
            const int tt = tid >> 3;
            if (tt < ns) {
                const f32x4 h0 = *(const LAS f32x4*)(L + L_HB + tt * 64 + g * 8), h1 = *(const LAS f32x4*)(L + L_HB + tt * 64 + g * 8 + 4);
                float hv[8] = {h0[0], h0[1], h0[2], h0[3], h1[0], h1[1], h1[2], h1[3]}; float ss = 0.f;
#pragma unroll
                for (int j = 0; j < 8; ++j) ss += hv[j] * hv[j];
                ss = sum8(ss);
                const float rs = rsqrtf(ss * (1.0f / 64.0f) + EPSN);
                const float* gm = c.in[I_GML] + layer * 256 + hh * 64 + g * 8; float bo[8];
                unpack8(*(const u32x4*)(Z + (row0 + seg + tt) * NZ + ZC_BO + hh * 64 + g * 8), bo); float o[8];
#pragma unroll
                for (int j = 0; j < 8; ++j) o[j] = sigmoidf_(bo[j]) * (hv[j] * rs * gm[j]);
                u32x4 w; w.x = pk2(o[0], o[1]); w.y = pk2(o[2], o[3]); w.z = pk2(o[4], o[5]); w.w = pk2(o[6], o[7]);
                *(u32x4*)(c.MIX() + (row0 + seg + tt) * DM + 256 + hh * 64 + g * 8) = w;
            }
        }
    }
    if (io.st_out) { *(f32x4*)(io.st_out + tid * 8) = (f32x4){C[0], C[1], C[2], C[3]}; *(f32x4*)(io.st_out + tid * 8 + 4) = (f32x4){C[4], C[5], C[6], C[7]};
        if (v == 0) { *(f32x4*)(io.n_out + g * 8) = (f32x4){n[0], n[1], n[2], n[3]}; *(f32x4*)(io.n_out + g * 8 + 4) = (f32x4){n[4], n[5], n[6], n[7]}; }
        if (tid == 0) { io.m_out[0] = m; if (io.b_out) io.b_out[0] = bsum; } }
    __syncthreads();
}
DEVI float hgrn_lb(const Ctx& c, int layer, int col) {
    if (layer == 0) return 0.f;
    const float a = c.in[I_LB][col], b = c.in[I_LB][256 + col]; const float mx = fmaxf(a, b); const float ea = __expf(a - mx), eb = __expf(b - mx);
    return eb * frcp(ea + eb);
}
DEVI void hgrn_lb8(const Ctx& c, int layer, int col0, float* out) {
    if (layer == 0) {
#pragma unroll
        for (int j = 0; j < 8; ++j) out[j] = 0.f;
        return; }
    const float* lb = c.in[I_LB];
    const f32x4 a0 = *(const f32x4*)(lb + col0), a1 = *(const f32x4*)(lb + col0 + 4), b0 = *(const f32x4*)(lb + 256 + col0), b1 = *(const f32x4*)(lb + 256 + col0 + 4);
#pragma unroll
    for (int j = 0; j < 8; ++j) { const float a = j < 4 ? a0[j & 3] : a1[j & 3], b = j < 4 ? b0[j & 3] : b1[j & 3]; const float mx = fmaxf(a, b); const float ea = __expf(a - mx), eb = __expf(b - mx); out[j] = eb * frcp(ea + eb); }
}
template <bool OUT> DEVI void hgrn_item(const Ctx& c, int layer, int hh, size_t row0, int nt, const RecIO& io) {
    LAS float* L = (LAS float*)c.lds; const bf16_t* Z = c.Z(); const int tid = c.tid, v = tid >> 3, g = tid & 7;
    float S[8], fs[8];
#pragma unroll
    for (int j = 0; j < 8; ++j) { fs[j] = 0.f;
        S[j] = io.st_in ? (io.native_in ? io.st_in[tid * 8 + j] : io.st_in[(g * 8 + j) * 64 + v]) : 0.f; }
    float lbv[8], llb[8], l1m[8];
    {
        hgrn_lb8(c, layer, hh * 64 + g * 8, lbv);
#pragma unroll
        for (int j = 0; j < 8; ++j) { llb[j] = __logf(fmaxf(lbv[j], 1e-30f)); l1m[j] = __logf(1.0f - lbv[j]); }
    }
    for (int seg = 0; seg < nt; seg += 64) {
        const int ns = (nt - seg) < 64 ? (nt - seg) : 64;
        __syncthreads();
        { const int tt = tid >> 3;
          if (tt < ns) { const size_t zr = (row0 + seg + tt) * NZ + hh * 64 + g * 8; float f[8];
            if (OUT) { unpack8(*(const u32x4*)(Z + zr + ZC_DQ), f); *(LAS f32x4*)(L + L_A0 + tt * 64 + g * 8) = (f32x4){f[0], f[1], f[2], f[3]}; *(LAS f32x4*)(L + L_A0 + tt * 64 + g * 8 + 4) = (f32x4){f[4], f[5], f[6], f[7]}; }
            unpack8(*(const u32x4*)(Z + zr + ZC_DF), f); float ff[8], kd[8];
#pragma unroll
            for (int j = 0; j < 8; ++j) { const float x1 = llb[j], x2 = l1m[j] + log_sigmoid(f[j]); const float mx = fmaxf(x1, x2); const float lfd = mx + log1pexp_neg(fabsf(x1 - x2));
                ff[j] = lfd; kd[j] = (1.0f - lbv[j]) * sigmoidf_(-f[j]); }
            *(LAS f32x4*)(L + L_A1 + tt * 64 + g * 8) = (f32x4){ff[0], ff[1], ff[2], ff[3]}; *(LAS f32x4*)(L + L_A1 + tt * 64 + g * 8 + 4) = (f32x4){ff[4], ff[5], ff[6], ff[7]};
            *(LAS f32x4*)(L + L_A2 + tt * 64 + g * 8) = (f32x4){kd[0], kd[1], kd[2], kd[3]}; *(LAS f32x4*)(L + L_A2 + tt * 64 + g * 8 + 4) = (f32x4){kd[4], kd[5], kd[6], kd[7]};
            unpack8(*(const u32x4*)(Z + zr + ZC_DI), f); *(LAS f32x4*)(L + L_A3 + tt * 64 + g * 8) = (f32x4){f[0], f[1], f[2], f[3]}; *(LAS f32x4*)(L + L_A3 + tt * 64 + g * 8 + 4) = (f32x4){f[4], f[5], f[6], f[7]}; } }
        __syncthreads();
#pragma unroll 2
        for (int tt = 0; tt < ns; ++tt) {
            const float vv = L[L_A3 + tt * 64 + v];
            const f32x4 f0 = *(const LAS f32x4*)(L + L_A1 + tt * 64 + g * 8), f1 = *(const LAS f32x4*)(L + L_A1 + tt * 64 + g * 8 + 4);
            const f32x4 k0 = *(const LAS f32x4*)(L + L_A2 + tt * 64 + g * 8), k1 = *(const LAS f32x4*)(L + L_A2 + tt * 64 + g * 8 + 4);
            const float lf[8] = {f0[0], f0[1], f0[2], f0[3], f1[0], f1[1], f1[2], f1[3]}; const float kk[8] = {k0[0], k0[1], k0[2], k0[3], k1[0], k1[1], k1[2], k1[3]};
#pragma unroll
            for (int j = 0; j < 8; ++j) { fs[j] += lf[j]; S[j] = __expf(lf[j]) * S[j] + kk[j] * vv; }
            if (OUT) {
                const f32x4 q0 = *(const LAS f32x4*)(L + L_A0 + tt * 64 + g * 8), q1 = *(const LAS f32x4*)(L + L_A0 + tt * 64 + g * 8 + 4);
                const float qq[8] = {q0[0], q0[1], q0[2], q0[3], q1[0], q1[1], q1[2], q1[3]};
                float o = 0.f;
#pragma unroll
                for (int j = 0; j < 8; ++j) o += qq[j] * S[j];
                o = sum8(o);
                if (g == 0) L[L_HB + tt * 64 + v] = o;
            }
        }
        if (OUT) {
            __syncthreads();
            const int tt = tid >> 3;
            if (tt < ns) {
                const f32x4 h0 = *(const LAS f32x4*)(L + L_HB + tt * 64 + g * 8), h1 = *(const LAS f32x4*)(L + L_HB + tt * 64 + g * 8 + 4);
                float hv[8] = {h0[0], h0[1], h0[2], h0[3], h1[0], h1[1], h1[2], h1[3]}; float ss = 0.f;
#pragma unroll
                for (int j = 0; j < 8; ++j) ss += hv[j] * hv[j];
                ss = sum8(ss);
                const float rs = rsqrtf(ss * (1.0f / 64.0f) + EPSN);
                const float* gm = c.in[I_GHG] + layer * 256 + hh * 64 + g * 8; float dg[8];
                unpack8(*(const u32x4*)(Z + (row0 + seg + tt) * NZ + ZC_DG + hh * 64 + g * 8), dg); float o[8];
#pragma unroll
                for (int j = 0; j < 8; ++j) o[j] = (hv[j] * rs * gm[j]) * (dg[j] * sigmoidf_(dg[j]));
                u32x4 w; w.x = pk2(o[0], o[1]); w.y = pk2(o[2], o[3]); w.z = pk2(o[4], o[5]); w.w = pk2(o[6], o[7]);
                *(u32x4*)(c.MIX() + (row0 + seg + tt) * DM + 768 + hh * 64 + g * 8) = w;
            }
        }
    }
    if (io.st_out) {
#pragma unroll
        for (int j = 0; j < 8; ++j) { if (io.native_out) io.st_out[tid * 8 + j] = S[j]; else io.st_out[(g * 8 + j) * 64 + v] = S[j]; }
        if (io.b_out && v == 0) {
#pragma unroll
            for (int j = 0; j < 8; ++j) io.b_out[g * 8 + j] = __expf(fs[j]); } }
    __syncthreads();
}

constexpr int RSTG = 128 * 144;
DEVI bf16x8_t pack8(const float* f) { union { u32x4 u; bf16x8_t v; } r; r.u.x = pk2(f[0], f[1]); r.u.y = pk2(f[2], f[3]); r.u.z = pk2(f[4], f[5]); r.u.w = pk2(f[6], f[7]); return r.v; }
DEVI bf16x8_t pack8v(const f32x4 a, const f32x4 b) { union { u32x4 u; bf16x8_t v; } r; r.u.x = pk2(a[0], a[1]); r.u.y = pk2(a[2], a[3]); r.u.z = pk2(b[0], b[1]); r.u.w = pk2(b[2], b[3]); return r.v; }
struct StageRegs { u32x4 v[2]; };
DEVI StageRegs stage_load(const bf16_t* src  , int tid) {
    StageRegs r; const int tt = tid >> 2, ch = tid & 3;
#pragma unroll
    for (int e = 0; e < 2; ++e) r.v[e] = *(const u32x4*)(src + (size_t)tt * NZ + 8 * (2 * ch + e));
    return r;
}
DEVI void stage_store(LAS unsigned char* stage, const StageRegs& r, int tid) {
    const int tt = tid >> 2, ch = tid & 3;
#pragma unroll
    for (int e = 0; e < 2; ++e) *(LAS u32x4*)(stage + tt * 144 + (2 * ch + e) * 16) = r.v[e];
}
struct GateRegs { unsigned short gi0, gi1, gf0, gf1; float bi, bfv; };
DEVI GateRegs gate_load(const Ctx& c, int layer, size_t row0, int hh) {
    GateRegs g; const bf16_t* Z = c.Z(); const size_t r0 = (row0 + 2 * c.lane) * NZ, r1 = r0 + NZ;
    g.gi0 = Z[r0 + ZC_GI + hh]; g.gi1 = Z[r1 + ZC_GI + hh]; g.gf0 = Z[r0 + ZC_GF + hh]; g.gf1 = Z[r1 + ZC_GF + hh]; g.bi = c.in[I_BI][layer * 4 + hh]; g.bfv = c.in[I_BF][layer * 4 + hh]; return g;
}
DEVI void mlstm_scalars(const Ctx& c, LAS float* F, const GateRegs& gr, float mprev) {
    if (c.wave == 0) {
        const int lane = c.lane;
        const float i0 = bf2f(gr.gi0) + gr.bi, i1 = bf2f(gr.gi1) + gr.bi, l0 = log_sigmoid(bf2f(gr.gf0) + gr.bfv), l1 = log_sigmoid(bf2f(gr.gf1) + gr.bfv);
        float inc = l0 + l1;
#pragma unroll
        for (int o = 1; o < 64; o <<= 1) { const float y = shfl_up_f(inc, o); if (lane >= o) inc += y; }
        const float b0 = inc - l1, b1 = inc, u0 = i0 - b0, u1 = i1 - b1;
        float mxs = fmaxf(u0, u1);
#pragma unroll
        for (int o = 1; o < 64; o <<= 1) { const float y = shfl_up_f(mxs, o); if (lane >= o) mxs = fmaxf(mxs, y); }
        float ex = shfl_up_f(mxs, 1); if (lane == 0) ex = NEGV;
        const float c0 = fmaxf(ex, u0), c1 = fmaxf(c0, u1);
        F[2 * lane] = b0; F[2 * lane + 1] = b1; F[128 + 2 * lane] = u0; F[128 + 2 * lane + 1] = u1; F[256 + 2 * lane] = fmaxf(b0 + mprev, b0 + c0); F[256 + 2 * lane + 1] = fmaxf(b1 + mprev, b1 + c1);
        if (lane == 63) { F[704] = b1; F[705] = mxs; }
    }
    __syncthreads();
}
constexpr int ML_V = 0, ML_K = RSTG, ML_F = 2 * RSTG, ML_P = ML_F + 4096;
DEVI void mlstm_chunk_state(const Ctx& c, int layer, int hh, size_t row0, float* Uout, float* nout, float* mout, float* bout) {
    LAS unsigned char* VS = c.lds + ML_V; LAS unsigned char* KS = c.lds + ML_K; LAS float* F = (LAS float*)(c.lds + ML_F); LAS float* NP_ = (LAS float*)(c.lds + ML_P);
    const bf16_t* Z = c.Z(); const int tid = c.tid, lane = c.lane, i = lane & 15, gq = lane >> 4;
    const StageRegs vreg = stage_load(Z + row0 * NZ + ZC_BV + hh * 64, tid), kreg = stage_load(Z + row0 * NZ + ZC_BK + hh * 64, tid);
    GateRegs gr{}; if (c.wave == 0) gr = gate_load(c, layer, row0, hh);
    __syncthreads();
    stage_store(VS, vreg, tid);
    mlstm_scalars(c, F, gr, 0.f);
    const float bL = F[704], umax = F[705];
    { const int tt = tid >> 2, ch = tid & 3; const float wsc = 0.125f * __expf(F[128 + tt] - umax);
#pragma unroll
      for (int e = 0; e < 2; ++e) { float f[8]; unpack8(kreg.v[e], f);
#pragma unroll
          for (int j = 0; j < 8; ++j) f[j] *= wsc;
          union { u32x4 u; bf16x8_t v; } pk; pk.v = pack8(f); *(LAS u32x4*)(KS + tt * 144 + (2 * ch + e) * 16) = pk.u; } }
    __syncthreads();
    { const int mt = c.wave >> 1, nt0 = 2 * (c.wave & 1);
      f32x4 acc0 = (f32x4){0.f, 0.f, 0.f, 0.f}, acc1 = acc0;
#pragma unroll
      for (int ks = 0; ks < 4; ++ks) { const bf16x8_t vf = lds_tfrag(VS, ks, 16 * mt + i, gq), k0 = lds_tfrag(KS, ks, 16 * nt0 + i, gq), k1 = lds_tfrag(KS, ks, 16 * (nt0 + 1) + i, gq);
          acc0 = __builtin_amdgcn_mfma_f32_16x16x32_bf16(vf, k0, acc0, 0, 0, 0); acc1 = __builtin_amdgcn_mfma_f32_16x16x32_bf16(vf, k1, acc1, 0, 0, 0); }
#pragma unroll
      for (int r = 0; r < 4; ++r) { Uout[(16 * mt + 4 * gq + r) * 64 + 16 * nt0 + i] = acc0[r]; Uout[(16 * mt + 4 * gq + r) * 64 + 16 * (nt0 + 1) + i] = acc1[r]; } }
    { const int k = tid & 63, part = tid >> 6; float sum = 0.f;
#pragma unroll
      for (int s = 0; s < 16; ++s) sum += bf2f(*(const LAS unsigned short*)(KS + (16 * part + s) * 144 + k * 2));
      NP_[part * 64 + k] = sum; }
    __syncthreads();
    if (tid < 64) { float sum = 0.f;
#pragma unroll
        for (int p8 = 0; p8 < 8; ++p8) sum += NP_[p8 * 64 + tid];
        nout[tid] = sum; }
    if (tid == 0) { mout[0] = bL + umax; bout[0] = bL; }
}
DEVI void mlstm_chunk_out(const Ctx& c, int layer, int hh, size_t row0, const float* Cp, const float* np, const float* mp_) {
    LAS unsigned char* VS = c.lds + ML_V; LAS float* F = (LAS float*)(c.lds + ML_F);
    const bf16_t* Z = c.Z(); const int tid = c.tid, lane = c.lane, i = lane & 15, gq = lane >> 4, w = c.wave;
    const int t = 16 * w + i;
    const StageRegs vreg = stage_load(Z + row0 * NZ + ZC_BV + hh * 64, tid);
    GateRegs gr{}; if (w == 0) gr = gate_load(c, layer, row0, hh);
    const float npv = (tid >= 128 && tid < 192) ? np[tid - 128] : 0.f;
    const float mprev = mp_[0];
    bf16x8_t qf[2], kfr[8][2];
    { const bf16_t* qp = Z + (row0 + t) * NZ + ZC_BQ + hh * 64 + 8 * gq; qf[0] = *(const bf16x8_t*)qp; qf[1] = *(const bf16x8_t*)(qp + 32); }
#pragma unroll
    for (int kt = 0; kt < 8; ++kt) if (kt <= w) { const bf16_t* kp = Z + (row0 + 16 * kt + i) * NZ + ZC_BK + hh * 64 + 8 * gq; kfr[kt][0] = *(const bf16x8_t*)kp; kfr[kt][1] = *(const bf16x8_t*)(kp + 32); }
    __syncthreads();
    stage_store(VS, vreg, tid);
    if (tid >= 128 && tid < 192) F[640 + tid - 128] = npv;
    mlstm_scalars(c, F, gr, mprev);
    u32x2 bog[4]; f32x4 gmv[4];
#pragma unroll
    for (int dt = 0; dt < 4; ++dt) { const int col = hh * 64 + 16 * dt + 4 * gq; gmv[dt] = *(const f32x4*)(c.in[I_GML] + layer * 256 + col); bog[dt] = *(const u32x2*)(Z + (row0 + t) * NZ + ZC_BO + col); }
    const float bt = F[t], mt_ = F[256 + t], wt = bt - mt_, gI = __expf(bt + mprev - mt_);
    f32x4 s[8]; float nqi = 0.f;
#pragma unroll
    for (int kt = 0; kt < 8; ++kt) {
        s[kt] = (f32x4){0.f, 0.f, 0.f, 0.f};
        if (kt <= w) {
            f32x4 a = (f32x4){0.f, 0.f, 0.f, 0.f};
            a = __builtin_amdgcn_mfma_f32_16x16x32_bf16(kfr[kt][0], qf[0], a, 0, 0, 0);
            a = __builtin_amdgcn_mfma_f32_16x16x32_bf16(kfr[kt][1], qf[1], a, 0, 0, 0);
            const f32x4 uu = *(const LAS f32x4*)(F + 128 + 16 * kt + 4 * gq);
#pragma unroll
            for (int r = 0; r < 4; ++r) { const bool valid = (16 * kt + 4 * gq + r) <= t; const float val = a[r] * 0.125f * __expf(valid ? uu[r] + wt : NEGV); a[r] = val; nqi += val; }
            s[kt] = a;
        }
    }
    nqi += shfl_xor_f(nqi, 16); nqi += shfl_xor_f(nqi, 32);
    f32x4 cpr[4][2][2];
#pragma unroll
    for (int dt = 0; dt < 4; ++dt)
#pragma unroll
        for (int ks = 0; ks < 2; ++ks) { const float* cp = Cp + (16 * dt + i) * 64 + 32 * ks + 8 * gq; cpr[dt][ks][0] = *(const f32x4*)cp; cpr[dt][ks][1] = *(const f32x4*)(cp + 4); }
    f32x4 o[4], oi[4];
#pragma unroll
    for (int dt = 0; dt < 4; ++dt) { o[dt] = (f32x4){0.f, 0.f, 0.f, 0.f}; oi[dt] = o[dt]; }
#pragma unroll
    for (int ks = 0; ks < 4; ++ks) {
        if (2 * ks <= w) {
            const bf16x8_t pf = pack8v(s[2 * ks], s[2 * ks + 1]);
#pragma unroll
            for (int dt = 0; dt < 4; ++dt) o[dt] = __builtin_amdgcn_mfma_f32_16x16x32_bf16(lds_tfrag(VS, ks, 16 * dt + i, gq), pf, o[dt], 0, 0, 0);
        }
    }
#pragma unroll
    for (int dt = 0; dt < 4; ++dt)
#pragma unroll
        for (int ks = 0; ks < 2; ++ks) oi[dt] = __builtin_amdgcn_mfma_f32_16x16x32_bf16(pack8v(cpr[dt][ks][0], cpr[dt][ks][1]), qf[ks], oi[dt], 0, 0, 0);
    float nqn = 0.f;
#pragma unroll
    for (int ks = 0; ks < 2; ++ks) { float qv[8]; union { u32x4 u; bf16x8_t v; } qq; qq.v = qf[ks]; unpack8(qq.u, qv);
#pragma unroll
        for (int j = 0; j < 8; ++j) nqn += qv[j] * F[640 + 32 * ks + 8 * gq + j]; }
    nqn += shfl_xor_f(nqn, 16); nqn += shfl_xor_f(nqn, 32);
    const float nq = nqi + gI * nqn, inv = frcp(fmaxf(fabsf(nq), __expf(-mt_)));
    float ss = 0.f;
#pragma unroll
    for (int dt = 0; dt < 4; ++dt) { o[dt] = (o[dt] + oi[dt] * gI) * inv; ss += (o[dt][0] * o[dt][0] + o[dt][1] * o[dt][1]) + (o[dt][2] * o[dt][2] + o[dt][3] * o[dt][3]); }
    ss += shfl_xor_f(ss, 16); ss += shfl_xor_f(ss, 32);
    const float rs = rsqrtf(ss * (1.0f / 64.0f) + EPSN);
#pragma unroll
    for (int dt = 0; dt < 4; ++dt) { const int col = hh * 64 + 16 * dt + 4 * gq; const f32x4 gm = gmv[dt]; const u32x2 bo = bog[dt];
        const float r0 = sigmoidf_(bflo(bo.x)) * (o[dt][0] * rs * gm[0]), r1 = sigmoidf_(bfhi(bo.x)) * (o[dt][1] * rs * gm[1]), r2 = sigmoidf_(bflo(bo.y)) * (o[dt][2] * rs * gm[2]), r3 = sigmoidf_(bfhi(bo.y)) * (o[dt][3] * rs * gm[3]);
        u32x2 wv; wv.x = pk2(r0, r1); wv.y = pk2(r2, r3); *(u32x2*)(c.MIX() + (row0 + t) * DM + 256 + col) = wv; }
}
constexpr int HG_V = 0, HG_K = RSTG, HG_BC = 2 * RSTG, HG_SEG = HG_BC + 32768;
DEVI void hgrn_logf_kd(float lbv, float llb, float l1m, float df, float& lfd, float& kd) {
    const float x2 = l1m + log_sigmoid(df), mx = fmaxf(llb, x2); lfd = mx + log1pexp_neg(fabsf(llb - x2)); kd = (1.0f - lbv) * sigmoidf_(-df);
}
struct DecayRegs { unsigned short df[16]; float lbv; };
DEVI DecayRegs decay_load(const Ctx& c, int layer, int hh, size_t row0) {
    DecayRegs r; const bf16_t* Z = c.Z(); const int d = c.tid & 63, seg = c.tid >> 6;
#pragma unroll
    for (int tt = 0; tt < 16; ++tt) r.df[tt] = Z[(row0 + 16 * seg + tt) * NZ + ZC_DF + hh * 64 + d];
    r.lbv = hgrn_lb(c, layer, hh * 64 + d); return r;
}
DEVI void hgrn_cumdecay(const Ctx& c, const DecayRegs& dr) {
    LAS float* BC = (LAS float*)(c.lds + HG_BC); LAS float* SEG = (LAS float*)(c.lds + HG_SEG);
    const int d = c.tid & 63, seg = c.tid >> 6; const float lbv = dr.lbv, llb = __logf(fmaxf(lbv, 1e-30f)), l1m = __logf(1.0f - lbv);
    float run = 0.f;
#pragma unroll
    for (int tt = 0; tt < 16; ++tt) { const int t = 16 * seg + tt; float lfd, kd; hgrn_logf_kd(lbv, llb, l1m, bf2f(dr.df[tt]), lfd, kd); run += lfd; BC[t * 64 + d] = run; }
    SEG[seg * 64 + d] = run;
    __syncthreads();
    float off = 0.f;
    for (int s2 = 0; s2 < seg; ++s2) off += SEG[s2 * 64 + d];
#pragma unroll 4
    for (int tt = 0; tt < 16; ++tt) BC[(16 * seg + tt) * 64 + d] += off;
    __syncthreads();
}
DEVI void hgrn_chunk_state(const Ctx& c, int layer, int hh, size_t row0, float* Uout  , float* dec_out) {
    LAS unsigned char* VS = c.lds + HG_V; LAS unsigned char* KS = c.lds + HG_K; LAS float* BC = (LAS float*)(c.lds + HG_BC);
    const bf16_t* Z = c.Z(); const int tid = c.tid, lane = c.lane, i = lane & 15, gq = lane >> 4;
    const StageRegs vreg = stage_load(Z + row0 * NZ + ZC_DI + hh * 64, tid), freg = stage_load(Z + row0 * NZ + ZC_DF + hh * 64, tid);
    const DecayRegs dr = decay_load(c, layer, hh, row0);
    float lb16[2][8];
#pragma unroll
    for (int e = 0; e < 2; ++e) hgrn_lb8(c, layer, hh * 64 + 8 * (2 * (tid & 3) + e), lb16[e]);
    __syncthreads();
    stage_store(VS, vreg, tid);
    hgrn_cumdecay(c, dr);
    { const int tt = tid >> 2, ch = tid & 3;
#pragma unroll
      for (int e = 0; e < 2; ++e) { const int d0 = 8 * (2 * ch + e); float f[8]; unpack8(freg.v[e], f);
#pragma unroll
          for (int j = 0; j < 8; ++j) { const float lbv = lb16[e][j]; float lfd, kd; hgrn_logf_kd(lbv, __logf(fmaxf(lbv, 1e-30f)), __logf(1.0f - lbv), f[j], lfd, kd);
              f[j] = kd * __expf(BC[127 * 64 + d0 + j] - BC[tt * 64 + d0 + j]); }
          union { u32x4 u; bf16x8_t v; } pk; pk.v = pack8(f); *(LAS u32x4*)(KS + tt * 144 + (2 * ch + e) * 16) = pk.u; } }
    __syncthreads();
    { const int mt = c.wave >> 1, nt0 = 2 * (c.wave & 1);
      f32x4 acc0 = (f32x4){0.f, 0.f, 0.f, 0.f}, acc1 = acc0;
#pragma unroll
      for (int ks = 0; ks < 4; ++ks) { const bf16x8_t vf = lds_tfrag(VS, ks, 16 * mt + i, gq), k0 = lds_tfrag(KS, ks, 16 * nt0 + i, gq), k1 = lds_tfrag(KS, ks, 16 * (nt0 + 1) + i, gq);
          acc0 = __builtin_amdgcn_mfma_f32_16x16x32_bf16(vf, k0, acc0, 0, 0, 0); acc1 = __builtin_amdgcn_mfma_f32_16x16x32_bf16(vf, k1, acc1, 0, 0, 0); }
#pragma unroll
      for (int r = 0; r < 4; ++r) { Uout[(16 * mt + 4 * gq + r) * 64 + 16 * nt0 + i] = acc0[r]; Uout[(16 * mt + 4 * gq + r) * 64 + 16 * (nt0 + 1) + i] = acc1[r]; } }
    if (tid < 64) dec_out[tid] = __expf(BC[127 * 64 + tid]);
}
DEVI void hgrn_chunk_out(const Ctx& c, int layer, int hh, size_t row0, const float* Sst  ) {
    LAS unsigned char* VS = c.lds + HG_V; LAS float* BC = (LAS float*)(c.lds + HG_BC);
    const bf16_t* Z = c.Z(); const int tid = c.tid, lane = c.lane, i = lane & 15, gq = lane >> 4, w = c.wave;
    const int t = 16 * w + i;
    const StageRegs vreg = stage_load(Z + row0 * NZ + ZC_DI + hh * 64, tid);
    const DecayRegs dr = decay_load(c, layer, hh, row0);
    u32x4 qraw[2], dfr[8][2]; f32x4 spr[4][2][2]; u32x2 dgg[4]; f32x4 gmv[4];
#pragma unroll
    for (int ks = 0; ks < 2; ++ks) qraw[ks] = *(const u32x4*)(Z + (row0 + t) * NZ + ZC_DQ + hh * 64 + 32 * ks + 8 * gq);
#pragma unroll
    for (int kt = 0; kt < 8; ++kt) if (kt <= w) {
#pragma unroll
        for (int ks = 0; ks < 2; ++ks) dfr[kt][ks] = *(const u32x4*)(Z + (row0 + 16 * kt + i) * NZ + ZC_DF + hh * 64 + 32 * ks + 8 * gq); }
    float oml[2][8]; bf16x8_t qf1[2], qf2[2];
#pragma unroll
    for (int ks = 0; ks < 2; ++ks) { hgrn_lb8(c, layer, hh * 64 + 32 * ks + 8 * gq, oml[ks]);
#pragma unroll
        for (int j = 0; j < 8; ++j) oml[ks][j] = 1.0f - oml[ks][j]; }
    __syncthreads();
    stage_store(VS, vreg, tid);
    hgrn_cumdecay(c, dr);
#pragma unroll
    for (int ks = 0; ks < 2; ++ks) { float qv[8]; unpack8(qraw[ks], qv); float q1[8], q2[8];
        const f32x4 b0 = *(const LAS f32x4*)(BC + t * 64 + 32 * ks + 8 * gq), b1 = *(const LAS f32x4*)(BC + t * 64 + 32 * ks + 8 * gq + 4);
        f32x4 r0 = (f32x4){0.f, 0.f, 0.f, 0.f}, r1 = r0;
        if (w > 0) { r0 = *(const LAS f32x4*)(BC + (16 * w - 1) * 64 + 32 * ks + 8 * gq); r1 = *(const LAS f32x4*)(BC + (16 * w - 1) * 64 + 32 * ks + 8 * gq + 4); }
#pragma unroll
        for (int j = 0; j < 8; ++j) { const float bj = j < 4 ? b0[j] : b1[j - 4], rj = j < 4 ? r0[j] : r1[j - 4];
            q1[j] = qv[j] * oml[ks][j] * __expf(bj - rj); q2[j] = qv[j] * __expf(bj); }
        qf1[ks] = pack8(q1); qf2[ks] = pack8(q2); }
    f32x4 s[8];
#pragma unroll
    for (int kt = 0; kt < 8; ++kt) {
        s[kt] = (f32x4){0.f, 0.f, 0.f, 0.f};
        if (kt <= w) {
            const int sk = 16 * kt + i; f32x4 a = (f32x4){0.f, 0.f, 0.f, 0.f};
#pragma unroll
            for (int ks = 0; ks < 2; ++ks) { float f[8]; unpack8(dfr[kt][ks], f);
                const f32x4 b0 = *(const LAS f32x4*)(BC + sk * 64 + 32 * ks + 8 * gq), b1 = *(const LAS f32x4*)(BC + sk * 64 + 32 * ks + 8 * gq + 4);
                f32x4 r0 = (f32x4){0.f, 0.f, 0.f, 0.f}, r1 = r0;
                if (w > 0) { r0 = *(const LAS f32x4*)(BC + (16 * w - 1) * 64 + 32 * ks + 8 * gq); r1 = *(const LAS f32x4*)(BC + (16 * w - 1) * 64 + 32 * ks + 8 * gq + 4); }
#pragma unroll
                for (int j = 0; j < 8; ++j) { const float bj = j < 4 ? b0[j] : b1[j - 4], rj = j < 4 ? r0[j] : r1[j - 4]; f[j] = sigmoidf_(-f[j]) * __expf(fminf(rj - bj, 80.f)); }
                a = __builtin_amdgcn_mfma_f32_16x16x32_bf16(pack8(f), qf1[ks], a, 0, 0, 0); }
#pragma unroll
            for (int r = 0; r < 4; ++r) a[r] = ((16 * kt + 4 * gq + r) <= t) ? a[r] : 0.f;
            s[kt] = a;
        }
    }
#pragma unroll
    for (int dt = 0; dt < 4; ++dt) {
#pragma unroll
        for (int ks = 0; ks < 2; ++ks) { const float* sp = Sst + (16 * dt + i) * 64 + 32 * ks + 8 * gq; spr[dt][ks][0] = *(const f32x4*)sp; spr[dt][ks][1] = *(const f32x4*)(sp + 4); }
        const int col = hh * 64 + 16 * dt + 4 * gq; gmv[dt] = *(const f32x4*)(c.in[I_GHG] + layer * 256 + col); dgg[dt] = *(const u32x2*)(Z + (row0 + t) * NZ + ZC_DG + col); }
    f32x4 o[4];
#pragma unroll
    for (int dt = 0; dt < 4; ++dt) o[dt] = (f32x4){0.f, 0.f, 0.f, 0.f};
#pragma unroll
    for (int ks = 0; ks < 4; ++ks) {
        if (2 * ks <= w) {
            const bf16x8_t pf = pack8v(s[2 * ks], s[2 * ks + 1]);
#pragma unroll
            for (int dt = 0; dt < 4; ++dt) o[dt] = __builtin_amdgcn_mfma_f32_16x16x32_bf16(lds_tfrag(VS, ks, 16 * dt + i, gq), pf, o[dt], 0, 0, 0);
        }
    }
#pragma unroll
    for (int dt = 0; dt < 4; ++dt)
#pragma unroll
        for (int ks = 0; ks < 2; ++ks) o[dt] = __builtin_amdgcn_mfma_f32_16x16x32_bf16(pack8v(spr[dt][ks][0], spr[dt][ks][1]), qf2[ks], o[dt], 0, 0, 0);
    float ss = 0.f;
#pragma unroll
    for (int dt = 0; dt < 4; ++dt) ss += (o[dt][0] * o[dt][0] + o[dt][1] * o[dt][1]) + (o[dt][2] * o[dt][2] + o[dt][3] * o[dt][3]);
    ss += shfl_xor_f(ss, 16); ss += shfl_xor_f(ss, 32);
    const float rs = rsqrtf(ss * (1.0f / 64.0f) + EPSN);
#pragma unroll
    for (int dt = 0; dt < 4; ++dt) { const int col = hh * 64 + 16 * dt + 4 * gq; const f32x4 gm = gmv[dt];
        const u32x2 dg = dgg[dt]; const float g0 = bflo(dg.x), g1 = bfhi(dg.x), g2 = bflo(dg.y), g3 = bfhi(dg.y);
        const float r0 = (o[dt][0] * rs * gm[0]) * (g0 * sigmoidf_(g0)), r1 = (o[dt][1] * rs * gm[1]) * (g1 * sigmoidf_(g1)), r2 = (o[dt][2] * rs * gm[2]) * (g2 * sigmoidf_(g2)), r3 = (o[dt][3] * rs * gm[3]) * (g3 * sigmoidf_(g3));
        u32x2 wv; wv.x = pk2(r0, r1); wv.y = pk2(r2, r3); *(u32x2*)(c.MIX() + (row0 + t) * DM + 768 + col) = wv; }
}

constexpr int GM_PITCH = 528;
DEVI void gmlp_chunk_item(const Ctx& c, int layer, size_t row0) {
    LAS unsigned char* VS = c.lds; const bf16_t* Z = c.Z(); const int lane = c.lane, i = lane & 15, gq = lane >> 4, w = c.wave, t = 16 * w + i;
    bf16x8_t wf[4][4];
    u32x2 cvr[16];
    {
        f32x4 wr[4][4][2];
#pragma unroll
        for (int hh = 0; hh < 4; ++hh)
#pragma unroll
            for (int ks = 0; ks < 4; ++ks) { const float* wp = c.in[I_WS] + ((size_t)(layer * NH + hh) * 128 + t) * 128 + 32 * ks + 4 * gq; wr[hh][ks][0] = *(const f32x4*)wp; wr[hh][ks][1] = *(const f32x4*)(wp + 16); }
#pragma unroll
        for (int rr = 0; rr < 16; ++rr) cvr[rr] = *(const u32x2*)(Z + (row0 + w * 16 + rr) * NZ + ZC_CV + 4 * lane);
#pragma unroll
        for (int hh = 0; hh < 4; ++hh)
#pragma unroll
            for (int ks = 0; ks < 4; ++ks) if (2 * ks <= w) { f32x4 w0 = wr[hh][ks][0], w1 = wr[hh][ks][1];
#pragma unroll
                for (int r = 0; r < 4; ++r) { if (32 * ks + 4 * gq + r > t) w0[r] = 0.f; if (32 * ks + 16 + 4 * gq + r > t) w1[r] = 0.f; }
                wf[hh][ks] = pack8v(w0, w1); }
    }
    __syncthreads();
    { const float* gcv = c.in[I_GCV] + layer * 256; const f32x4 gv = *(const f32x4*)(gcv + 4 * lane);
#pragma unroll
      for (int rr = 0; rr < 16; ++rr) { const u32x2 u = cvr[rr];
          const float e0 = gelu_tanh(bflo(u.x)), e1 = gelu_tanh(bfhi(u.x)), e2 = gelu_tanh(bflo(u.y)), e3 = gelu_tanh(bfhi(u.y));
          const float rs = rsqrtf(wave_sum((e0 * e0 + e1 * e1) + (e2 * e2 + e3 * e3)) * (1.0f / 256.0f) + EPSN);
          u32x2 o; o.x = pk2(e0 * rs * gv[0], e1 * rs * gv[1]); o.y = pk2(e2 * rs * gv[2], e3 * rs * gv[3]);
          *(LAS u32x2*)(VS + (w * 16 + rr) * GM_PITCH + 8 * lane) = o; } }
    __syncthreads();
    u32x2 cur4[4][4]; float bs4[4];
#pragma unroll
    for (int hh = 0; hh < 4; ++hh) {
#pragma unroll
        for (int ct = 0; ct < 4; ++ct) cur4[hh][ct] = *(const u32x2*)(Z + (row0 + t) * NZ + ZC_CU + hh * 64 + 16 * ct + 4 * gq);
        bs4[hh] = c.in[I_BS][(layer * NH + hh) * 128 + t]; }
    __builtin_amdgcn_sched_barrier(0);
#pragma unroll
    for (int hh = 0; hh < 4; ++hh) {
        const u32x2* cur = cur4[hh]; const float bsv = bs4[hh];
        f32x4 acc[4];
#pragma unroll
        for (int ct = 0; ct < 4; ++ct) acc[ct] = (f32x4){0.f, 0.f, 0.f, 0.f};
#pragma unroll
        for (int ks = 0; ks < 4; ++ks) if (2 * ks <= w) {
#pragma unroll
            for (int ct = 0; ct < 4; ++ct) acc[ct] = __builtin_amdgcn_mfma_f32_16x16x32_bf16(lds_tfrag<GM_PITCH>(VS, ks, hh * 64 + 16 * ct + i, gq), wf[hh][ks], acc[ct], 0, 0, 0);
        }
#pragma unroll
        for (int ct = 0; ct < 4; ++ct) { const u32x2 u = cur[ct];
            const float r0 = gelu_tanh(bflo(u.x)) * (acc[ct][0] + bsv), r1 = gelu_tanh(bfhi(u.x)) * (acc[ct][1] + bsv), r2 = gelu_tanh(bflo(u.y)) * (acc[ct][2] + bsv), r3 = gelu_tanh(bfhi(u.y)) * (acc[ct][3] + bsv);
            u32x2 wv; wv.x = pk2(r0, r1); wv.y = pk2(r2, r3); *(u32x2*)(c.MIX() + (row0 + t) * DM + 512 + hh * 64 + 16 * ct + 4 * gq) = wv; }
    }
}

DEVI void copy_item(const Ctx& c, int layer, int it) {
    constexpr int PER_T_P = 2 * WB * 256 / 16384  , PER_T_S = DECB * WB * 256 / 16384  ;
    const bf16_t* Z = c.Z();
    if (it < 2 * PER_T_P) {
        const int kv = it / PER_T_P, r = it % PER_T_P; float* o = c.out + (kv ? O_VWP : O_KWP) + (size_t)layer * 2 * WB * 256 + (size_t)r * 16384; const int zc = kv ? ZC_AV : ZC_AK;
        for (int i = c.tid; i < 4096; i += NTHREADS) { const size_t e = (size_t)r * 16384 + 4 * i; const int b = (int)(e / (WB * 256)), rr = (int)((e / 256) % WB), col = (int)(e % 256);
            const u32x2 u = *(const u32x2*)(Z + ((size_t)b * TSEQ + (TSEQ - WB) + rr) * NZ + zc + col); *(f32x4*)(o + 4 * i) = (f32x4){bflo(u.x), bfhi(u.x), bflo(u.y), bfhi(u.y)}; }
    } else {
        it -= 2 * PER_T_P; const int kv = it / PER_T_S, r = it % PER_T_S; float* o = c.out + (kv ? O_VWS : O_KWS) + (size_t)layer * DECB * WB * 256 + (size_t)r * 16384; const int zc = kv ? ZC_AV : ZC_AK;
        const float* src = c.in[kv ? I_CV : I_CK] + (size_t)layer * DECB * WB * 256;
        if ((r & 31) != 31) {
            const f32x4* s4 = (const f32x4*)(src + (size_t)r * 16384 + DECT * 256); f32x4* o4 = (f32x4*)o; f32x4 v[8];
#pragma unroll
            for (int k = 0; k < 8; ++k) v[k] = __builtin_nontemporal_load(s4 + c.tid + k * NTHREADS);
#pragma unroll
            for (int k = 0; k < 8; ++k) __builtin_nontemporal_store(v[k], o4 + c.tid + k * NTHREADS);
            return;
        }
        for (int i = c.tid; i < 4096; i += NTHREADS) { const size_t e = (size_t)r * 16384 + 4 * i; const int b = (int)(e / (WB * 256)), rr = (int)((e / 256) % WB), col = (int)(e % 256);
            f32x4 val;
            if (rr < WB - DECT) val = *(const f32x4*)(src + ((size_t)b * WB + rr + DECT) * 256 + col);
            else { const u32x2 u = *(const u32x2*)(Z + ((size_t)NPR + b * DECT + (rr - (WB - DECT))) * NZ + zc + col); val = (f32x4){bflo(u.x), bfhi(u.x), bflo(u.y), bfhi(u.y)}; }
            *(f32x4*)(o + 4 * i) = val; }
    }
}
constexpr int N_BIG = 2 * DECB * 8;
DEVI void big_copy_item(const Ctx& c, int layer, int it) {
    const int kv = it >> 8, b = (it >> 3) & 31, j = it & 7, n16 = (j == 7) ? 3 : 4;
    const size_t off = ((size_t)(layer * DECB + b) * WB) * 256 + (size_t)j * 4 * 16384;
    const f32x4* s4 = (const f32x4*)(c.in[kv ? I_CV : I_CK] + off + DECT * 256); f32x4* o4 = (f32x4*)(c.out + (kv ? O_VWS : O_KWS) + off);
    f32x4 v[32];
#pragma unroll
    for (int k = 0; k < 32; ++k) if (k < 8 * n16) v[k] = __builtin_nontemporal_load(s4 + c.tid + k * NTHREADS);
#pragma unroll
    for (int k = 0; k < 32; ++k) if (k < 8 * n16) __builtin_nontemporal_store(v[k], o4 + c.tid + k * NTHREADS);
}
DEVI void phase_mix_local(const Ctx& c0, int layer0, int qslot) {
    WorkQueue q; q.start(c0, (unsigned*)(c0.ws + WS_CTL) + CW_QUEUE + 64 * (2 * layer0) + 64 * 8 * qslot);
    for (;;) {
        const int pos = q.pop(c0);
        if (pos >= 2208) break;
        int it; bool big = false;
        if (pos < 64) it = 1440 + pos;
        else if (pos >= 64 + 102 * 21) { big = true; it = 510 + (pos - (64 + 102 * 21)); }
        else { const int p = pos - 64, g = p / 21, m = p % 21;
            if ((m & 3) == 3) { big = true; it = g * 5 + (m >> 2); }
            else { const int nb = g * 16 + m - ((m + 1) >> 2);
                if (nb < 416) it = nb;
                else { const int p2 = nb - 416, g2 = p2 / 19, m2 = p2 % 19; it = (m2 < 16) ? 416 + g2 * 16 + m2 : 1504 + g2 * 3 + (m2 - 16); } } }
        const Ctx c = relaunder(c0); int layer = layer0; asm volatile("" : "+s"(layer));
        float* MU = (float*)(c.ws + WS_MU); float* HU = (float*)(c.ws + WS_HU);
        if (big || it >= 256) q.prefetch(c);
        if (big) big_copy_item(c, layer, it);
        else if (it < 256) { const int itu = __builtin_amdgcn_readfirstlane(it); const int blk = itu & 31, hh = (itu >> 5) & 3, b = itu >> 7; for (int rp = 0; rp < REP_ATT; ++rp) attn_block_item(c, layer, b, hh, blk, q); }
        else if (it < 384) { for (int rp = 0; rp < REP_GMLP; ++rp) gmlp_chunk_item(c, layer, (size_t)(it - 256) * 128); }
        else if (it < 416) { const int b = it - 384; gmlp_item(c, layer, (size_t)NPR + b * DECT, DECT, c.out + O_CVS + ((size_t)layer * DECB + b) * DECT * 256); }
        else if (it < 928) { const int i2 = it - 416, b = i2 >> 8, hh = (i2 >> 6) & 3, ch = i2 & 63;
            for (int rp = 0; rp < REP_STATE; ++rp) mlstm_chunk_state(c, layer, hh, (size_t)b * TSEQ + ch * 128, MU + (size_t)i2 * 4096, (float*)((char*)MU + REC_N_OFF) + i2 * 64, (float*)((char*)MU + REC_M_OFF) + i2, (float*)((char*)MU + REC_B_OFF) + i2); }
        else if (it < 1440) { const int i2 = it - 928, b = i2 >> 8, hh = (i2 >> 6) & 3, ch = i2 & 63;
            for (int rp = 0; rp < REP_STATE; ++rp) hgrn_chunk_state(c, layer, hh, (size_t)b * TSEQ + ch * 128, HU + (size_t)i2 * 4096, (float*)((char*)HU + REC_N_OFF) + i2 * 64); }
        else if (it < 1504) { const int qh = __builtin_amdgcn_readfirstlane((it - 1440) * 8 + c.wave); const int t = qh & 3, hh = (qh >> 2) & 3, b = qh >> 4; for (int rp = 0; rp < REP_SATT; ++rp) attn_sample_qh(c, layer, b, hh, t); }
        else if (it < 1632) copy_item(c, layer, it - 1504);
        else { const int s = it - 1632; copy_item(c, layer, 128 + (s >> 5) * 1024 + (s & 31) * 32 + 31); }
    }
}

DEVI void phase_scan(const Ctx& c, int layer) {
    float* MU = (float*)(c.ws + WS_MU); float* MCS = (float*)(c.ws + WS_MCS); float* HU = (float*)(c.ws + WS_HU); float* HSS = (float*)(c.ws + WS_HSS);
    const int tid = c.tid; constexpr int GRP = 16;
    for (int it = c.bid; it < 128; it += c.G) {
        const int seq = it >> 3, e = (it & 7) * 512 + tid;
        if (seq < 8) {
            const float* un = (const float*)((const char*)MU + REC_N_OFF); const float* um = (const float*)((const char*)MU + REC_M_OFF); const float* ub = (const float*)((const char*)MU + REC_B_OFF);
            float* csn = (float*)((char*)MCS + REC_N_OFF); float* csm = (float*)((char*)MCS + REC_M_OFF);
            const bool lead = (it & 7) == 0; const bool do_n = lead && tid < 64;
            float C = 0.f, nn = 0.f, m = 0.f;
#pragma unroll 1
            for (int ch0 = 0; ch0 < NCHUNK; ch0 += GRP) {
                const float* up = MU + (size_t)(seq * NCHUNK + ch0) * 4096 + e; float* cp = MCS + (size_t)(seq * NCHUNK + ch0) * 4096 + e; const int item0 = seq * NCHUNK + ch0;
                float u[GRP], nu[GRP], Bv[GRP], mlv[GRP];
#pragma unroll
                for (int q = 0; q < GRP; ++q) { u[q] = up[(size_t)q * 4096]; Bv[q] = ub[item0 + q]; mlv[q] = um[item0 + q]; nu[q] = do_n ? un[(item0 + q) * 64 + tid] : 0.f; }
#pragma unroll
                for (int q = 0; q < GRP; ++q) {
                    cp[(size_t)q * 4096] = C; if (do_n) csn[(item0 + q) * 64 + tid] = nn; if (lead && tid == 0) csm[item0 + q] = m;
                    const float mn = fmaxf(Bv[q] + m, mlv[q]); const float a = __expf(Bv[q] + m - mn), bb = __expf(mlv[q] - mn);
                    C = a * C + bb * u[q]; nn = a * nn + bb * nu[q]; m = mn; }
            }
            c.out[O_CP + ((size_t)layer * 8 + seq) * 4096 + e] = C;
            if (lead && tid == 0) c.out[O_MP + layer * 8 + seq] = m;
            if (do_n) c.out[O_NP + ((size_t)layer * 8 + seq) * 64 + tid] = nn;
        } else {
            const int bh = seq - 8, d = e & 63, v = e >> 6; const float* dec = (const float*)((const char*)HU + REC_N_OFF);
            float S = 0.f;
#pragma unroll 1
            for (int ch0 = 0; ch0 < NCHUNK; ch0 += GRP) {
                const float* up = HU + (size_t)(bh * NCHUNK + ch0) * 4096 + e; float* sp = HSS + (size_t)(bh * NCHUNK + ch0) * 4096 + e; const float* dp = dec + (bh * NCHUNK + ch0) * 64 + d;
                float u[GRP], dd[GRP];
#pragma unroll
                for (int q = 0; q < GRP; ++q) { u[q] = up[(size_t)q * 4096]; dd[q] = dp[q * 64]; }
#pragma unroll
                for (int q = 0; q < GRP; ++q) { sp[(size_t)q * 4096] = S; S = dd[q] * S + u[q]; }
            }
            c.out[O_SP + ((size_t)layer * 8 + bh) * 4096 + d * 64 + v] = S;
        }
    }
}

DEVI void phase_mix_out(const Ctx& c0, int layer0, int qslot) {
    WorkQueue q; q.start(c0, (unsigned*)(c0.ws + WS_CTL) + CW_QUEUE + 64 * (2 * layer0 + 1) + 64 * 8 * qslot);
    for (;;) {
        const int it = q.pop(c0);
        if (it >= 1280) break;
        const Ctx c = relaunder(c0); int layer = layer0; asm volatile("" : "+s"(layer));
        float* MCS = (float*)(c.ws + WS_MCS); float* HSS = (float*)(c.ws + WS_HSS);
        q.prefetch(c);
        if (it < 512) { const int b = it >> 8, hh = (it >> 6) & 3, ch = it & 63; RecIO io{}; io.st_in = MCS + (size_t)it * 4096; io.n_in = (const float*)((const char*)MCS + REC_N_OFF) + it * 64; io.m_in = (const float*)((const char*)MCS + REC_M_OFF) + it;
            for (int rp = 0; rp < REP_OUT; ++rp) mlstm_chunk_out(c, layer, hh, (size_t)b * TSEQ + ch * 128, io.st_in, io.n_in, io.m_in); }
        else if (it < 1024) { const int i2 = it - 512, b = i2 >> 8, hh = (i2 >> 6) & 3, ch = i2 & 63; RecIO io{}; io.st_in = HSS + (size_t)i2 * 4096; io.native_in = true;
            for (int rp = 0; rp < REP_OUT; ++rp) hgrn_chunk_out(c, layer, hh, (size_t)b * TSEQ + ch * 128, io.st_in); }
        else if (it < 1152) { const int i2 = it - 1024, b = i2 >> 2, hh = i2 & 3; const size_t sidx = (size_t)(layer * DECB + b) * NH + hh; RecIO io{};
            io.st_in = c.in[I_MC] + sidx * 4096; io.n_in = c.in[I_MN] + sidx * 64; io.m_in = c.in[I_MM] + sidx;
            io.st_out = c.out + O_CS + sidx * 4096; io.n_out = c.out + O_NS + sidx * 64; io.m_out = c.out + O_MS + sidx;
            for (int rp = 0; rp < REP_SREC; ++rp) mlstm_item<true>(c, layer, hh, (size_t)NPR + b * DECT, DECT, io, 0.f); }
        else { const int i2 = it - 1152, b = i2 >> 2, hh = i2 & 3; const size_t sidx = (size_t)(layer * DECB + b) * NH + hh; RecIO io{};
            io.st_in = c.in[I_HS] + sidx * 4096; io.st_out = c.out + O_SS + sidx * 4096;
            for (int rp = 0; rp < REP_SREC; ++rp) hgrn_item<true>(c, layer, hh, (size_t)NPR + b * DECT, DECT, io); }
    }
}

DEVI void phase_final(const Ctx& c) {
    const int gw = c.bid * 8 + c.wave, NGW = c.G * 8; const bf16_t* x = c.X2(); const float* g = c.in[I_GFIN];
    f32x4 gv[4];
#pragma unroll
    for (int j = 0; j < 4; ++j) gv[j] = *(const f32x4*)(g + 256 * j + 4 * c.lane);
    for (int row0 = gw; row0 < NTOK; row0 += 3 * NGW) {
        u32x2 xb[3][4]; float rs[3];
#pragma unroll
        for (int r = 0; r < 3; ++r) { const int row = row0 + r * NGW < NTOK ? row0 + r * NGW : row0; const bf16_t* xr = x + (size_t)row * DM;
#pragma unroll
            for (int j = 0; j < 4; ++j) xb[r][j] = *(const u32x2*)(xr + 256 * j + 4 * c.lane);
            rs[r] = row_rs(c.SSQ(), row); }
        __builtin_amdgcn_sched_barrier(0);
#pragma unroll
        for (int r = 0; r < 3; ++r) { const int row = row0 + r * NGW; if (row < NTOK) {
            float* o = c.out + ((row < NPR) ? O_YP + (size_t)row * DM : O_YS + (size_t)(row - NPR) * DM);
#pragma unroll
            for (int j = 0; j < 4; ++j) { const f32x4 v = (f32x4){bflo(xb[r][j].x), bfhi(xb[r][j].x), bflo(xb[r][j].y), bfhi(xb[r][j].y)}; __builtin_nontemporal_store(v * rs[r] * gv[j], (f32x4*)(o + 256 * j + 4 * c.lane)); } } }
    }
}

#define XB_TMO      128
#define XB_XCNT(j)  (256  + 64 * (j))
#define XB_XSUB(j)  (1280 + 64 * (j))
#define XB_XGEN(j)  (2304 + 64 * (j))
#define XB_TOP      3328
#define XB_TOPGEN   3392
#define XCD_BAR_WORDS 3456
#define XB_SPIN_CAP (1u << 18)

__device__ __forceinline__ unsigned xb_ld(unsigned* p)              { return __hip_atomic_load(p, __ATOMIC_RELAXED, __HIP_MEMORY_SCOPE_AGENT); }
__device__ __forceinline__ unsigned xb_add(unsigned* p, unsigned v) { return __hip_atomic_fetch_add(p, v, __ATOMIC_RELAXED, __HIP_MEMORY_SCOPE_AGENT); }
__device__ __forceinline__ unsigned xb_xcc_id() { return (unsigned)__builtin_amdgcn_s_getreg((3 << 11) | 20) & 0xFu; }
#define XB_SPIN(cond, bar) do { unsigned _sp = 0; while (cond) { __builtin_amdgcn_s_sleep(1); \
    if ((++_sp & 255u) == 0u) { if (xb_ld(&(bar)[XB_TMO])) break; if (_sp > XB_SPIN_CAP) { atomicAdd(&(bar)[XB_TMO], 1u); break; } } } } while (0)

struct XcdBarrier {
    unsigned* bar; unsigned x;
    volatile LAS unsigned* st;
};

__device__ __forceinline__ XcdBarrier xcd_barrier_post(unsigned* bar, volatile LAS unsigned* st, bool leader) {
    XcdBarrier b; b.bar = bar; b.x = xb_xcc_id(); b.st = st;
    if (leader) (void)xb_add(&bar[XB_XCNT(b.x)], 1u);
    return b;
}
__device__ __forceinline__ void xcd_barrier_complete(unsigned* bar, unsigned x, unsigned& nloc, unsigned& nx) {
    const unsigned G = gridDim.x * gridDim.y * gridDim.z;
    unsigned sum, cnt, mine, sp = 0u;
    for (;;) {
        sum = 0u; cnt = 0u; mine = 0u;
#pragma unroll
        for (unsigned j = 0; j < 16; ++j) { const unsigned c = xb_ld(&bar[XB_XCNT(j)]); sum += c; cnt += (c > 0u) ? 1u : 0u; mine = (j == x) ? c : mine; }
        if (sum == G) break;
        __builtin_amdgcn_s_sleep(1);
        if ((++sp & 255u) == 0u) { if (xb_ld(&bar[XB_TMO])) break; if (sp > XB_SPIN_CAP) { atomicAdd(&bar[XB_TMO], 1u); break; } }
    }
    nloc = mine > 0u ? mine : 1u; nx = cnt > 0u ? cnt : 1u;
}

__device__ __forceinline__ void xcd_barrier(const XcdBarrier& b, bool leader) {
    asm volatile("s_waitcnt vmcnt(0)" ::: "memory");
    __syncthreads();
    if (leader) {
        unsigned* bar = b.bar;
        __builtin_amdgcn_s_waitcnt(0);
        unsigned nloc = b.st[0], nx = b.st[1];
        if (nloc == 0u) { xcd_barrier_complete(bar, b.x, nloc, nx); b.st[0] = nloc; b.st[1] = nx; }
        const unsigned old = xb_add(&bar[XB_XSUB(b.x)], 1u);
        const unsigned gen = old / nloc;
        if (old + 1u == (gen + 1u) * nloc) {
            __builtin_amdgcn_fence(__ATOMIC_RELEASE, "agent");
            asm volatile("s_waitcnt vmcnt(0)" ::: "memory");
            const unsigned og = xb_add(&bar[XB_TOP], 1u);
            const unsigned tg = og / nx;
            if (og + 1u == (tg + 1u) * nx) xb_add(&bar[XB_TOPGEN], 1u);
            else XB_SPIN(xb_ld(&bar[XB_TOPGEN]) == tg, bar);
            __builtin_amdgcn_fence(__ATOMIC_ACQUIRE, "agent");
            xb_add(&bar[XB_XGEN(b.x)], 1u);
            asm volatile("s_waitcnt vmcnt(0)" ::: "memory");
        } else {
            XB_SPIN(xb_ld(&bar[XB_XGEN(b.x)]) == gen, bar);
            __builtin_amdgcn_fence(__ATOMIC_ACQUIRE, "agent");
            asm volatile("s_waitcnt vmcnt(0)" ::: "memory");
        }
    }
    __syncthreads();
}

constexpr int PH_PER_LAYER = 9;
DEVI Ctx make_ctx(const Params& p, unsigned char* lds_raw, int wave0) {
    int tid_ = wave0 * 64 + lane_opaque(); asm volatile("" : "+v"(tid_));
    const __attribute__((address_space(4))) Params* kp = (const __attribute__((address_space(4))) Params*)__builtin_amdgcn_kernarg_segment_ptr(); asm volatile("" : "+s"(kp));
    const __attribute__((address_space(4))) ParamsDev* kd = (const __attribute__((address_space(4))) ParamsDev*)kp; Ctx c; c.in.p = kd->in; c.out = (float*)kd->out; c.ws = (unsigned char*)kd->ws; c.lds = (LAS unsigned char*)lds_raw; c.tid = tid_; c.lane = c.tid & 63; c.wave = __builtin_amdgcn_readfirstlane(c.tid >> 6); c.G = gridDim.x; c.bid = blockIdx.x;
    return c;
}
template <int SUB> DEVI void run_sub(const Ctx& c, const Params& p, int layer, int qslot = 0) {
    const bf16_t* xin_p = c.X2(); const bf16_t* xin_s = c.X2() + (size_t)NPR * DM;
    if constexpr (SUB == 1) { pg8::Gemm g{c.X2(), (const bf16_t*)(c.ws + WS_WIN) + (size_t)layer * NZ * DM, MPAD, NZ, DM}; pg8::StaticOrder S; S.init(MPAD, NZ, c.G, c.bid);
        EpiRowScaleBf16<0> E{c.Z(), NZ, c.SSQ(), c.lds + EPI_STG}; pg8::gemm_phase<EpiRowScaleBf16<0>, pg8::StaticOrder, true, true>(c.lds, g, S, E, c.tid); }
    else if constexpr (SUB == 2) phase_mix_local(c, layer, qslot);
    else if constexpr (SUB == 3) phase_scan(c, layer);
    else if constexpr (SUB == 4) phase_mix_out(c, layer, qslot);
    else if constexpr (SUB == 5) { const bf16_t* wt = (const bf16_t*)(c.ws + WS_WOUT) + (size_t)layer * DM * DM;
        pg8::Gemm g{c.MIX(), wt, NPR, DM, DM}; pg8::StaticOrder S; S.init(NPR, DM, c.G, c.bid);
        pg8::gemm_prestage<EpiResidualNorm, pg8::StaticOrder>(c.lds, g, S, c.tid);
        { SkEpiResidualNorm se{xin_s, c.X1() + (size_t)NPR * DM, c.SSQ() + (size_t)NPR * 16}; skinny_gemm(c, c.MIX() + (size_t)NPR * DM, wt, DM, DM, se); }
        EpiResidualNorm E{xin_p, c.X1(), c.SSQ(), c.lds + EPI_STG}; pg8::gemm_phase<EpiResidualNorm, pg8::StaticOrder, true, true, true>(c.lds, g, S, E, c.tid); }
    else if constexpr (SUB == 7) { const bf16_t* wt = (const bf16_t*)(c.ws + WS_WUP) + (size_t)layer * FF * DM;
        pg8::Gemm g{c.X1(), wt, NPR, FF, DM}; pg8::StaticOrder S; S.init(NPR, FF, c.G, c.bid);
        pg8::gemm_prestage<EpiRowScaleBf16<1>, pg8::StaticOrder>(c.lds, g, S, c.tid);
        { SkEpiRelu2 se{c.Hb() + (size_t)NPR * FF, c.SSQ() + (size_t)NPR * 16}; skinny_gemm(c, c.X1() + (size_t)NPR * DM, wt, FF, DM, se); }
        EpiRowScaleBf16<1> E{c.Hb(), FF, c.SSQ(), c.lds + EPI_STG}; pg8::gemm_phase<EpiRowScaleBf16<1>, pg8::StaticOrder, true, true, true>(c.lds, g, S, E, c.tid); }
    else if constexpr (SUB == 8) { const bf16_t* wt = (const bf16_t*)(c.ws + WS_WDN) + (size_t)layer * DM * FF;
        pg8::Gemm g{c.Hb(), wt, NPR, DM, FF}; pg8::StaticOrder S; S.init(NPR, DM, c.G, c.bid);
        pg8::gemm_prestage<EpiResidualNorm, pg8::StaticOrder>(c.lds, g, S, c.tid);
        { SkEpiResidualNorm se{c.X1() + (size_t)NPR * DM, c.X2() + (size_t)NPR * DM, c.SSQ() + (size_t)NPR * 16}; skinny_gemm(c, c.Hb() + (size_t)NPR * FF, wt, DM, FF, se); }
        EpiResidualNorm E{c.X1(), c.X2(), c.SSQ(), c.lds + EPI_STG}; pg8::gemm_phase<EpiResidualNorm, pg8::StaticOrder, true, true, true>(c.lds, g, S, E, c.tid); }
    else if constexpr (SUB == 9) phase_prologue(c);
    else phase_final(c);
}
template <int SUB> __global__ void __launch_bounds__(NTHREADS, 2) k_sub(Params p, int layer) {
    extern __shared__ __attribute__((aligned(16))) unsigned char lds_raw[];
    const Ctx c = make_ctx(p, lds_raw, __builtin_amdgcn_readfirstlane((int)threadIdx.x >> 6));
    run_sub<SUB>(c, p, layer);
}
template <int SUB> static void launch_sub(const Params& p, int layer, int grid, hipStream_t stream) {
    static bool attr_set = false;
    if (!attr_set) { (void)hipFuncSetAttribute((const void*)k_sub<SUB>, hipFuncAttributeMaxDynamicSharedMemorySize, LDS_BYTES); attr_set = true; }
    hipLaunchKernelGGL(k_sub<SUB>, dim3(grid), dim3(NTHREADS), LDS_BYTES, stream, p, layer);
}

#ifndef REP_A
#define REP_A 1
#endif
#ifndef REP_B
#define REP_B 1
#endif
#ifndef REP_C
#define REP_C 1
#endif
#ifndef REP_D
#define REP_D 1
#endif
#ifndef REP_G1
#define REP_G1 1
#endif
#ifndef REP_G2
#define REP_G2 1
#endif
#ifndef REP_G3
#define REP_G3 1
#endif
#ifndef REP_G4
#define REP_G4 1
#endif
#ifndef REP_ML
#define REP_ML 1
#endif
#ifndef REP_MO
#define REP_MO 1
#endif
#ifndef REP_BAR
#define REP_BAR 1
#endif
#define GRID_BAR() do { for (int rb_ = 0; rb_ < REP_BAR; ++rb_) { XcdBarrier b_; b_.bar = (unsigned*)(c.ws + WS_CTL); b_.x = xb_xcc_id(); b_.st = (volatile LAS unsigned*)(c.lds + LDS_BYTES - 64); xcd_barrier(b_, wave0 == 0 && lane_opaque() == 0); c = make_ctx(p, lds_raw, wave0); } } while (0)
__global__ void __launch_bounds__(NTHREADS, 2) mk_fwd(Params p) {
    extern __shared__ __attribute__((aligned(16))) unsigned char lds_raw[];
    const int wave0 = __builtin_amdgcn_readfirstlane((int)threadIdx.x >> 6);
    Ctx c = make_ctx(p, lds_raw, wave0);
    volatile LAS unsigned* st = (volatile LAS unsigned*)(c.lds + LDS_BYTES - 64);
    if (c.tid < 16) st[c.tid] = 0u;
    __syncthreads();
    (void)xcd_barrier_post((unsigned*)(c.ws + WS_CTL), st, c.tid == 0);
    c = make_ctx(p, lds_raw, wave0);
    if (p.ph_lo < 0) cg::this_grid().sync();
    for (int rep = 0; rep < REP_D; ++rep) run_sub<9>(c, p, 0);
    GRID_BAR();
#pragma unroll 1
    for (int layer = 0; layer < NLAYER; ++layer) {
        for (int rep = 0; rep < REP_A * REP_G1; ++rep) run_sub<1>(c, p, layer);
        GRID_BAR();
        for (int rep = 0; rep < REP_ML; ++rep) run_sub<2>(c, p, layer, rep);
        GRID_BAR();
        for (int rep = 0; rep < REP_D; ++rep) run_sub<3>(c, p, layer);
        GRID_BAR();
        for (int rep = 0; rep < REP_MO; ++rep) run_sub<4>(c, p, layer, rep);
        GRID_BAR();
        for (int rep = 0; rep < REP_A * REP_G2; ++rep) run_sub<5>(c, p, layer);
        GRID_BAR();
        for (int rep = 0; rep < REP_A * REP_G3; ++rep) run_sub<7>(c, p, layer);
        GRID_BAR();
        for (int rep = 0; rep < REP_A * REP_G4; ++rep) run_sub<8>(c, p, layer);
        GRID_BAR();
    }
    for (int rep = 0; rep < REP_D; ++rep) run_sub<10>(c, p, 0);
}

extern "C" void kernel_launch(void* const* d_in, const int* in_sizes, int n_in, void* d_out, int out_size, void* d_ws, size_t ws_size, hipStream_t stream) {
    static int grid = 0;
    if (grid == 0) {
        if (n_in != N_IN || (size_t)out_size != O_END || ws_size < WS_END) { fprintf(stderr, "kernel_launch: unexpected shapes: n_in %d out %d (want %zu) ws %zu (want %zu)\n", n_in, out_size, (size_t)O_END, ws_size, (size_t)WS_END); grid = -1; return; }
        int dev = 0, cus = 0, per_cu = 0;
        (void)hipGetDevice(&dev); (void)hipDeviceGetAttribute(&cus, hipDeviceAttributeMultiprocessorCount, dev);
        if (hipFuncSetAttribute((const void*)mk_fwd, hipFuncAttributeMaxDynamicSharedMemorySize, LDS_BYTES) != hipSuccess) { fprintf(stderr, "kernel_launch: hipFuncSetAttribute failed\n"); grid = -1; return; }
        if (hipOccupancyMaxActiveBlocksPerMultiprocessor(&per_cu, (const void*)mk_fwd, NTHREADS, LDS_BYTES) != hipSuccess || per_cu < 1) { fprintf(stderr, "kernel_launch: occupancy query says %d blocks per CU\n", per_cu); (void)hipGetLastError(); grid = -1; return; }
        grid = (cus > 0 ? cus : 256);
    }
    if (grid < 0) return;
    (void)hipMemsetAsync((char*)d_ws + WS_CTL, 0, CTL_ZERO_BYTES, stream);
    Params p{};
    for (int i = 0; i < N_IN; ++i) p.in[i] = (const float*)d_in[i];
    p.out = (float*)d_out; p.ws = (unsigned char*)d_ws;
    void* args[] = {&p};
    const hipError_t e = hipLaunchCooperativeKernel((const void*)mk_fwd, dim3(grid), dim3(NTHREADS), args, LDS_BYTES, stream);
    if (e != hipSuccess) fprintf(stderr, "kernel_launch: cooperative launch failed: %s (grid %d)\n", hipGetErrorString(e), grid);
}
```

```cpp
#include <hip/hip_runtime.h>
#include <hip/hip_cooperative_groups.h>
#include <cstdio>
#include <cstdint>
namespace cg = cooperative_groups;

namespace pg8 {
#define PG8_LAS __attribute__((address_space(3)))
typedef unsigned short bf16_t;
typedef short bf16x8 __attribute__((ext_vector_type(8)));
typedef float f32x4 __attribute__((ext_vector_type(4)));
typedef unsigned u32x4 __attribute__((ext_vector_type(4)));
constexpr int BM = 256, BK = 64, HALF = 128, HTB = HALF * BK * 2  , STAGE_BYTES = 8 * HTB, NXCD = 8, WGM = 8;

__host__ __device__ __forceinline__ int lds_byte(int r, int c) { const int st = (r >> 4) * 2 + (c >> 5), rr = r & 15, cc = c & 31, ob = rr * 64 + cc * 2; return st * 1024 + (ob ^ (((ob >> 9) & 1) << 5)); }
__host__ __device__ __forceinline__ void stage_rc(int b, int& R, int& C) { const int st = b / 1024, sb = b % 1024, swz = sb ^ (((sb >> 9) & 1) << 5); R = (st >> 1) * 16 + swz / 64; C = (st & 1) * 32 + (swz % 64) / 2; }
__host__ __device__ __forceinline__ int perm32(int rho) { const int n = rho >> 4, i = rho & 15; return 8 * (i >> 2) + 4 * n + (i & 3); }

struct Unit { int pm, pn; };
struct Gemm { const bf16_t* A; const bf16_t* Bt; int M, N, K; };

struct StaticOrder {
    int nM, nN, nwg, G, c;
    __host__ __device__ void init(int M, int N, int G_, int c_) { nM = M / BM; nN = N / BM; nwg = nM * nN; G = G_; c = c_; }
    __host__ __device__ bool next(int i, Unit& u) const {
        const long L = (long)i * G + c; if (L >= nwg) return false;
        int wgid = (int)L; { const int q = nwg / NXCD, r = nwg % NXCD, xcd = wgid % NXCD, off = wgid / NXCD; wgid = (xcd < r ? xcd * (q + 1) : r * (q + 1) + (xcd - r) * q) + off; }
        const int nig = WGM * nN, gid = wgid / nig, fm = gid * WGM, gsz = (nM - fm) < WGM ? (nM - fm) : WGM;
        u.pm = fm + ((wgid % nig) % gsz); u.pn = (wgid % nig) / gsz; return true;
    }
    __device__ __forceinline__ void a_ready(const Unit&) const {}
    __device__ __forceinline__ void done(const Unit&) const {}
};

template <class Epi, class Sched, bool ALIGN_EPI = false, bool SP2 = false>
__device__ __forceinline__ void gemm_phase(PG8_LAS unsigned char* lds, const Gemm g, const Sched& S, const Epi& E, int tid_in) {
    int tid_ = tid_in; asm volatile("" : "+v"(tid_));
    const int tid = tid_, wid = __builtin_amdgcn_readfirstlane(tid >> 6), lane = tid & 63, wr = wid >> 2, wc = wid & 3, fr = lane & 15, fq = lane >> 4;
    const int K = g.K, nt = K / BK;
    unsigned voffA[2], voffB[2];
#pragma unroll
    for (int i = 0; i < 2; ++i) { int R, C; stage_rc(tid * 16 + i * 8192, R, C); const int Rb = Epi::WIDE ? ((R >> 5) * 64 + perm32(R & 31)) : (Epi::PERM ? ((R & ~31) + perm32(R & 31)) : R);
        voffA[i] = (unsigned)(R * K + C) * 2u; voffB[i] = (unsigned)(Rb * K + C) * 2u; }
    const size_t kstep = (size_t)(BK * 2);
    const size_t hstep = (size_t)HALF * K * 2;
    const size_t hstepB = Epi::WIDE ? (size_t)32 * K * 2 : hstep;
    const size_t tstep = 2 * hstep;
    const unsigned ldsw = (unsigned)wid * 1024u;
    const int aoff = lds_byte(wr * 64 + fr, fq * 8), boff = lds_byte(wc * 32 + fr, fq * 8);
#define PG8_SA(b, h) (((b) * 2 + (h)) * HTB)
#define PG8_SB(b, h) ((4 + (b) * 2 + (h)) * HTB)
#define PG8_STAGE(bufoff, gbase, voff) do { _Pragma("unroll") for (int _i = 0; _i < 2; ++_i) \
        __builtin_amdgcn_global_load_lds((const unsigned*)((const char*)(gbase) + (voff)[_i]), (PG8_LAS unsigned*)(lds + (bufoff) + ldsw + _i * 8192), 16, 0, 0); } while (0)
#define PG8_LDA(dst, b, h) do { _Pragma("unroll") for (int m = 0; m < 4; ++m) _Pragma("unroll") for (int k = 0; k < 2; ++k) dst[m][k] = *(const PG8_LAS bf16x8*)(lds + PG8_SA(b, h) + aoff + m * 2048 + k * 1024); } while (0)
#define PG8_LDB(dst, b, h) do { _Pragma("unroll") for (int n = 0; n < 2; ++n) _Pragma("unroll") for (int k = 0; k < 2; ++k) dst[n][k] = *(const PG8_LAS bf16x8*)(lds + PG8_SB(b, h) + boff + n * 2048 + k * 1024); } while (0)
#define PG8_MMA(ai, bj, At, Bt) do { __builtin_amdgcn_s_setprio(1); _Pragma("unroll") for (int m = 0; m < 4; ++m) _Pragma("unroll") for (int n = 0; n < 2; ++n) _Pragma("unroll") for (int k = 0; k < 2; ++k) \
        acc[ai][bj][m][n] = __builtin_amdgcn_mfma_f32_16x16x32_bf16(Bt[n][k], At[m][k], acc[ai][bj][m][n], 0, 0, 0); __builtin_amdgcn_s_setprio(0); } while (0)
#define PG8_WAIT_V(n) asm volatile("s_waitcnt vmcnt(" #n ")" ::: "memory")
#define PG8_WAIT_L(n) asm volatile("s_waitcnt lgkmcnt(" #n ")" ::: "memory")
#define PG8_BAR __builtin_amdgcn_s_barrier()
#define PG8_SCHED __builtin_amdgcn_sched_barrier(0)
    Unit cur, nxt; int ui = 0;
    if (!S.next(0, cur)) return;
    f32x4 acc[2][2][4][2];
#pragma unroll
    for (int a = 0; a < 2; ++a)
#pragma unroll
        for (int b = 0; b < 2; ++b)
#pragma unroll
            for (int m = 0; m < 4; ++m)
#pragma unroll
                for (int n = 0; n < 2; ++n) acc[a][b][m][n] = (f32x4){0.f, 0.f, 0.f, 0.f};
    bf16x8 At[4][2], B0[2][2], B1[2][2];
    const char* cA = (const char*)g.A + (size_t)cur.pm * tstep; const char* cB = (const char*)g.Bt + (size_t)cur.pn * tstep;
    S.a_ready(cur);
    if constexpr (SP2) {
        PG8_STAGE(PG8_SB(0, 0), cB, voffB); PG8_STAGE(PG8_SB(0, 1), cB + hstepB, voffB); PG8_STAGE(PG8_SA(0, 0), cA, voffA); PG8_STAGE(PG8_SA(0, 1), cA + hstep, voffA);
        if (wr == 1) PG8_BAR;
        PG8_WAIT_V(2); PG8_BAR;
        PG8_STAGE(PG8_SB(1, 0), cB + kstep, voffB); PG8_STAGE(PG8_SA(1, 0), cA + kstep, voffA); PG8_STAGE(PG8_SB(1, 1), cB + hstepB + kstep, voffB);
        PG8_WAIT_V(6); PG8_BAR;
    } else {
        PG8_STAGE(PG8_SB(0, 0), cB, voffB); PG8_STAGE(PG8_SA(0, 0), cA, voffA); PG8_STAGE(PG8_SB(0, 1), cB + hstepB, voffB); PG8_STAGE(PG8_SA(0, 1), cA + hstep, voffA);
        if (wr == 1) PG8_BAR;
        PG8_WAIT_V(4); PG8_BAR;
        PG8_STAGE(PG8_SB(1, 0), cB + kstep, voffB); PG8_STAGE(PG8_SA(1, 0), cA + kstep, voffA); PG8_STAGE(PG8_SB(1, 1), cB + hstepB + kstep, voffB);
        PG8_WAIT_V(6); PG8_BAR;
    }
    for (;;) {
        const bool has_next = S.next(ui + 1, nxt);
        const char* nA = has_next ? (const char*)g.A + (size_t)nxt.pm * tstep : cA; const char* nB = has_next ? (const char*)g.Bt + (size_t)nxt.pn * tstep : cB;
        for (int t = 0; t < nt; t += 2) {
            const bool last = (t == nt - 2);
            const char* a1 = cA + (size_t)(t + 1) * kstep;
            const char* a2 = last ? nA : cA + (size_t)(t + 2) * kstep; const char* b2 = last ? nB : cB + (size_t)(t + 2) * kstep;
            const char* a3 = a2 + kstep; const char* b3 = b2 + kstep;
            if (last && has_next) S.a_ready(nxt);
            if constexpr (SP2) {
            PG8_LDB(B0, 0, 0); PG8_LDB(B1, 0, 1); PG8_SCHED; PG8_LDA(At, 0, 0); PG8_STAGE(PG8_SA(1, 1), a1 + hstep, voffA);
            PG8_WAIT_V(8); PG8_WAIT_L(0); PG8_BAR; PG8_MMA(0, 0, At, B0); PG8_MMA(0, 1, At, B1); PG8_BAR; PG8_SCHED;
            PG8_LDA(At, 0, 1); PG8_STAGE(PG8_SB(0, 0), b2, voffB); PG8_STAGE(PG8_SB(0, 1), b2 + hstepB, voffB); PG8_STAGE(PG8_SA(0, 0), a2, voffA);
            PG8_WAIT_V(8); PG8_WAIT_L(0); PG8_BAR; PG8_MMA(1, 0, At, B0); PG8_MMA(1, 1, At, B1); PG8_BAR; PG8_SCHED;
            PG8_LDB(B0, 1, 0); PG8_LDB(B1, 1, 1); PG8_SCHED; PG8_LDA(At, 1, 0); PG8_STAGE(PG8_SA(0, 1), a2 + hstep, voffA);
            PG8_WAIT_V(8); PG8_WAIT_L(0); PG8_BAR; PG8_MMA(0, 0, At, B0); PG8_MMA(0, 1, At, B1); PG8_BAR; PG8_SCHED;
            PG8_LDA(At, 1, 1); PG8_STAGE(PG8_SB(1, 0), b3, voffB); PG8_STAGE(PG8_SB(1, 1), b3 + hstepB, voffB); PG8_STAGE(PG8_SA(1, 0), a3, voffA);
            PG8_WAIT_V(8); PG8_WAIT_L(0); PG8_BAR; PG8_MMA(1, 0, At, B0); PG8_MMA(1, 1, At, B1); PG8_BAR; PG8_SCHED;
            } else {
            PG8_LDB(B0, 0, 0); PG8_SCHED; PG8_LDA(At, 0, 0); PG8_STAGE(PG8_SA(1, 1), a1 + hstep, voffA);
            PG8_WAIT_L(8); PG8_BAR; PG8_WAIT_L(0); PG8_MMA(0, 0, At, B0); PG8_BAR; PG8_SCHED;
            PG8_LDB(B1, 0, 1); PG8_STAGE(PG8_SB(0, 0), b2, voffB);
            PG8_BAR; PG8_WAIT_L(0); PG8_MMA(0, 1, At, B1); PG8_BAR;
            PG8_LDA(At, 0, 1); PG8_STAGE(PG8_SA(0, 0), a2, voffA);
            PG8_BAR; PG8_WAIT_L(0); PG8_MMA(1, 0, At, B0); PG8_BAR; PG8_SCHED;
            PG8_STAGE(PG8_SB(0, 1), b2 + hstepB, voffB);
            PG8_WAIT_V(6); PG8_BAR; PG8_MMA(1, 1, At, B1); PG8_BAR;
            PG8_LDB(B0, 1, 0); PG8_SCHED; PG8_LDA(At, 1, 0); PG8_STAGE(PG8_SA(0, 1), a2 + hstep, voffA);
            PG8_WAIT_L(8); PG8_BAR; PG8_WAIT_L(0); PG8_MMA(0, 0, At, B0); PG8_BAR; PG8_SCHED;
            PG8_LDB(B1, 1, 1); PG8_STAGE(PG8_SB(1, 0), b3, voffB);
            PG8_BAR; PG8_WAIT_L(0); PG8_MMA(0, 1, At, B1); PG8_BAR;
            PG8_LDA(At, 1, 1); PG8_STAGE(PG8_SA(1, 0), a3, voffA);
            PG8_BAR; PG8_WAIT_L(0); PG8_MMA(1, 0, At, B0); PG8_BAR; PG8_SCHED;
            PG8_STAGE(PG8_SB(1, 1), b3 + hstepB, voffB);
            PG8_WAIT_V(6); PG8_BAR; PG8_MMA(1, 1, At, B1); PG8_BAR;
            }
        }
        if constexpr (ALIGN_EPI) { if (wr == 0) PG8_BAR; }
        if constexpr (!Epi::AFTER_DRAIN) { E(acc, cur, wr, wc, fr, fq); S.done(cur); }
        if (!has_next) break;
#pragma unroll
        for (int a = 0; a < 2; ++a)
#pragma unroll
            for (int b = 0; b < 2; ++b)
#pragma unroll
                for (int m = 0; m < 4; ++m)
#pragma unroll
                    for (int n = 0; n < 2; ++n) acc[a][b][m][n] = (f32x4){0.f, 0.f, 0.f, 0.f};
        cur = nxt; cA = nA; cB = nB; ++ui;
        if constexpr (ALIGN_EPI) { if (wr == 1) PG8_BAR; }
    }
    PG8_WAIT_V(0);
    if constexpr (!ALIGN_EPI) { if (wr == 0) PG8_BAR; }
    PG8_BAR;
    if constexpr (Epi::AFTER_DRAIN) { E.fused(acc, cur, wr, wc, fr, fq, lds, wid, lane); S.done(cur); }
#undef PG8_SA
#undef PG8_SB
#undef PG8_STAGE
#undef PG8_LDA
#undef PG8_LDB
#undef PG8_MMA
#undef PG8_WAIT_V
#undef PG8_WAIT_L
#undef PG8_BAR
#undef PG8_SCHED
}
}

#define LAS __attribute__((address_space(3)))
#define DEVI __device__ __forceinline__
typedef unsigned short bf16_t;
typedef float f32x4 __attribute__((ext_vector_type(4)));
typedef unsigned u32x4 __attribute__((ext_vector_type(4)));
typedef unsigned u32x2 __attribute__((ext_vector_type(2)));
typedef short bf16x8_t __attribute__((ext_vector_type(8)));

constexpr int DM = 1024, TSEQ = 8192, NPR = 16384  , NSR = 128  , NTOK = NPR + NSR, MPAD = 16640  ;
constexpr int DIN = 3336, NZ = 3584, FF = 4096, NH = 4, DH = 64, NLAYER = 2, WB = 2048, DECB = 32, DECT = 4;
constexpr float EPSN = 1e-6f, NEGV = -1e30f;
constexpr int ZC_AQ = 0, ZC_AK = 256, ZC_AV = 512, ZC_BQ = 768, ZC_BK = 1024, ZC_BV = 1280, ZC_BO = 1536, ZC_CU = 1792, ZC_CV = 2048, ZC_DQ = 2304, ZC_DF = 2560, ZC_DI = 2816, ZC_DG = 3072;
constexpr int SRC_GATE = 1792, ZC_GI = 3328, ZC_GF = 3332;
enum { I_XP = 0, I_XS, I_CK, I_CV, I_MC, I_MN, I_MM, I_HS, I_RB, I_WIN, I_WOUT, I_GATTN, I_GMLP, I_WUP, I_WDN, I_BI, I_BF, I_GML, I_GCV, I_WS, I_BS, I_LB, I_GHG, I_GFIN, N_IN };
constexpr size_t O_YP = 0, O_YS = O_YP + (size_t)NPR * DM, O_KWP = O_YS + (size_t)NSR * DM, O_VWP = O_KWP + (size_t)NLAYER * 2 * WB * 256, O_KWS = O_VWP + (size_t)NLAYER * 2 * WB * 256,
                 O_VWS = O_KWS + (size_t)NLAYER * DECB * WB * 256, O_CP = O_VWS + (size_t)NLAYER * DECB * WB * 256, O_NP = O_CP + (size_t)NLAYER * 2 * NH * 4096, O_MP = O_NP + (size_t)NLAYER * 2 * NH * 64,
                 O_CS = O_MP + (size_t)NLAYER * 2 * NH, O_NS = O_CS + (size_t)NLAYER * DECB * NH * 4096, O_MS = O_NS + (size_t)NLAYER * DECB * NH * 64, O_SP = O_MS + (size_t)NLAYER * DECB * NH,
                 O_SS = O_SP + (size_t)NLAYER * 2 * NH * 4096, O_CVS = O_SS + (size_t)NLAYER * DECB * NH * 4096, O_END = O_CVS + (size_t)NLAYER * DECB * DECT * 256;
constexpr size_t MiB = 1u << 20;
constexpr size_t WS_CTL = 0, CTL_ZERO_BYTES = 64 * 1024;
constexpr size_t WS_WIN = 1 * MiB, WS_WOUT = 15 * MiB, WS_WUP = 19 * MiB, WS_WDN = 35 * MiB;
constexpr size_t WS_XN = 51 * MiB;
constexpr size_t WS_SMALL = 84 * MiB;
constexpr size_t WS_Z = 86 * MiB, WS_MIX = 200 * MiB, WS_H = WS_Z;
constexpr size_t WS_X1 = 233 * MiB, WS_X2 = 298 * MiB;
constexpr size_t WS_MU = 363 * MiB, WS_MCS = 372 * MiB, WS_HU = 381 * MiB, WS_HSS = 390 * MiB, WS_END = 399 * MiB;
static_assert(WS_Z + (size_t)MPAD * NZ * 2 <= WS_MIX && WS_MIX + (size_t)MPAD * DM * 2 <= WS_X1 && WS_H + (size_t)MPAD * FF * 2 <= WS_X1, "ws map");
static_assert(WS_WIN + 2 * (size_t)NZ * DM * 2 <= WS_WOUT && WS_XN + (size_t)MPAD * DM * 2 <= WS_SMALL, "ws map 2");
constexpr int CONV_ITEMS_PER_LAYER = 16 * ((3328 + 32) / 32) + 16 * 32 + 16 * (4096 / 32) + 64 * 32;
constexpr size_t SM_SSQ = 0, SM_BT = 1280 * 1024;
constexpr int NCHUNK = 64, NITEM_REC = 2 * NH * NCHUNK;
constexpr size_t REC_N_OFF = (size_t)NITEM_REC * 4096 * 4, REC_M_OFF = REC_N_OFF + (size_t)NITEM_REC * 64 * 4, REC_B_OFF = REC_M_OFF + (size_t)NITEM_REC * 4;
static_assert(REC_B_OFF + NITEM_REC * 4 <= 9 * MiB, "rec scratch");

constexpr int LDS_BYTES = 148480, NTHREADS = 512, EPI_STG = 131072;
#ifndef REP_ATT
#define REP_ATT 1
#endif
#ifndef REP_GMLP
#define REP_GMLP 1
#endif
#ifndef REP_STATE
#define REP_STATE 1
#endif
#ifndef REP_OUT
#define REP_OUT 1
#endif
#ifndef REP_COPY
#define REP_COPY 1
#endif
#ifndef REP_SATT
#define REP_SATT 1
#endif
#ifndef REP_SREC
#define REP_SREC 1
#endif


struct Params { const float* in[N_IN]; float* out; unsigned char* ws; int ph_lo, ph_hi; };

DEVI float bf2f(unsigned v) { return __uint_as_float(v << 16); }
DEVI unsigned pk2(float lo, float hi) { unsigned r; asm("v_cvt_pk_bf16_f32 %0, %1, %2" : "=v"(r) : "v"(lo), "v"(hi)); return r; }
DEVI unsigned f2bf(float f) { return pk2(f, 0.f) & 0xffffu; }
DEVI float bflo(unsigned u) { return __uint_as_float(u << 16); }
DEVI float bfhi(unsigned u) { return __uint_as_float(u & 0xffff0000u); }
DEVI void unpack8(const u32x4 u, float* f) { f[0] = bflo(u.x); f[1] = bfhi(u.x); f[2] = bflo(u.y); f[3] = bfhi(u.y); f[4] = bflo(u.z); f[5] = bfhi(u.z); f[6] = bflo(u.w); f[7] = bfhi(u.w); }
DEVI int lane_opaque() { unsigned z = 0u; asm volatile("" : "+s"(z)); return (int)__builtin_amdgcn_mbcnt_hi(~0u, __builtin_amdgcn_mbcnt_lo(~0u, z)); }
DEVI float shfl_xor_f(float v, int m) {
    const unsigned b = __builtin_bit_cast(unsigned, v);
    if (m == 32) { const auto r = __builtin_amdgcn_permlane32_swap(b, b, false, false); return __builtin_bit_cast(float, (lane_opaque() & 32) ? r[0] : r[1]); }
    if (m == 16) { const auto r = __builtin_amdgcn_permlane16_swap(b, b, false, false); return __builtin_bit_cast(float, (lane_opaque() & 16) ? r[0] : r[1]); }
    return __builtin_bit_cast(float, __builtin_amdgcn_ds_bpermute((lane_opaque() ^ m) << 2, __builtin_bit_cast(int, v)));
}
DEVI float shfl_up_f(float v, int o) { const int l = lane_opaque(); const int s = l - o; return __builtin_bit_cast(float, __builtin_amdgcn_ds_bpermute((s < 0 ? l : s) << 2, __builtin_bit_cast(int, v))); }
typedef short v4i16_t __attribute__((ext_vector_type(4)));
template <int PITCH = 144> DEVI bf16x8_t lds_tfrag(const LAS unsigned char* stage, int ks, int col, int gq) {
    const int i = col & 15, q = i >> 2, p = i & 3;
    const LAS unsigned char* a0 = stage + (32 * ks + 4 * gq + q) * PITCH + ((col - i) + 4 * p) * 2;
    const v4i16_t lo = __builtin_amdgcn_ds_read_tr16_b64_v4i16((LAS v4i16_t*)a0), hi = __builtin_amdgcn_ds_read_tr16_b64_v4i16((LAS v4i16_t*)(a0 + 16 * PITCH));
    return (bf16x8_t){lo[0], lo[1], lo[2], lo[3], hi[0], hi[1], hi[2], hi[3]};
}
DEVI float wave_sum(float v) {
#pragma unroll
    for (int o = 1; o < 64; o <<= 1) v += shfl_xor_f(v, o);
    return v;
}
DEVI float wave_max(float v) {
#pragma unroll
    for (int o = 1; o < 64; o <<= 1) v = fmaxf(v, shfl_xor_f(v, o));
    return v;
}
DEVI float sum8(float v) {
    v += __builtin_bit_cast(float, __builtin_amdgcn_update_dpp(0, __builtin_bit_cast(int, v), 0xB1, 0xF, 0xF, true));
    v += __builtin_bit_cast(float, __builtin_amdgcn_update_dpp(0, __builtin_bit_cast(int, v), 0x4E, 0xF, 0xF, true));
    v += __builtin_bit_cast(float, __builtin_amdgcn_update_dpp(0, __builtin_bit_cast(int, v), 0x141, 0xF, 0xF, true));
    return v;
}
DEVI float sum16(float v) {
    v = sum8(v);
    v += __builtin_bit_cast(float, __builtin_amdgcn_update_dpp(0, __builtin_bit_cast(int, v), 0x140, 0xF, 0xF, true));
    return v;
}
DEVI float frcp(float x) { return __builtin_amdgcn_rcpf(x); }
DEVI float sigmoidf_(float x) { return frcp(1.0f + __expf(-x)); }
DEVI float log1pexp_neg(float a) { return __logf(1.0f + __expf(-a)); }
DEVI float log_sigmoid(float x) { return fminf(x, 0.f) - log1pexp_neg(fabsf(x)); }
DEVI float gelu_tanh(float x) { const float u = 0.7978845608028654f * (x + 0.044715f * x * x * x); return x * frcp(1.0f + __expf(-2.0f * u)); }

#define GAS __attribute__((address_space(1)))
struct InPtrs { GAS const float* const __attribute__((address_space(4)))* p; DEVI const float* operator[](int i) const { return (const float*)p[i]; } };
struct ParamsDev { GAS const float* in[N_IN]; GAS float* out; GAS unsigned char* ws; int ph_lo, ph_hi; };
struct Ctx {
    InPtrs in; float* out; unsigned char* ws;
    LAS unsigned char* lds; int tid, lane, wave, G, bid;
    DEVI bf16_t* Z() const { return (bf16_t*)(ws + WS_Z); }
    DEVI bf16_t* MIX() const { return (bf16_t*)(ws + WS_MIX); }
    DEVI bf16_t* Hb() const { return (bf16_t*)(ws + WS_H); }
    DEVI bf16_t* X1() const { return (bf16_t*)(ws + WS_X1); }
    DEVI bf16_t* X2() const { return (bf16_t*)(ws + WS_X2); }
    DEVI float* SSQ() const { return (float*)(ws + WS_SMALL + SM_SSQ); }
    DEVI float* BT() const { return (float*)(ws + WS_SMALL + SM_BT); }
};

DEVI Ctx relaunder(const Ctx& c0) {
    Ctx c = c0; int t = c0.wave * 64 + lane_opaque(); asm volatile("" : "+v"(t)); c.tid = t; c.lane = t & 63; c.wave = c0.wave;
    auto inp = c0.in.p; asm volatile("" : "+s"(inp)); c.in.p = inp; GAS unsigned char* w = (GAS unsigned char*)c0.ws; asm volatile("" : "+s"(w)); c.ws = (unsigned char*)w; GAS float* o = (GAS float*)c0.out; asm volatile("" : "+s"(o)); c.out = (float*)o; return c;
}
constexpr int CW_QUEUE = 4096;
struct WorkQueue {
    unsigned* ctr; int nxt;
    DEVI void prefetch(const Ctx& c) { int t = 0; if (c.wave == 0 && lane_opaque() == 0) t = (int)__hip_atomic_fetch_add(ctr, 1u, __ATOMIC_RELAXED, __HIP_MEMORY_SCOPE_AGENT); nxt = t; }
    DEVI void start(const Ctx& c, unsigned* counter) { ctr = counter; nxt = 0; prefetch(c); }
    DEVI int pop(const Ctx& c) {
        LAS int* slot = (LAS int*)(c.lds + LDS_BYTES - 32);
        __syncthreads();
        if (c.wave == 0 && lane_opaque() == 0) *slot = nxt;
        __syncthreads();
        return *slot;
    }
};

DEVI float row_rs(const float* ssq, int row) {
    const f32x4* p = (const f32x4*)(ssq + (size_t)row * 16); const f32x4 a = p[0], b = p[1], c2 = p[2], d = p[3];
    const float s = ((a[0] + a[1]) + (a[2] + a[3])) + ((b[0] + b[1]) + (b[2] + b[3])) + ((c2[0] + c2[1]) + (c2[2] + c2[3])) + ((d[0] + d[1]) + (d[2] + d[3]));
    return rsqrtf(s * (1.0f / DM) + EPSN);
}
template <int ACT  > struct EpiRowScaleBf16 {
    static constexpr bool PERM = true, WIDE = true, AFTER_DRAIN = false;
    bf16_t* O; int ldc; const float* ssq; LAS unsigned char* stg;
    __device__ __forceinline__ void operator()(const pg8::f32x4 (&acc)[2][2][4][2], const pg8::Unit& u, int wr, int wc, int fr, int fq) const {
        const int row0 = u.pm * 256 + wr * 64 + fr;
        const int lane = fr + 16 * fq, rr = lane >> 3, sg = lane & 7;
        LAS unsigned char* my = stg + (wr * 4 + wc) * 2048;
        float rsv[2];
#pragma unroll
        for (int j = 0; j < 2; ++j) { const int row = row0 + (fq >> 1) * 128 + (2 * (fq & 1) + j) * 16; rsv[j] = row_rs(ssq, row < NTOK ? row : NTOK - 1); }
        bf16_t* obase = O + (size_t)(u.pm * 256 + wr * 64 + rr) * ldc + u.pn * 256 + wc * 64 + sg * 8;
#pragma unroll
        for (int ai = 0; ai < 2; ++ai)
#pragma unroll
            for (int m = 0; m < 4; ++m) {
                const float s = __builtin_bit_cast(float, __builtin_amdgcn_ds_bpermute((fr + 16 * (2 * ai + (m >> 1))) << 2, __builtin_bit_cast(int, rsv[m & 1])));
#pragma unroll
                for (int bj = 0; bj < 2; ++bj) {
                    pg8::f32x4 v0 = acc[ai][bj][m][0] * s, v1 = acc[ai][bj][m][1] * s;
                    if (ACT == 1) {
#pragma unroll
                        for (int e = 0; e < 4; ++e) { const float a = fmaxf(v0[e], 0.f), b = fmaxf(v1[e], 0.f); v0[e] = a * a; v1[e] = b * b; }
                    }
                    u32x4 w; w.x = pk2(v0[0], v0[1]); w.y = pk2(v0[2], v0[3]); w.z = pk2(v1[0], v1[1]); w.w = pk2(v1[2], v1[3]);
                    *(LAS u32x4*)(my + fr * 128 + (((bj * 4 + fq) ^ (fr & 7)) * 16)) = w;
                }
#pragma unroll
                for (int k = 0; k < 2; ++k) { const int r = rr + 8 * k; const u32x4 w = *(const LAS u32x4*)(my + r * 128 + ((sg ^ (r & 7)) * 16));
                    *(u32x4*)(obase + (size_t)(ai * 128 + m * 16 + 8 * k) * ldc) = w; }
            }
    }
};
struct EpiResidualNorm {
    static constexpr bool PERM = false, WIDE = false, AFTER_DRAIN = false;
    const bf16_t* base; bf16_t* out; float* ssq; LAS unsigned char* stg;
    __device__ __forceinline__ void operator()(const pg8::f32x4 (&acc)[2][2][4][2], const pg8::Unit& u, int wr, int wc, int fr, int fq) const {
        const int lane = fr + 16 * fq, rr = lane >> 3, sg = lane & 7;
        LAS unsigned char* my = stg + (wr * 4 + wc) * 2048;
        const int rbase = u.pm * 256 + wr * 64, cb = u.pn * 256 + wc * 32 + 4 * sg;
        u32x2 pre[4][2][2];
#define RN_LOAD(G) do { _Pragma("unroll") for (int k = 0; k < 2; ++k) _Pragma("unroll") for (int bj = 0; bj < 2; ++bj) \
            pre[(G) & 3][k][bj] = *(const u32x2*)(base + (size_t)(rbase + ((G) >> 2) * 128 + ((G) & 3) * 16 + rr + 8 * k) * DM + cb + bj * 128); } while (0)
        RN_LOAD(0); RN_LOAD(1); RN_LOAD(2); RN_LOAD(3);
        __builtin_amdgcn_sched_barrier(0);
#pragma unroll
        for (int G = 0; G < 8; ++G) {
            const int ai = G >> 2, m = G & 3; float ss[2] = {0.f, 0.f};
#pragma unroll
            for (int bj = 0; bj < 2; ++bj) {
#pragma unroll
                for (int n = 0; n < 2; ++n) *(LAS pg8::f32x4*)(my + fr * 128 + (((n * 4 + fq) ^ (fr & 7)) * 16)) = acc[ai][bj][m][n];
#pragma unroll
                for (int k = 0; k < 2; ++k) { const int r = rr + 8 * k; const pg8::f32x4 v = *(const LAS pg8::f32x4*)(my + r * 128 + ((sg ^ (r & 7)) * 16));
                    const u32x2 pb = pre[G & 3][k][bj]; const pg8::f32x4 x = (pg8::f32x4){bflo(pb.x), bfhi(pb.x), bflo(pb.y), bfhi(pb.y)} + v; const size_t o = (size_t)(rbase + ai * 128 + m * 16 + r) * DM + cb + bj * 128;
                    { u32x2 xb; xb.x = pk2(x[0], x[1]); xb.y = pk2(x[2], x[3]); *(u32x2*)(out + o) = xb; } ss[k] += (x[0] * x[0] + x[1] * x[1]) + (x[2] * x[2] + x[3] * x[3]); }
            }
            if (G + 4 < 8) RN_LOAD(G + 4);
#pragma unroll
            for (int k = 0; k < 2; ++k) { const float s = sum8(ss[k]); if (sg == 0) ssq[(size_t)(rbase + ai * 128 + m * 16 + rr + 8 * k) * 16 + u.pn * 4 + wc] = s; }
        }
#undef RN_LOAD
    }
};

template <class E> DEVI void skinny_gemm(const Ctx& c, const bf16_t* A, const bf16_t* Bt, int N, int K, const E& epi) {
    const int lane = c.lane, fr = lane & 15, gq = lane >> 4, ngrp = N >> 6, total = ngrp * 8, kw = K >> 3;
    LAS float* red = (LAS float*)c.lds;
    bf16x8_t a0[4], b0[4][4], a1[4], b1[4][4];
    const bf16_t* ap = A; const bf16_t* bp = Bt;
#define SK_PTRS(T) { const int ng_ = (T) % ngrp, mg_ = (T) / ngrp; ap = A + (size_t)(mg_ * 16 + fr) * K + c.wave * kw + 8 * gq; bp = Bt + (size_t)(ng_ * 64 + fr) * K + c.wave * kw + 8 * gq; }
#define SK_LOAD(AF, BF, KC) { _Pragma("unroll") for (int s4 = 0; s4 < 4; ++s4) { AF[s4] = *(const bf16x8_t*)(ap + (KC) + 32 * s4); _Pragma("unroll") for (int e = 0; e < 4; ++e) BF[s4][e] = *(const bf16x8_t*)(bp + (size_t)(16 * e) * K + (KC) + 32 * s4); } }
#define SK_MMA(AF, BF) { _Pragma("unroll") for (int s4 = 0; s4 < 4; ++s4) { _Pragma("unroll") for (int e = 0; e < 4; ++e) acc[e] = __builtin_amdgcn_mfma_f32_16x16x32_bf16(BF[s4][e], AF[s4], acc[e], 0, 0, 0); } }
    if (c.bid < total) { SK_PTRS(c.bid); SK_LOAD(a0, b0, 0); }
    for (int task = c.bid; task < total; task += c.G) {
        const int ng = task % ngrp, mg = task / ngrp;
        f32x4 acc[4];
#pragma unroll
        for (int e = 0; e < 4; ++e) acc[e] = (f32x4){0.f, 0.f, 0.f, 0.f};
#pragma unroll 1
        for (int kc = 0; kc < kw; kc += 256) {
            const bool h1 = kc + 128 < kw;
            if (h1) SK_LOAD(a1, b1, kc + 128);
            __builtin_amdgcn_sched_barrier(0);
            SK_MMA(a0, b0);
            __builtin_amdgcn_sched_barrier(0);
            if (h1) {
                if (kc + 256 < kw) SK_LOAD(a0, b0, kc + 256);
                __builtin_amdgcn_sched_barrier(0);
                SK_MMA(a1, b1);
                __builtin_amdgcn_sched_barrier(0);
            }
        }
        if (task + c.G < total) { SK_PTRS(task + c.G); SK_LOAD(a0, b0, 0); }
        __builtin_amdgcn_sched_barrier(0);
        __syncthreads();
#pragma unroll
        for (int e = 0; e < 4; ++e) *(LAS f32x4*)(red + ((c.wave * 4 + e) * 64 + lane) * 4) = acc[e];
        __syncthreads();
        { const int row = c.tid >> 5, cp = c.tid & 31, col = 2 * cp, e = col >> 4, g2 = (col >> 2) & 3, r = col & 3; float s0 = 0.f, s1 = 0.f;
#pragma unroll
          for (int w = 0; w < 8; ++w) { const LAS float* p = red + ((w * 4 + e) * 64 + (g2 * 16 + row)) * 4 + r; s0 += p[0]; s1 += p[1]; }
          float ss = epi.pair(mg * 16 + row, ng * 64 + col, s0, s1);
          ss += shfl_xor_f(ss, 1); ss += shfl_xor_f(ss, 2); ss += shfl_xor_f(ss, 4); ss += shfl_xor_f(ss, 8); ss += shfl_xor_f(ss, 16);
          if (cp == 0) epi.rowsum(mg * 16 + row, ng, ss); }
    }
#undef SK_PTRS
#undef SK_LOAD
#undef SK_MMA
    __syncthreads();
}
struct SkEpiResidualNorm {
    const bf16_t* base; bf16_t* out; float* ssq;
    DEVI float pair(int row, int col, float v0, float v1) const { const size_t o = (size_t)row * DM + col; const unsigned bb = *(const unsigned*)(base + o); const float x0 = bflo(bb) + v0, x1 = bfhi(bb) + v1; *(unsigned*)(out + o) = pk2(x0, x1); return x0 * x0 + x1 * x1; }
    DEVI void rowsum(int row, int slot, float s) const { ssq[(size_t)row * 16 + slot] = s; }
};
struct SkEpiRelu2 { bf16_t* H; const float* ssq;
    DEVI float pair(int row, int col, float v0, float v1) const { const float rs = row_rs(ssq, row); const float a = fmaxf(v0 * rs, 0.f), b = fmaxf(v1 * rs, 0.f); *(unsigned*)(H + (size_t)row * FF + col) = pk2(a * a, b * b); return 0.f; }
    DEVI void rowsum(int, int, float) const {}
};

DEVI void transpose_item(const float* W, int ldw, int src_col0, int K, bf16_t* WT, int dst_row0, LAS float* scr, int k0, int lane, const float* gk) {
    float wv[32];
#pragma unroll
    for (int i = 0; i < 32; ++i) wv[i] = __builtin_nontemporal_load(W + (size_t)(k0 + 2 * i + (lane >> 5)) * ldw + src_col0 + (lane & 31));
#pragma unroll
    for (int i = 0; i < 32; ++i) scr[(2 * i + (lane >> 5)) * 33 + (lane & 31)] = gk ? wv[i] * gk[k0 + 2 * i + (lane >> 5)] : wv[i];
    asm volatile("s_waitcnt lgkmcnt(0)" ::: "memory");
    const int c = lane & 7;
#pragma unroll
    for (int j = 0; j < 4; ++j) { const int n = (lane >> 3) + 8 * j; const LAS float* s = scr + (8 * c) * 33 + n;
        u32x4 o; o.x = pk2(s[0 * 33], s[1 * 33]); o.y = pk2(s[2 * 33], s[3 * 33]); o.z = pk2(s[4 * 33], s[5 * 33]); o.w = pk2(s[6 * 33], s[7 * 33]);
        *(u32x4*)(WT + (size_t)(dst_row0 + n) * K + k0 + 8 * c) = o; }
    asm volatile("s_waitcnt lgkmcnt(0)" ::: "memory");
}
DEVI int rel_bucket(int dist) {
    if (dist < 16) return dist;
    int large = 16 + (int)(log((double)dist / 16.0) / log(128.0) * 16.0);
    large = large < 16 ? 16 : (large > 31 ? 31 : large);
    return large;
}
DEVI void convert_weights(const Ctx& c, int it0, int it1, int wi, int nw) {
    LAS float* scr = (LAS float*)(c.lds + c.wave * 16384);
    constexpr int NZS = 3328 + 32;
    constexpr int I_IN = 16 * (NZS / 32), I_OUT = 16 * 32, I_UP = 16 * (FF / 32), I_DN = 64 * 32, I_L = I_IN + I_OUT + I_UP + I_DN;
    static_assert(I_L == CONV_ITEMS_PER_LAYER, "conversion item count");
    for (int it = it0 + wi; it < it1; it += nw) {
        const int l = it / I_L; int r = it % I_L;
        if (r < I_IN) { const int kb = r / (NZS / 32), nb = r % (NZS / 32), n0 = nb * 32;
            transpose_item(c.in[I_WIN] + (size_t)l * DM * DIN, DIN, n0 == 3328 ? SRC_GATE : n0 + (n0 >= SRC_GATE ? 8 : 0), DM, (bf16_t*)(c.ws + WS_WIN) + (size_t)l * NZ * DM, n0, scr, kb * 64, c.lane, c.in[I_GATTN] + l * DM); continue; }
        r -= I_IN;
        if (r < I_OUT) { const int kb = r / 32, nb = r % 32; transpose_item(c.in[I_WOUT] + (size_t)l * DM * DM, DM, nb * 32, DM, (bf16_t*)(c.ws + WS_WOUT) + (size_t)l * DM * DM, nb * 32, scr, kb * 64, c.lane, nullptr); continue; }
        r -= I_OUT;
        if (r < I_UP) { const int kb = r / (FF / 32), nb = r % (FF / 32); transpose_item(c.in[I_WUP] + (size_t)l * DM * FF, FF, nb * 32, DM, (bf16_t*)(c.ws + WS_WUP) + (size_t)l * FF * DM, nb * 32, scr, kb * 64, c.lane, c.in[I_GMLP] + l * DM); continue; }
        r -= I_UP;
        { const int kb = r / 32, nb = r % 32; transpose_item(c.in[I_WDN] + (size_t)l * FF * DM, DM, nb * 32, FF, (bf16_t*)(c.ws + WS_WDN) + (size_t)l * DM * FF, nb * 32, scr, kb * 64, c.lane, nullptr); }
    }
}
DEVI void phase_prologue(const Ctx& c) {
    const int gw = c.bid * 8 + c.wave, NGW = c.G * 8;
    convert_weights(c, 0, CONV_ITEMS_PER_LAYER, gw, NGW);
    for (int idx = c.bid * NTHREADS + c.tid; idx < NLAYER * 224 * (DM / 8); idx += c.G * NTHREADS) { const int l = idx / (224 * (DM / 8)), r = idx % (224 * (DM / 8));
        *(u32x4*)((bf16_t*)(c.ws + WS_WIN) + (size_t)l * NZ * DM + (size_t)3360 * DM + (size_t)r * 8) = (u32x4){0u, 0u, 0u, 0u}; }
    for (int row0 = gw; row0 < NTOK; row0 += 3 * NGW) {
        f32x4 v[3][4];
#pragma unroll
        for (int r = 0; r < 3; ++r) { const int row = row0 + r * NGW < NTOK ? row0 + r * NGW : row0;
            const float* xr = (row < NPR) ? c.in[I_XP] + (size_t)row * DM : c.in[I_XS] + (size_t)(row - NPR) * DM;
#pragma unroll
            for (int j = 0; j < 4; ++j) v[r][j] = __builtin_nontemporal_load((const f32x4*)(xr + 256 * j + 4 * c.lane)); }
        __builtin_amdgcn_sched_barrier(0);
#pragma unroll
        for (int r = 0; r < 3; ++r) { const int row = row0 + r * NGW; if (row < NTOK) {
            float ss = 0.f; u32x2* xb = (u32x2*)(c.X2() + (size_t)row * DM);
#pragma unroll
            for (int j = 0; j < 4; ++j) { ss += (v[r][j][0] * v[r][j][0] + v[r][j][1] * v[r][j][1]) + (v[r][j][2] * v[r][j][2] + v[r][j][3] * v[r][j][3]);
                u32x2 w2; w2.x = pk2(v[r][j][0], v[r][j][1]); w2.y = pk2(v[r][j][2], v[r][j][3]); xb[64 * j + c.lane] = w2; }
            ss = wave_sum(ss);
            if (c.lane < 16) c.SSQ()[(size_t)row * 16 + c.lane] = c.lane == 0 ? ss : 0.f; } }
    }
    if (c.bid == 0) {
        for (int i = c.tid; i < 3 * 129 * 4; i += NTHREADS) { const int h = i & 3, j = (i >> 2) % 129, pat = (i >> 2) / 129; const int d = pat == 0 ? 1 : (pat == 1 ? 4 : 16);
            c.BT()[i] = c.in[I_RB][rel_bucket(j * d) * 4 + h]; }
    }
}

DEVI void attn_sample_qh(const Ctx& c, int layer, int b, int h, int t) {
    const bf16_t* Z = c.Z(); const int lane = c.lane, kg = lane >> 4, c4 = lane & 15;
    const size_t rbase = (size_t)(NPR + b * DECT);
    const size_t qrow = rbase + t;
    LAS float* pl = (LAS float*)(c.lds + c.wave * 1024);
    const u32x2 qu = *(const u32x2*)(Z + qrow * NZ + ZC_AQ + h * 64 + 4 * c4);
    const f32x4 q4 = (f32x4){bflo(qu.x), bfhi(qu.x), bflo(qu.y), bfhi(qu.y)};
    const float* bt = c.BT() + h;
    const float* ck = c.in[I_CK] + ((size_t)(layer * DECB + b) * WB) * 256 + h * 64;
    const float* cv = c.in[I_CV] + ((size_t)(layer * DECB + b) * WB) * 256 + h * 64;
    float Mx = NEGV, wsum = 0.f; f32x4 accv = (f32x4){0.f, 0.f, 0.f, 0.f};
#pragma unroll 1
    for (int pat = 0; pat < 3; ++pat) {
        const int d = 1 << (2 * pat);
        const float* btp = bt + pat * 129 * 4;
        const int pos0 = t - kg * d; const bool isz = pos0 >= 0; const int zp = isz ? pos0 : 0, cp = isz ? -1 : pos0;
        const unsigned loff = (unsigned)((3 - kg) * d * 256 + 4 * c4), loff0 = (unsigned)((WB + cp) * 256 + 4 * c4), loff32 = (unsigned)(4 * c4);
        float lg[33]; f32x4 kv[33];
        const u32x2 uk = *(const u32x2*)(Z + (rbase + zp) * NZ + ZC_AK + h * 64 + 4 * c4);
        kv[0] = *(const f32x4*)(ck + loff0);
#pragma unroll
        for (int it = 1; it < 32; ++it) kv[it] = *(const f32x4*)(ck + (size_t)(WB + t - (4 * it + 3) * d) * 256 + loff);
        kv[32] = *(const f32x4*)(ck + (size_t)(WB + t - 128 * d) * 256 + loff32);
        { const float b0 = btp[lane * 4], b1 = btp[(64 + lane) * 4], b2 = btp[128 * 4]; pl[lane] = b0; pl[64 + lane] = b1; pl[128 + lane] = b2; }
        __builtin_amdgcn_sched_barrier(0);
        kv[0] = (f32x4){isz ? bflo(uk.x) : kv[0][0], isz ? bfhi(uk.x) : kv[0][1], isz ? bflo(uk.y) : kv[0][2], isz ? bfhi(uk.y) : kv[0][3]};
#pragma unroll
        for (int it = 0; it < 33; ++it) {
            const float dot = sum16((q4[0] * kv[it][0] + q4[1] * kv[it][1]) + (q4[2] * kv[it][2] + q4[3] * kv[it][3]));
            lg[it] = (it < 32 || kg == 0) ? dot * 0.125f + pl[4 * it + kg] : NEGV;
        }
        __builtin_amdgcn_sched_barrier(0);
        const u32x2 uv = *(const u32x2*)(Z + (rbase + zp) * NZ + ZC_AV + h * 64 + 4 * c4);
        kv[0] = *(const f32x4*)(cv + loff0);
#pragma unroll
        for (int it = 1; it < 32; ++it) kv[it] = *(const f32x4*)(cv + (size_t)(WB + t - (4 * it + 3) * d) * 256 + loff);
        kv[32] = *(const f32x4*)(cv + (size_t)(WB + t - 128 * d) * 256 + loff32);
        __builtin_amdgcn_sched_barrier(0);
        float m = lg[0];
#pragma unroll
        for (int it = 1; it < 33; ++it) m = fmaxf(m, lg[it]);
        m = fmaxf(m, shfl_xor_f(m, 16)); m = fmaxf(m, shfl_xor_f(m, 32));
        float den = 0.f;
#pragma unroll
        for (int it = 0; it < 33; ++it) { lg[it] = __expf(lg[it] - m); den += lg[it]; }
        den += shfl_xor_f(den, 16); den += shfl_xor_f(den, 32);
        __builtin_amdgcn_sched_barrier(0);
        f32x4 o4 = (f32x4){isz ? bflo(uv.x) : kv[0][0], isz ? bfhi(uv.x) : kv[0][1], isz ? bflo(uv.y) : kv[0][2], isz ? bfhi(uv.y) : kv[0][3]} * lg[0];
#pragma unroll
        for (int it = 1; it < 33; ++it) o4 += kv[it] * lg[it];
#pragma unroll
        for (int e = 0; e < 4; ++e) { o4[e] += shfl_xor_f(o4[e], 16); o4[e] += shfl_xor_f(o4[e], 32); }
        const float lse = m + __logf(den), Mn = fmaxf(Mx, lse), sc = __expf(Mx - Mn), wp = __expf(lse - Mn);
        accv = accv * sc + o4 * (wp / den); wsum = wsum * sc + wp; Mx = Mn;
    }
    if (kg == 0) { const f32x4 r = accv * (1.0f / wsum); u32x2 w; w.x = pk2(r[0], r[1]); w.y = pk2(r[2], r[3]); *(u32x2*)(c.MIX() + qrow * DM + h * 64 + 4 * c4) = w; }
}

constexpr int AT_LBW = 192;
constexpr int AT_OA = 0, AT_LM = 65536, AT_LW = AT_LM + 1024, AT_LB = AT_LW + 1024, AT_VS = AT_LB + 3 * AT_LBW * 4, AT_VS_WAVE = 32 * 144;
static_assert(AT_VS % 16 == 0 && AT_VS + 8 * AT_VS_WAVE <= LDS_BYTES - 64, "attention LDS map");
DEVI void attn_block_item(const Ctx& c, int layer, int b, int h, int blk, WorkQueue& q) {
    const int lane = c.lane, i = lane & 15, gq = lane >> 4;
    LAS float* OA = (LAS float*)(c.lds + AT_OA); LAS float* LM = (LAS float*)(c.lds + AT_LM); LAS float* LW = (LAS float*)(c.lds + AT_LW); LAS float* LB = (LAS float*)(c.lds + AT_LB);
    LAS unsigned char* VS = c.lds + AT_VS + c.wave * AT_VS_WAVE;
    __syncthreads();
    for (int idx = c.tid; idx < 3 * AT_LBW; idx += NTHREADS) { const int pat = idx / AT_LBW, x = idx % AT_LBW - 16, j = 128 - x; LB[idx] = (j >= 0 && j <= 128) ? 1.4426950408889634f * c.BT()[(pat * 129 + j) * 4 + h] : 0.f; }
    __syncthreads();
    const int base = blk * 256;
    const char* zb = (const char*)(c.Z() + (size_t)b * TSEQ * NZ + h * 64);
#define AT_T0(PAT, TK) (base + ((PAT) == 0 ? 16 * (TK) : ((PAT) == 1 ? 64 * ((TK) >> 2) + ((TK) & 3) : (TK))))
    bf16x8_t qf[2], kfr[9][2];
#define AT_KQLOAD(PAT, TK) do { const int d_ = 1 << (2 * (PAT)), t0_ = AT_T0(PAT, TK); const unsigned lk_ = (unsigned)((d_ * i * NZ + 8 * gq) * 2); \
        { const char* qb = zb + ((size_t)(unsigned)t0_ * NZ + ZC_AQ) * 2; qf[0] = *(const bf16x8_t*)(qb + lk_); qf[1] = *(const bf16x8_t*)(qb + lk_ + 64); } \
        _Pragma("unroll") for (int kt = 0; kt < 9; ++kt) { int u_ = t0_ + d_ * (16 * kt - 128); u_ = u_ < 0 ? 0 : u_;     \
            const char* kb = zb + ((size_t)(unsigned)u_ * NZ + ZC_AK) * 2; kfr[kt][0] = *(const bf16x8_t*)(kb + lk_); kfr[kt][1] = *(const bf16x8_t*)(kb + lk_ + 64); } } while (0)
    AT_KQLOAD(0, c.wave);
#pragma unroll 1
    for (int ti = 0; ti < 6; ++ti) {
        {
            const int pat = ti >> 1, tk = c.wave + 8 * (ti & 1), d = 1 << (2 * pat);
            const int t0 = AT_T0(pat, tk);
            const int tq = t0 + d * i;
            const int kmin = 128 - (t0 >> (2 * pat));
            const int vrow0 = lane >> 3;
            u32x4 vr[5][4];
            const unsigned lv = (unsigned)((d * vrow0 * NZ + 8 * (lane & 7)) * 2);
#define AT_VLOAD(S5) do { _Pragma("unroll") for (int n = 0; n < ((S5) == 4 ? 2 : 4); ++n) { int uv = t0 + d * (32 * (S5) + 8 * n - 128); uv = uv < 0 ? 0 : uv;     \
                vr[(S5)][n] = *(const u32x4*)(zb + ((size_t)(unsigned)uv * NZ + ZC_AV) * 2 + lv); } } while (0)
            AT_VLOAD(0); AT_VLOAD(1); AT_VLOAD(2); AT_VLOAD(3); AT_VLOAD(4);
            __builtin_amdgcn_sched_barrier(0);
            f32x4 s[10];
#pragma unroll
            for (int kt = 0; kt < 9; ++kt) {
                f32x4 a = (f32x4){0.f, 0.f, 0.f, 0.f};
                a = __builtin_amdgcn_mfma_f32_16x16x32_bf16(kfr[kt][0], qf[0], a, 0, 0, 0);
                a = __builtin_amdgcn_mfma_f32_16x16x32_bf16(kfr[kt][1], qf[1], a, 0, 0, 0);
                s[kt] = a;
            }
            s[9] = (f32x4){0.f, 0.f, 0.f, 0.f};
            const LAS float* lb = LB + pat * AT_LBW + 16 + 4 * gq - i;
            float mx = NEGV;
#pragma unroll
            for (int half = 0; half < 2; ++half) {
                float bz[5][4];
#pragma unroll
                for (int k5 = 0; k5 < 5; ++k5) { const int kt = 5 * half + k5; if (kt < 9) {
#pragma unroll
                    for (int r = 0; r < 4; ++r) bz[k5][r] = lb[16 * kt + r]; } }
                __builtin_amdgcn_sched_barrier(0);
#pragma unroll
                for (int k5 = 0; k5 < 5; ++k5) { const int kt = 5 * half + k5; if (kt < 9) {
#pragma unroll
                    for (int r = 0; r < 4; ++r) {
                        const bool valid = kt == 0 ? (kmin <= 0 && 4 * gq + r >= i) : (kt == 8 ? (4 * gq + r <= i) : (16 * kt >= kmin));
                        const float lg = valid ? s[kt][r] * (0.125f * 1.4426950408889634f) + bz[k5][r] : NEGV;
                        s[kt][r] = lg; mx = fmaxf(mx, lg);
                    } } }
                __builtin_amdgcn_sched_barrier(0);
            }
            mx = fmaxf(mx, shfl_xor_f(mx, 16)); mx = fmaxf(mx, shfl_xor_f(mx, 32));
            float den = 0.f;
#pragma unroll
            for (int kt = 0; kt < 9; ++kt)
#pragma unroll
                for (int r = 0; r < 4; ++r) { const float pv = __builtin_amdgcn_exp2f(s[kt][r] - mx); s[kt][r] = pv; den += pv; }
            den += shfl_xor_f(den, 16); den += shfl_xor_f(den, 32);
            u32x4 pf[5];
#pragma unroll
            for (int s5 = 0; s5 < 5; ++s5) { pf[s5].x = pk2(s[2 * s5][0], s[2 * s5][1]); pf[s5].y = pk2(s[2 * s5][2], s[2 * s5][3]); pf[s5].z = pk2(s[2 * s5 + 1][0], s[2 * s5 + 1][1]); pf[s5].w = pk2(s[2 * s5 + 1][2], s[2 * s5 + 1][3]); }
            f32x4 o[4];
#pragma unroll
            for (int dt = 0; dt < 4; ++dt) o[dt] = (f32x4){0.f, 0.f, 0.f, 0.f};
#pragma unroll
            for (int s5 = 0; s5 < 5; ++s5) {
                __builtin_amdgcn_sched_barrier(0);
                if (s5 == 2 && ti == 5) q.prefetch(c);
                if (s5 == 2 && ti + 1 < 6) { const int np_ = (ti + 1) >> 1, ntk_ = c.wave + 8 * ((ti + 1) & 1); AT_KQLOAD(np_, ntk_); }
#pragma unroll
                for (int n = 0; n < 4; ++n) *(LAS u32x4*)(VS + (vrow0 + 8 * n) * 144 + (lane & 7) * 16) = (s5 == 4 && n >= 2) ? vr[4][n - 2] : vr[s5][n];
#pragma unroll
                for (int dt = 0; dt < 4; ++dt) {
                    union { u32x4 u; bf16x8_t v; } pp; pp.u = pf[s5];
                    o[dt] = __builtin_amdgcn_mfma_f32_16x16x32_bf16(lds_tfrag<144>(VS, 0, 16 * dt + i, gq), pp.v, o[dt], 0, 0, 0);
                }
            }
#undef AT_VLOAD
            const float inv = frcp(den), lse = mx + __builtin_amdgcn_logf(den); const int tok = tq - base;
            if (pat == 0) {
#pragma unroll
                for (int dt = 0; dt < 4; ++dt) *(LAS f32x4*)(OA + tok * 64 + 16 * dt + 4 * gq) = o[dt] * inv;
                if (gq == 0) { LM[tok] = lse; LW[tok] = 1.0f; }
            } else {
                const float Mo = LM[tok], Wo = LW[tok]; const float Mn = fmaxf(Mo, lse), sc = __builtin_amdgcn_exp2f(Mo - Mn), wl = __builtin_amdgcn_exp2f(lse - Mn), wp = wl * inv; const float wn = Wo * sc + wl;
                if (pat == 1) {
#pragma unroll
                    for (int dt = 0; dt < 4; ++dt) o[dt] = (*(const LAS f32x4*)(OA + tok * 64 + 16 * dt + 4 * gq)) * sc + o[dt] * wp;
#pragma unroll
                    for (int dt = 0; dt < 4; ++dt) *(LAS f32x4*)(OA + tok * 64 + 16 * dt + 4 * gq) = o[dt];
                    asm volatile("s_waitcnt lgkmcnt(0)" ::: "memory");
                    if (gq == 0) { LM[tok] = Mn; LW[tok] = wn; }
                } else {
                    const float rw = frcp(wn);
#pragma unroll
                    for (int dt = 0; dt < 4; ++dt) o[dt] = ((*(const LAS f32x4*)(OA + tok * 64 + 16 * dt + 4 * gq)) * sc + o[dt] * wp) * rw;
#pragma unroll
                    for (int dt = 0; dt < 4; ++dt) { const f32x4 r = o[dt];
                        u32x2 w; w.x = pk2(r[0], r[1]); w.y = pk2(r[2], r[3]); *(u32x2*)(c.MIX() + ((size_t)b * TSEQ + tq) * DM + h * 64 + 16 * dt + 4 * gq) = w; }
                }
            }
        }
        if (ti & 1) __syncthreads();
    }
#undef AT_KQLOAD
#undef AT_T0
}

DEVI void gmlp_item(const Ctx& c, int layer, size_t row0, int nrows, float* chunk_v_out) {
    LAS float* vr = (LAS float*)c.lds;
    const bf16_t* Z = c.Z(); const int lane = c.lane;
    const float* gcv = c.in[I_GCV] + layer * 256;
    __syncthreads();
    for (int r = c.wave; r < nrows; r += 8) {
        const u32x2 u = *(const u32x2*)(Z + (row0 + r) * NZ + ZC_CV + 4 * lane);
        float e0 = gelu_tanh(bflo(u.x)), e1 = gelu_tanh(bfhi(u.x)), e2 = gelu_tanh(bflo(u.y)), e3 = gelu_tanh(bfhi(u.y));
        const float ss = wave_sum((e0 * e0 + e1 * e1) + (e2 * e2 + e3 * e3));
        const float rs = rsqrtf(ss * (1.0f / 256.0f) + EPSN);
        const f32x4 gv = *(const f32x4*)(gcv + 4 * lane);
        f32x4 o; o[0] = e0 * rs * gv[0]; o[1] = e1 * rs * gv[1]; o[2] = e2 * rs * gv[2]; o[3] = e3 * rs * gv[3];
        *(LAS f32x4*)(vr + r * 260 + 4 * lane) = o;
        if (chunk_v_out) *(f32x4*)(chunk_v_out + (size_t)r * 256 + 4 * lane) = o;
    }
    __syncthreads();
    const int t = c.tid >> 2, hh = c.tid & 3;
    const float* wrow = c.in[I_WS] + ((size_t)(layer * NH + hh) * 128 + t) * 128;
    int smax = c.wave * 16 + 15; if (smax > nrows - 1) smax = nrows - 1;
    const float bsv = (t < nrows) ? c.in[I_BS][(layer * NH + hh) * 128 + t] : 0.f;
#pragma unroll 1
    for (int half = 0; half < 2; ++half) {
        float acc[32];
#pragma unroll
        for (int i = 0; i < 32; ++i) acc[i] = 0.f;
#pragma unroll 1
        for (int s = 0; s <= smax; ++s) {
            const float w = (s <= t && t < nrows) ? wrow[s] : 0.f;
            const LAS f32x4* vp = (const LAS f32x4*)(vr + s * 260 + hh * 64 + half * 32);
#pragma unroll
            for (int i = 0; i < 8; ++i) { const f32x4 v = vp[i]; acc[4 * i] += w * v[0]; acc[4 * i + 1] += w * v[1]; acc[4 * i + 2] += w * v[2]; acc[4 * i + 3] += w * v[3]; }
        }
        if (t < nrows) {
            const u32x4* up = (const u32x4*)(Z + (row0 + t) * NZ + ZC_CU + hh * 64 + half * 32);
            u32x4* mp = (u32x4*)(c.MIX() + (row0 + t) * DM + 512 + hh * 64 + half * 32);
#pragma unroll
            for (int i = 0; i < 4; ++i) { float uf[8]; unpack8(up[i], uf); float o[8];
#pragma unroll
                for (int e = 0; e < 8; ++e) o[e] = gelu_tanh(uf[e]) * (acc[8 * i + e] + bsv);
                u32x4 w; w.x = pk2(o[0], o[1]); w.y = pk2(o[2], o[3]); w.z = pk2(o[4], o[5]); w.w = pk2(o[6], o[7]); mp[i] = w; }
        }
    }
    __syncthreads();
}

constexpr int L_A0 = 0, L_A1 = 4096, L_A2 = 8192, L_A3 = 12288, L_HB = 16384, L_SC = 20480;
struct RecIO {
    const float* st_in;
    const float* n_in; const float* m_in;
    float* st_out; float* n_out; float* m_out; float* b_out;
    bool native_in, native_out;
};
template <bool OUT> DEVI void mlstm_item(const Ctx& c, int layer, int hh, size_t row0, int nt, const RecIO& io, float m_init) {
    LAS float* L = (LAS float*)c.lds; const bf16_t* Z = c.Z(); const int tid = c.tid, v = tid >> 3, g = tid & 7;
    float C[8], n[8], m;
    if (io.st_in) { const f32x4 a = *(const f32x4*)(io.st_in + tid * 8), b = *(const f32x4*)(io.st_in + tid * 8 + 4); C[0] = a[0]; C[1] = a[1]; C[2] = a[2]; C[3] = a[3]; C[4] = b[0]; C[5] = b[1]; C[6] = b[2]; C[7] = b[3];
        const f32x4 na = *(const f32x4*)(io.n_in + g * 8), nb = *(const f32x4*)(io.n_in + g * 8 + 4); n[0] = na[0]; n[1] = na[1]; n[2] = na[2]; n[3] = na[3]; n[4] = nb[0]; n[5] = nb[1]; n[6] = nb[2]; n[7] = nb[3]; m = io.m_in[0]; }
    else {
#pragma unroll
        for (int j = 0; j < 8; ++j) { C[j] = 0.f; n[j] = 0.f; } m = m_init; }
    float bsum = 0.f;
    const float gbi = c.in[I_BI][layer * 4 + hh], gbf = c.in[I_BF][layer * 4 + hh];
    for (int seg = 0; seg < nt; seg += 64) {
        const int ns = (nt - seg) < 64 ? (nt - seg) : 64;
        __syncthreads();
        { const int tt = tid >> 3;
          if (tt < ns) { const size_t zr = (row0 + seg + tt) * NZ + hh * 64 + g * 8; float f[8];
            if (OUT) { unpack8(*(const u32x4*)(Z + zr + ZC_BQ), f); *(LAS f32x4*)(L + L_A0 + tt * 64 + g * 8) = (f32x4){f[0], f[1], f[2], f[3]}; *(LAS f32x4*)(L + L_A0 + tt * 64 + g * 8 + 4) = (f32x4){f[4], f[5], f[6], f[7]}; }
            unpack8(*(const u32x4*)(Z + zr + ZC_BK), f); *(LAS f32x4*)(L + L_A1 + tt * 64 + g * 8) = (f32x4){f[0], f[1], f[2], f[3]} * 0.125f; *(LAS f32x4*)(L + L_A1 + tt * 64 + g * 8 + 4) = (f32x4){f[4], f[5], f[6], f[7]} * 0.125f;
            unpack8(*(const u32x4*)(Z + zr + ZC_BV), f); *(LAS f32x4*)(L + L_A2 + tt * 64 + g * 8) = (f32x4){f[0], f[1], f[2], f[3]}; *(LAS f32x4*)(L + L_A2 + tt * 64 + g * 8 + 4) = (f32x4){f[4], f[5], f[6], f[7]}; }
          if (tid < ns) { L[L_SC + tid] = bf2f(Z[(row0 + seg + tid) * NZ + ZC_GI + hh]) + gbi; L[L_SC + 64 + tid] = log_sigmoid(bf2f(Z[(row0 + seg + tid) * NZ + ZC_GF + hh]) + gbf); } }
        __syncthreads();
#pragma unroll 2
        for (int tt = 0; tt < ns; ++tt) {
            const float ii = L[L_SC + tt], lf = L[L_SC + 64 + tt];
            const float mn = fmaxf(lf + m, ii);
            const float a = __expf(lf + m - mn), bb = __expf(ii - mn);
            bsum += lf; m = mn;
            const float bv = bb * L[L_A2 + tt * 64 + v];
            const f32x4 k0 = *(const LAS f32x4*)(L + L_A1 + tt * 64 + g * 8), k1 = *(const LAS f32x4*)(L + L_A1 + tt * 64 + g * 8 + 4);
            const float kk[8] = {k0[0], k0[1], k0[2], k0[3], k1[0], k1[1], k1[2], k1[3]};
#pragma unroll
            for (int j = 0; j < 8; ++j) { C[j] = a * C[j] + bv * kk[j]; n[j] = a * n[j] + bb * kk[j]; }
            if (OUT) {
                const f32x4 q0 = *(const LAS f32x4*)(L + L_A0 + tt * 64 + g * 8), q1 = *(const LAS f32x4*)(L + L_A0 + tt * 64 + g * 8 + 4);
                const float qq[8] = {q0[0], q0[1], q0[2], q0[3], q1[0], q1[1], q1[2], q1[3]};
                float num = 0.f, nq = 0.f;
#pragma unroll
                for (int j = 0; j < 8; ++j) { num += C[j] * qq[j]; nq += n[j] * qq[j]; }
                num = sum8(num); nq = sum8(nq);
                const float den = fmaxf(fabsf(nq), __expf(-mn));
                if (g == 0) L[L_HB + tt * 64 + v] = num / den;
            }
        }
        if (OUT) {
            __syncthreads();
            const int tt = tid >> 3;
            if (tt < ns) {
                const f32x4 h0 = *(const LAS f32x4*)(L + L_HB + tt * 64 + g * 8), h1 = *(const LAS f32x4*)(L + L_HB + tt * 64 + g * 8 + 4);
                float hv[8] = {h0[0], h0[1], h0[2], h0[3], h1[0], h1[1], h1[2], h1[3]}; float ss = 0.f;
#pragma unroll
                for (int j = 0; j < 8; ++j) ss += hv[j] * hv[j];
                ss = sum8(ss);
                const float rs = rsqrtf(ss * (1.0f / 64.0f) + EPSN);
                const float* gm = c.in[I_GML] + layer * 256 + hh * 64 + g * 8; float bo[8];
                unpack8(*(const u32x4*)(Z + (row0 + seg + tt) * NZ + ZC_BO + hh * 64 + g * 8), bo); float o[8];
#pragma unroll
                for (int j = 0; j < 8; ++j) o[j] = sigmoidf_(bo[j]) * (hv[j] * rs * gm[j]);
                u32x4 w; w.x = pk2(o[0], o[1]); w.y = pk2(o[2], o[3]); w.z = pk2(o[4], o[5]); w.w = pk2(o[6], o[7]);
                *(u32x4*)(c.MIX() + (row0 + seg + tt) * DM + 256 + hh * 64 + g * 8) = w;
            }
        }
    }
    if (io.st_out) { *(f32x4*)(io.st_out + tid * 8) = (f32x4){C[0], C[1], C[2], C[3]}; *(f32x4*)(io.st_out + tid * 8 + 4) = (f32x4){C[4], C[5], C[6], C[7]};
        if (v == 0) { *(f32x4*)(io.n_out + g * 8) = (f32x4){n[0], n[1], n[2], n[3]}; *(f32x4*)(io.n_out + g * 8 + 4) = (f32x4){n[4], n[5], n[6], n[7]}; }
        if (tid == 0) { io.m_out[0] = m; if (io.b_out) io.b_out[0] = bsum; } }
    __syncthreads();
}
DEVI float hgrn_lb(const Ctx& c, int layer, int col) {
    if (layer == 0) return 0.f;
    const float a = c.in[I_LB][col], b = c.in[I_LB][256 + col]; const float mx = fmaxf(a, b); const float ea = __expf(a - mx), eb = __expf(b - mx);
    return eb * frcp(ea + eb);
}
DEVI void hgrn_lb8(const Ctx& c, int layer, int col0, float* out) {
    if (layer == 0) {
#pragma unroll
        for (int j = 0; j < 8; ++j) out[j] = 0.f;
        return; }
    const float* lb = c.in[I_LB];
    const f32x4 a0 = *(const f32x4*)(lb + col0), a1 = *(const f32x4*)(lb + col0 + 4), b0 = *(const f32x4*)(lb + 256 + col0), b1 = *(const f32x4*)(lb + 256 + col0 + 4);
#pragma unroll
    for (int j = 0; j < 8; ++j) { const float a = j < 4 ? a0[j & 3] : a1[j & 3], b = j < 4 ? b0[j & 3] : b1[j & 3]; const float mx = fmaxf(a, b); const float ea = __expf(a - mx), eb = __expf(b - mx); out[j] = eb * frcp(ea + eb); }
}
template <bool OUT> DEVI void hgrn_item(const Ctx& c, int layer, int hh, size_t row0, int nt, const RecIO& io) {
    LAS float* L = (LAS float*)c.lds; const bf16_t* Z = c.Z(); const int tid = c.tid, v = tid >> 3, g = tid & 7;
    float S[8], fs[8];
#pragma unroll
    for (int j = 0; j < 8; ++j) { fs[j] = 0.f;
        S[j] = io.st_in ? (io.native_in ? io.st_in[tid * 8 + j] : io.st_in[(g * 8 + j) * 64 + v]) : 0.f; }
    float lbv[8], llb[8], l1m[8];
    {
        hgrn_lb8(c, layer, hh * 64 + g * 8, lbv);
#pragma unroll
        for (int j = 0; j < 8; ++j) { llb[j] = __logf(fmaxf(lbv[j], 1e-30f)); l1m[j] = __logf(1.0f - lbv[j]); }
    }
    for (int seg = 0; seg < nt; seg += 64) {
        const int ns = (nt - seg) < 64 ? (nt - seg) : 64;
        __syncthreads();
        { const int tt = tid >> 3;
          if (tt < ns) { const size_t zr = (row0 + seg + tt) * NZ + hh * 64 + g * 8; float f[8];
            if (OUT) { unpack8(*(const u32x4*)(Z + zr + ZC_DQ), f); *(LAS f32x4*)(L + L_A0 + tt * 64 + g * 8) = (f32x4){f[0], f[1], f[2], f[3]}; *(LAS f32x4*)(L + L_A0 + tt * 64 + g * 8 + 4) = (f32x4){f[4], f[5], f[6], f[7]}; }
            unpack8(*(const u32x4*)(Z + zr + ZC_DF), f); float ff[8], kd[8];
#pragma unroll
            for (int j = 0; j < 8; ++j) { const float x1 = llb[j], x2 = l1m[j] + log_sigmoid(f[j]); const float mx = fmaxf(x1, x2); const float lfd = mx + log1pexp_neg(fabsf(x1 - x2));
                ff[j] = lfd; kd[j] = (1.0f - lbv[j]) * sigmoidf_(-f[j]); }
            *(LAS f32x4*)(L + L_A1 + tt * 64 + g * 8) = (f32x4){ff[0], ff[1], ff[2], ff[3]}; *(LAS f32x4*)(L + L_A1 + tt * 64 + g * 8 + 4) = (f32x4){ff[4], ff[5], ff[6], ff[7]};
            *(LAS f32x4*)(L + L_A2 + tt * 64 + g * 8) = (f32x4){kd[0], kd[1], kd[2], kd[3]}; *(LAS f32x4*)(L + L_A2 + tt * 64 + g * 8 + 4) = (f32x4){kd[4], kd[5], kd[6], kd[7]};
            unpack8(*(const u32x4*)(Z + zr + ZC_DI), f); *(LAS f32x4*)(L + L_A3 + tt * 64 + g * 8) = (f32x4){f[0], f[1], f[2], f[3]}; *(LAS f32x4*)(L + L_A3 + tt * 64 + g * 8 + 4) = (f32x4){f[4], f[5], f[6], f[7]}; } }
        __syncthreads();
#pragma unroll 2
        for (int tt = 0; tt < ns; ++tt) {
            const float vv = L[L_A3 + tt * 64 + v];
            const f32x4 f0 = *(const LAS f32x4*)(L + L_A1 + tt * 64 + g * 8), f1 = *(const LAS f32x4*)(L + L_A1 + tt * 64 + g * 8 + 4);
            const f32x4 k0 = *(const LAS f32x4*)(L + L_A2 + tt * 64 + g * 8), k1 = *(const LAS f32x4*)(L + L_A2 + tt * 64 + g * 8 + 4);
            const float lf[8] = {f0[0], f0[1], f0[2], f0[3], f1[0], f1[1], f1[2], f1[3]}; const float kk[8] = {k0[0], k0[1], k0[2], k0[3], k1[0], k1[1], k1[2], k1[3]};
#pragma unroll
            for (int j = 0; j < 8; ++j) { fs[j] += lf[j]; S[j] = __expf(lf[j]) * S[j] + kk[j] * vv; }
            if (OUT) {
                const f32x4 q0 = *(const LAS f32x4*)(L + L_A0 + tt * 64 + g * 8), q1 = *(const LAS f32x4*)(L + L_A0 + tt * 64 + g * 8 + 4);
                const float qq[8] = {q0[0], q0[1], q0[2], q0[3], q1[0], q1[1], q1[2], q1[3]};
                float o = 0.f;
#pragma unroll
                for (int j = 0; j < 8; ++j) o += qq[j] * S[j];
                o = sum8(o);
                if (g == 0) L[L_HB + tt * 64 + v] = o;
            }
        }
        if (OUT) {
            __syncthreads();
            const int tt = tid >> 3;
            if (tt < ns) {
                const f32x4 h0 = *(const LAS f32x4*)(L + L_HB + tt * 64 + g * 8), h1 = *(const LAS f32x4*)(L + L_HB + tt * 64 + g * 8 + 4);
                float hv[8] = {h0[0], h0[1], h0[2], h0[3], h1[0], h1[1], h1[2], h1[3]}; float ss = 0.f;
#pragma unroll
                for (int j = 0; j < 8; ++j) ss += hv[j] * hv[j];
                ss = sum8(ss);
                const float rs = rsqrtf(ss * (1.0f / 64.0f) + EPSN);
                const float* gm = c.in[I_GHG] + layer * 256 + hh * 64 + g * 8; float dg[8];
                unpack8(*(const u32x4*)(Z + (row0 + seg + tt) * NZ + ZC_DG + hh * 64 + g * 8), dg); float o[8];
#pragma unroll
                for (int j = 0; j < 8; ++j) o[j] = (hv[j] * rs * gm[j]) * (dg[j] * sigmoidf_(dg[j]));
                u32x4 w; w.x = pk2(o[0], o[1]); w.y = pk2(o[2], o[3]); w.z = pk2(o[4], o[5]); w.w = pk2(o[6], o[7]);
                *(u32x4*)(c.MIX() + (row0 + seg + tt) * DM + 768 + hh * 64 + g * 8) = w;
            }
        }
    }
    if (io.st_out) {
#pragma unroll
        for (int j = 0; j < 8; ++j) { if (io.native_out) io.st_out[tid * 8 + j] = S[j]; else io.st_out[(g * 8 + j) * 64 + v] = S[j]; }
        if (io.b_out && v == 0) {
#pragma unroll
            for (int j = 0; j < 8; ++j) io.b_out[g * 8 + j] = __expf(fs[j]); } }
    __syncthreads();
}

constexpr int RSTG = 128 * 144;
DEVI bf16x8_t pack8(const float* f) { union { u32x4 u; bf16x8_t v; } r; r.u.x = pk2(f[0], f[1]); r.u.y = pk2(f[2], f[3]); r.u.z = pk2(f[4], f[5]); r.u.w = pk2(f[6], f[7]); return r.v; }
DEVI bf16x8_t pack8v(const f32x4 a, const f32x4 b) { union { u32x4 u; bf16x8_t v; } r; r.u.x = pk2(a[0], a[1]); r.u.y = pk2(a[2], a[3]); r.u.z = pk2(b[0], b[1]); r.u.w = pk2(b[2], b[3]); return r.v; }
struct StageRegs { u32x4 v[2]; };
DEVI StageRegs stage_load(const bf16_t* src  , int tid) {
    StageRegs r; const int tt = tid >> 2, ch = tid & 3;
#pragma unroll
    for (int e = 0; e < 2; ++e) r.v[e] = *(const u32x4*)(src + (size_t)tt * NZ + 8 * (2 * ch + e));
    return r;
}
DEVI void stage_store(LAS unsigned char* stage, const StageRegs& r, int tid) {
    const int tt = tid >> 2, ch = tid & 3;
#pragma unroll
    for (int e = 0; e < 2; ++e) *(LAS u32x4*)(stage + tt * 144 + (2 * ch + e) * 16) = r.v[e];
}
struct GateRegs { unsigned short gi0, gi1, gf0, gf1; float bi, bfv; };
DEVI GateRegs gate_load(const Ctx& c, int layer, size_t row0, int hh) {
    GateRegs g; const bf16_t* Z = c.Z(); const size_t r0 = (row0 + 2 * c.lane) * NZ, r1 = r0 + NZ;
    g.gi0 = Z[r0 + ZC_GI + hh]; g.gi1 = Z[r1 + ZC_GI + hh]; g.gf0 = Z[r0 + ZC_GF + hh]; g.gf1 = Z[r1 + ZC_GF + hh]; g.bi = c.in[I_BI][layer * 4 + hh]; g.bfv = c.in[I_BF][layer * 4 + hh]; return g;
}
DEVI void mlstm_scalars(const Ctx& c, LAS float* F, const GateRegs& gr, float mprev) {
    if (c.wave == 0) {
        const int lane = c.lane;
        const float i0 = bf2f(gr.gi0) + gr.bi, i1 = bf2f(gr.gi1) + gr.bi, l0 = log_sigmoid(bf2f(gr.gf0) + gr.bfv), l1 = log_sigmoid(bf2f(gr.gf1) + gr.bfv);
        float inc = l0 + l1;
#pragma unroll
        for (int o = 1; o < 64; o <<= 1) { const float y = shfl_up_f(inc, o); if (lane >= o) inc += y; }
        const float b0 = inc - l1, b1 = inc, u0 = i0 - b0, u1 = i1 - b1;
        float mxs = fmaxf(u0, u1);
#pragma unroll
        for (int o = 1; o < 64; o <<= 1) { const float y = shfl_up_f(mxs, o); if (lane >= o) mxs = fmaxf(mxs, y); }
        float ex = shfl_up_f(mxs, 1); if (lane == 0) ex = NEGV;
        const float c0 = fmaxf(ex, u0), c1 = fmaxf(c0, u1);
        F[2 * lane] = b0; F[2 * lane + 1] = b1; F[128 + 2 * lane] = u0; F[128 + 2 * lane + 1] = u1; F[256 + 2 * lane] = fmaxf(b0 + mprev, b0 + c0); F[256 + 2 * lane + 1] = fmaxf(b1 + mprev, b1 + c1);
        if (lane == 63) { F[704] = b1; F[705] = mxs; }
    }
    __syncthreads();
}
constexpr int ML_V = 0, ML_K = RSTG, ML_F = 2 * RSTG, ML_P = ML_F + 4096;
DEVI void mlstm_chunk_state(const Ctx& c, int layer, int hh, size_t row0, float* Uout, float* nout, float* mout, float* bout) {
    LAS unsigned char* VS = c.lds + ML_V; LAS unsigned char* KS = c.lds + ML_K; LAS float* F = (LAS float*)(c.lds + ML_F); LAS float* NP_ = (LAS float*)(c.lds + ML_P);
    const bf16_t* Z = c.Z(); const int tid = c.tid, lane = c.lane, i = lane & 15, gq = lane >> 4;
    const StageRegs vreg = stage_load(Z + row0 * NZ + ZC_BV + hh * 64, tid), kreg = stage_load(Z + row0 * NZ + ZC_BK + hh * 64, tid);
    GateRegs gr{}; if (c.wave == 0) gr = gate_load(c, layer, row0, hh);
    __syncthreads();
    stage_store(VS, vreg, tid);
    mlstm_scalars(c, F, gr, 0.f);
    const float bL = F[704], umax = F[705];
    { const int tt = tid >> 2, ch = tid & 3; const float wsc = 0.125f * __expf(F[128 + tt] - umax);
#pragma unroll
      for (int e = 0; e < 2; ++e) { float f[8]; unpack8(kreg.v[e], f);
#pragma unroll
          for (int j = 0; j < 8; ++j) f[j] *= wsc;
          union { u32x4 u; bf16x8_t v; } pk; pk.v = pack8(f); *(LAS u32x4*)(KS + tt * 144 + (2 * ch + e) * 16) = pk.u; } }
    __syncthreads();
    { const int mt = c.wave >> 1, nt0 = 2 * (c.wave & 1);
      f32x4 acc0 = (f32x4){0.f, 0.f, 0.f, 0.f}, acc1 = acc0;
#pragma unroll
      for (int ks = 0; ks < 4; ++ks) { const bf16x8_t vf = lds_tfrag(VS, ks, 16 * mt + i, gq), k0 = lds_tfrag(KS, ks, 16 * nt0 + i, gq), k1 = lds_tfrag(KS, ks, 16 * (nt0 + 1) + i, gq);
          acc0 = __builtin_amdgcn_mfma_f32_16x16x32_bf16(vf, k0, acc0, 0, 0, 0); acc1 = __builtin_amdgcn_mfma_f32_16x16x32_bf16(vf, k1, acc1, 0, 0, 0); }
#pragma unroll
      for (int r = 0; r < 4; ++r) { Uout[(16 * mt + 4 * gq + r) * 64 + 16 * nt0 + i] = acc0[r]; Uout[(16 * mt + 4 * gq + r) * 64 + 16 * (nt0 + 1) + i] = acc1[r]; } }
    { const int k = tid & 63, part = tid >> 6; float sum = 0.f;
#pragma unroll
      for (int s = 0; s < 16; ++s) sum += bf2f(*(const LAS unsigned short*)(KS + (16 * part + s) * 144 + k * 2));
      NP_[part * 64 + k] = sum; }
    __syncthreads();
    if (tid < 64) { float sum = 0.f;
#pragma unroll
        for (int p8 = 0; p8 < 8; ++p8) sum += NP_[p8 * 64 + tid];
        nout[tid] = sum; }
    if (tid == 0) { mout[0] = bL + umax; bout[0] = bL; }
}
DEVI void mlstm_chunk_out(const Ctx& c, int layer, int hh, size_t row0, const float* Cp, const float* np, const float* mp_) {
    LAS unsigned char* VS = c.lds + ML_V; LAS float* F = (LAS float*)(c.lds + ML_F);
    const bf16_t* Z = c.Z(); const int tid = c.tid, lane = c.lane, i = lane & 15, gq = lane >> 4, w = c.wave;
    const int t = 16 * w + i;
    const StageRegs vreg = stage_load(Z + row0 * NZ + ZC_BV + hh * 64, tid);
    GateRegs gr{}; if (w == 0) gr = gate_load(c, layer, row0, hh);
    const float npv = (tid >= 128 && tid < 192) ? np[tid - 128] : 0.f;
    const float mprev = mp_[0];
    bf16x8_t qf[2], kfr[8][2];
    { const bf16_t* qp = Z + (row0 + t) * NZ + ZC_BQ + hh * 64 + 8 * gq; qf[0] = *(const bf16x8_t*)qp; qf[1] = *(const bf16x8_t*)(qp + 32); }
#pragma unroll
    for (int kt = 0; kt < 8; ++kt) if (kt <= w) { const bf16_t* kp = Z + (row0 + 16 * kt + i) * NZ + ZC_BK + hh * 64 + 8 * gq; kfr[kt][0] = *(const bf16x8_t*)kp; kfr[kt][1] = *(const bf16x8_t*)(kp + 32); }
    __syncthreads();
    stage_store(VS, vreg, tid);
    if (tid >= 128 && tid < 192) F[640 + tid - 128] = npv;
    mlstm_scalars(c, F, gr, mprev);
    u32x2 bog[4]; f32x4 gmv[4];
#pragma unroll
    for (int dt = 0; dt < 4; ++dt) { const int col = hh * 64 + 16 * dt + 4 * gq; gmv[dt] = *(const f32x4*)(c.in[I_GML] + layer * 256 + col); bog[dt] = *(const u32x2*)(Z + (row0 + t) * NZ + ZC_BO + col); }
    const float bt = F[t], mt_ = F[256 + t], wt = bt - mt_, gI = __expf(bt + mprev - mt_);
    f32x4 s[8]; float nqi = 0.f;
#pragma unroll
    for (int kt = 0; kt < 8; ++kt) {
        s[kt] = (f32x4){0.f, 0.f, 0.f, 0.f};
        if (kt <= w) {
            f32x4 a = (f32x4){0.f, 0.f, 0.f, 0.f};
            a = __builtin_amdgcn_mfma_f32_16x16x32_bf16(kfr[kt][0], qf[0], a, 0, 0, 0);
            a = __builtin_amdgcn_mfma_f32_16x16x32_bf16(kfr[kt][1], qf[1], a, 0, 0, 0);
            const f32x4 uu = *(const LAS f32x4*)(F + 128 + 16 * kt + 4 * gq);
#pragma unroll
            for (int r = 0; r < 4; ++r) { const bool valid = (16 * kt + 4 * gq + r) <= t; const float val = a[r] * 0.125f * __expf(valid ? uu[r] + wt : NEGV); a[r] = val; nqi += val; }
            s[kt] = a;
        }
    }
    nqi += shfl_xor_f(nqi, 16); nqi += shfl_xor_f(nqi, 32);
    f32x4 cpr[4][2][2];
#pragma unroll
    for (int dt = 0; dt < 4; ++dt)
#pragma unroll
        for (int ks = 0; ks < 2; ++ks) { const float* cp = Cp + (16 * dt + i) * 64 + 32 * ks + 8 * gq; cpr[dt][ks][0] = *(const f32x4*)cp; cpr[dt][ks][1] = *(const f32x4*)(cp + 4); }
    f32x4 o[4], oi[4];
#pragma unroll
    for (int dt = 0; dt < 4; ++dt) { o[dt] = (f32x4){0.f, 0.f, 0.f, 0.f}; oi[dt] = o[dt]; }
#pragma unroll
    for (int ks = 0; ks < 4; ++ks) {
        if (2 * ks <= w) {
            const bf16x8_t pf = pack8v(s[2 * ks], s[2 * ks + 1]);
#pragma unroll
            for (int dt = 0; dt < 4; ++dt) o[dt] = __builtin_amdgcn_mfma_f32_16x16x32_bf16(lds_tfrag(VS, ks, 16 * dt + i, gq), pf, o[dt], 0, 0, 0);
        }
    }
#pragma unroll
    for (int dt = 0; dt < 4; ++dt)
#pragma unroll
        for (int ks = 0; ks < 2; ++ks) oi[dt] = __builtin_amdgcn_mfma_f32_16x16x32_bf16(pack8v(cpr[dt][ks][0], cpr[dt][ks][1]), qf[ks], oi[dt], 0, 0, 0);
    float nqn = 0.f;
#pragma unroll
    for (int ks = 0; ks < 2; ++ks) { float qv[8]; union { u32x4 u; bf16x8_t v; } qq; qq.v = qf[ks]; unpack8(qq.u, qv);
#pragma unroll
        for (int j = 0; j < 8; ++j) nqn += qv[j] * F[640 + 32 * ks + 8 * gq + j]; }
    nqn += shfl_xor_f(nqn, 16); nqn += shfl_xor_f(nqn, 32);
    const float nq = nqi + gI * nqn, inv = frcp(fmaxf(fabsf(nq), __expf(-mt_)));
    float ss = 0.f;
#pragma unroll
    for (int dt = 0; dt < 4; ++dt) { o[dt] = (o[dt] + oi[dt] * gI) * inv; ss += (o[dt][0] * o[dt][0] + o[dt][1] * o[dt][1]) + (o[dt][2] * o[dt][2] + o[dt][3] * o[dt][3]); }
    ss += shfl_xor_f(ss, 16); ss += shfl_xor_f(ss, 32);
    const float rs = rsqrtf(ss * (1.0f / 64.0f) + EPSN);
#pragma unroll
    for (int dt = 0; dt < 4; ++dt) { const int col = hh * 64 + 16 * dt + 4 * gq; const f32x4 gm = gmv[dt]; const u32x2 bo = bog[dt];
        const float r0 = sigmoidf_(bflo(bo.x)) * (o[dt][0] * rs * gm[0]), r1 = sigmoidf_(bfhi(bo.x)) * (o[dt][1] * rs * gm[1]), r2 = sigmoidf_(bflo(bo.y)) * (o[dt][2] * rs * gm[2]), r3 = sigmoidf_(bfhi(bo.y)) * (o[dt][3] * rs * gm[3]);
        u32x2 wv; wv.x = pk2(r0, r1); wv.y = pk2(r2, r3); *(u32x2*)(c.MIX() + (row0 + t) * DM + 256 + col) = wv; }
}
constexpr int HG_V = 0, HG_K = RSTG, HG_BC = 2 * RSTG, HG_SEG = HG_BC + 32768;
DEVI void hgrn_logf_kd(float lbv, float llb, float l1m, float df, float& lfd, float& kd) {
    const float x2 = l1m + log_sigmoid(df), mx = fmaxf(llb, x2); lfd = mx + log1pexp_neg(fabsf(llb - x2)); kd = (1.0f - lbv) * sigmoidf_(-df);
}
struct DecayRegs { unsigned short df[16]; float lbv; };
DEVI DecayRegs decay_load(const Ctx& c, int layer, int hh, size_t row0) {
    DecayRegs r; const bf16_t* Z = c.Z(); const int d = c.tid & 63, seg = c.tid >> 6;
#pragma unroll
    for (int tt = 0; tt < 16; ++tt) r.df[tt] = Z[(row0 + 16 * seg + tt) * NZ + ZC_DF + hh * 64 + d];
    r.lbv = hgrn_lb(c, layer, hh * 64 + d); return r;
}
DEVI void hgrn_cumdecay(const Ctx& c, const DecayRegs& dr) {
    LAS float* BC = (LAS float*)(c.lds + HG_BC); LAS float* SEG = (LAS float*)(c.lds + HG_SEG);
    const int d = c.tid & 63, seg = c.tid >> 6; const float lbv = dr.lbv, llb = __logf(fmaxf(lbv, 1e-30f)), l1m = __logf(1.0f - lbv);
    float run = 0.f;
#pragma unroll
    for (int tt = 0; tt < 16; ++tt) { const int t = 16 * seg + tt; float lfd, kd; hgrn_logf_kd(lbv, llb, l1m, bf2f(dr.df[tt]), lfd, kd); run += lfd; BC[t * 64 + d] = run; }
    SEG[seg * 64 + d] = run;
    __syncthreads();
    float off = 0.f;
    for (int s2 = 0; s2 < seg; ++s2) off += SEG[s2 * 64 + d];
#pragma unroll 4
    for (int tt = 0; tt < 16; ++tt) BC[(16 * seg + tt) * 64 + d] += off;
    __syncthreads();
}
DEVI void hgrn_chunk_state(const Ctx& c, int layer, int hh, size_t row0, float* Uout  , float* dec_out) {
    LAS unsigned char* VS = c.lds + HG_V; LAS unsigned char* KS = c.lds + HG_K; LAS float* BC = (LAS float*)(c.lds + HG_BC);
    const bf16_t* Z = c.Z(); const int tid = c.tid, lane = c.lane, i = lane & 15, gq = lane >> 4;
    const StageRegs vreg = stage_load(Z + row0 * NZ + ZC_DI + hh * 64, tid), freg = stage_load(Z + row0 * NZ + ZC_DF + hh * 64, tid);
    const DecayRegs dr = decay_load(c, layer, hh, row0);
    float lb16[2][8];
#pragma unroll
    for (int e = 0; e < 2; ++e) hgrn_lb8(c, layer, hh * 64 + 8 * (2 * (tid & 3) + e), lb16[e]);
    __syncthreads();
    stage_store(VS, vreg, tid);
    hgrn_cumdecay(c, dr);
    { const int tt = tid >> 2, ch = tid & 3;
#pragma unroll
      for (int e = 0; e < 2; ++e) { const int d0 = 8 * (2 * ch + e); float f[8]; unpack8(freg.v[e], f);
#pragma unroll
          for (int j = 0; j < 8; ++j) { const float lbv = lb16[e][j]; float lfd, kd; hgrn_logf_kd(lbv, __logf(fmaxf(lbv, 1e-30f)), __logf(1.0f - lbv), f[j], lfd, kd);
              f[j] = kd * __expf(BC[127 * 64 + d0 + j] - BC[tt * 64 + d0 + j]); }
          union { u32x4 u; bf16x8_t v; } pk; pk.v = pack8(f); *(LAS u32x4*)(KS + tt * 144 + (2 * ch + e) * 16) = pk.u; } }
    __syncthreads();
    { const int mt = c.wave >> 1, nt0 = 2 * (c.wave & 1);
      f32x4 acc0 = (f32x4){0.f, 0.f, 0.f, 0.f}, acc1 = acc0;
#pragma unroll
      for (int ks = 0; ks < 4; ++ks) { const bf16x8_t vf = lds_tfrag(VS, ks, 16 * mt + i, gq), k0 = lds_tfrag(KS, ks, 16 * nt0 + i, gq), k1 = lds_tfrag(KS, ks, 16 * (nt0 + 1) + i, gq);
          acc0 = __builtin_amdgcn_mfma_f32_16x16x32_bf16(vf, k0, acc0, 0, 0, 0); acc1 = __builtin_amdgcn_mfma_f32_16x16x32_bf16(vf, k1, acc1, 0, 0, 0); }
#pragma unroll
      for (int r = 0; r < 4; ++r) { Uout[(16 * mt + 4 * gq + r) * 64 + 16 * nt0 + i] = acc0[r]; Uout[(16 * mt + 4 * gq + r) * 64 + 16 * (nt0 + 1) + i] = acc1[r]; } }
    if (tid < 64) dec_out[tid] = __expf(BC[127 * 64 + tid]);
}
DEVI void hgrn_chunk_out(const Ctx& c, int layer, int hh, size_t row0, const float* Sst  ) {
    LAS unsigned char* VS = c.lds + HG_V; LAS float* BC = (LAS float*)(c.lds + HG_BC);
    const bf16_t* Z = c.Z(); const int tid = c.tid, lane = c.lane, i = lane & 15, gq = lane >> 4, w = c.wave;
    const int t = 16 * w + i;
    const StageRegs vreg = stage_load(Z + row0 * NZ + ZC_DI + hh * 64, tid);
    const DecayRegs dr = decay_load(c, layer, hh, row0);
    u32x4 qraw[2], dfr[8][2]; f32x4 spr[4][2][2]; u32x2 dgg[4]; f32x4 gmv[4];
#pragma unroll
    for (int ks = 0; ks < 2; ++ks) qraw[ks] = *(const u32x4*)(Z + (row0 + t) * NZ + ZC_DQ + hh * 64 + 32 * ks + 8 * gq);
#pragma unroll
    for (int kt = 0; kt < 8; ++kt) if (kt <= w) {
#pragma unroll
        for (int ks = 0; ks < 2; ++ks) dfr[kt][ks] = *(const u32x4*)(Z + (row0 + 16 * kt + i) * NZ + ZC_DF + hh * 64 + 32 * ks + 8 * gq); }
    float oml[2][8]; bf16x8_t qf1[2], qf2[2];
#pragma unroll
    for (int ks = 0; ks < 2; ++ks) { hgrn_lb8(c, layer, hh * 64 + 32 * ks + 8 * gq, oml[ks]);
#pragma unroll
        for (int j = 0; j < 8; ++j) oml[ks][j] = 1.0f - oml[ks][j]; }
    __syncthreads();
    stage_store(VS, vreg, tid);
    hgrn_cumdecay(c, dr);
#pragma unroll
    for (int ks = 0; ks < 2; ++ks) { float qv[8]; unpack8(qraw[ks], qv); float q1[8], q2[8];
        const f32x4 b0 = *(const LAS f32x4*)(BC + t * 64 + 32 * ks + 8 * gq), b1 = *(const LAS f32x4*)(BC + t * 64 + 32 * ks + 8 * gq + 4);
        f32x4 r0 = (f32x4){0.f, 0.f, 0.f, 0.f}, r1 = r0;
        if (w > 0) { r0 = *(const LAS f32x4*)(BC + (16 * w - 1) * 64 + 32 * ks + 8 * gq); r1 = *(const LAS f32x4*)(BC + (16 * w - 1) * 64 + 32 * ks + 8 * gq + 4); }
#pragma unroll
        for (int j = 0; j < 8; ++j) { const float bj = j < 4 ? b0[j] : b1[j - 4], rj = j < 4 ? r0[j] : r1[j - 4];
            q1[j] = qv[j] * oml[ks][j] * __expf(bj - rj); q2[j] = qv[j] * __expf(bj); }
        qf1[ks] = pack8(q1); qf2[ks] = pack8(q2); }
    f32x4 s[8];
#pragma unroll
    for (int kt = 0; kt < 8; ++kt) {
        s[kt] = (f32x4){0.f, 0.f, 0.f, 0.f};
        if (kt <= w) {
            const int sk = 16 * kt + i; f32x4 a = (f32x4){0.f, 0.f, 0.f, 0.f};
#pragma unroll
            for (int ks = 0; ks < 2; ++ks) { float f[8]; unpack8(dfr[kt][ks], f);
                const f32x4 b0 = *(const LAS f32x4*)(BC + sk * 64 + 32 * ks + 8 * gq), b1 = *(const LAS f32x4*)(BC + sk * 64 + 32 * ks + 8 * gq + 4);
                f32x4 r0 = (f32x4){0.f, 0.f, 0.f, 0.f}, r1 = r0;
                if (w > 0) { r0 = *(const LAS f32x4*)(BC + (16 * w - 1) * 64 + 32 * ks + 8 * gq); r1 = *(const LAS f32x4*)(BC + (16 * w - 1) * 64 + 32 * ks + 8 * gq + 4); }
#pragma unroll
                for (int j = 0; j < 8; ++j) { const float bj = j < 4 ? b0[j] : b1[j - 4], rj = j < 4 ? r0[j] : r1[j - 4]; f[j] = sigmoidf_(-f[j]) * __expf(fminf(rj - bj, 80.f)); }
                a = __builtin_amdgcn_mfma_f32_16x16x32_bf16(pack8(f), qf1[ks], a, 0, 0, 0); }
#pragma unroll
            for (int r = 0; r < 4; ++r) a[r] = ((16 * kt + 4 * gq + r) <= t) ? a[r] : 0.f;
            s[kt] = a;
        }
    }
#pragma unroll
    for (int dt = 0; dt < 4; ++dt) {
#pragma unroll
        for (int ks = 0; ks < 2; ++ks) { const float* sp = Sst + (16 * dt + i) * 64 + 32 * ks + 8 * gq; spr[dt][ks][0] = *(const f32x4*)sp; spr[dt][ks][1] = *(const f32x4*)(sp + 4); }
        const int col = hh * 64 + 16 * dt + 4 * gq; gmv[dt] = *(const f32x4*)(c.in[I_GHG] + layer * 256 + col); dgg[dt] = *(const u32x2*)(Z + (row0 + t) * NZ + ZC_DG + col); }
    f32x4 o[4];
#pragma unroll
    for (int dt = 0; dt < 4; ++dt) o[dt] = (f32x4){0.f, 0.f, 0.f, 0.f};
#pragma unroll
    for (int ks = 0; ks < 4; ++ks) {
        if (2 * ks <= w) {
            const bf16x8_t pf = pack8v(s[2 * ks], s[2 * ks + 1]);
#pragma unroll
            for (int dt = 0; dt < 4; ++dt) o[dt] = __builtin_amdgcn_mfma_f32_16x16x32_bf16(lds_tfrag(VS, ks, 16 * dt + i, gq), pf, o[dt], 0, 0, 0);
        }
    }
#pragma unroll
    for (int dt = 0; dt < 4; ++dt)
#pragma unroll
        for (int ks = 0; ks < 2; ++ks) o[dt] = __builtin_amdgcn_mfma_f32_16x16x32_bf16(pack8v(spr[dt][ks][0], spr[dt][ks][1]), qf2[ks], o[dt], 0, 0, 0);
    float ss = 0.f;
#pragma unroll
    for (int dt = 0; dt < 4; ++dt) ss += (o[dt][0] * o[dt][0] + o[dt][1] * o[dt][1]) + (o[dt][2] * o[dt][2] + o[dt][3] * o[dt][3]);
    ss += shfl_xor_f(ss, 16); ss += shfl_xor_f(ss, 32);
    const float rs = rsqrtf(ss * (1.0f / 64.0f) + EPSN);
#pragma unroll
    for (int dt = 0; dt < 4; ++dt) { const int col = hh * 64 + 16 * dt + 4 * gq; const f32x4 gm = gmv[dt];
        const u32x2 dg = dgg[dt]; const float g0 = bflo(dg.x), g1 = bfhi(dg.x), g2 = bflo(dg.y), g3 = bfhi(dg.y);
        const float r0 = (o[dt][0] * rs * gm[0]) * (g0 * sigmoidf_(g0)), r1 = (o[dt][1] * rs * gm[1]) * (g1 * sigmoidf_(g1)), r2 = (o[dt][2] * rs * gm[2]) * (g2 * sigmoidf_(g2)), r3 = (o[dt][3] * rs * gm[3]) * (g3 * sigmoidf_(g3));
        u32x2 wv; wv.x = pk2(r0, r1); wv.y = pk2(r2, r3); *(u32x2*)(c.MIX() + (row0 + t) * DM + 768 + col) = wv; }
}

constexpr int GM_PITCH = 528;
DEVI void gmlp_chunk_item(const Ctx& c, int layer, size_t row0) {
    LAS unsigned char* VS = c.lds; const bf16_t* Z = c.Z(); const int lane = c.lane, i = lane & 15, gq = lane >> 4, w = c.wave, t = 16 * w + i;
    bf16x8_t wf[4][4];
    u32x2 cvr[16];
    {
        f32x4 wr[4][4][2];
#pragma unroll
        for (int hh = 0; hh < 4; ++hh)
#pragma unroll
            for (int ks = 0; ks < 4; ++ks) { const float* wp = c.in[I_WS] + ((size_t)(layer * NH + hh) * 128 + t) * 128 + 32 * ks + 4 * gq; wr[hh][ks][0] = *(const f32x4*)wp; wr[hh][ks][1] = *(const f32x4*)(wp + 16); }
#pragma unroll
        for (int rr = 0; rr < 16; ++rr) cvr[rr] = *(const u32x2*)(Z + (row0 + w * 16 + rr) * NZ + ZC_CV + 4 * lane);
#pragma unroll
        for (int hh = 0; hh < 4; ++hh)
#pragma unroll
            for (int ks = 0; ks < 4; ++ks) if (2 * ks <= w) { f32x4 w0 = wr[hh][ks][0], w1 = wr[hh][ks][1];
#pragma unroll
                for (int r = 0; r < 4; ++r) { if (32 * ks + 4 * gq + r > t) w0[r] = 0.f; if (32 * ks + 16 + 4 * gq + r > t) w1[r] = 0.f; }
                wf[hh][ks] = pack8v(w0, w1); }
    }
    __syncthreads();
    { const float* gcv = c.in[I_GCV] + layer * 256; const f32x4 gv = *(const f32x4*)(gcv + 4 * lane);
#pragma unroll
      for (int rr = 0; rr < 16; ++rr) { const u32x2 u = cvr[rr];
          const float e0 = gelu_tanh(bflo(u.x)), e1 = gelu_tanh(bfhi(u.x)), e2 = gelu_tanh(bflo(u.y)), e3 = gelu_tanh(bfhi(u.y));
          const float rs = rsqrtf(wave_sum((e0 * e0 + e1 * e1) + (e2 * e2 + e3 * e3)) * (1.0f / 256.0f) + EPSN);
          u32x2 o; o.x = pk2(e0 * rs * gv[0], e1 * rs * gv[1]); o.y = pk2(e2 * rs * gv[2], e3 * rs * gv[3]);
          *(LAS u32x2*)(VS + (w * 16 + rr) * GM_PITCH + 8 * lane) = o; } }
    __syncthreads();
    u32x2 cur4[4][4]; float bs4[4];
#pragma unroll
    for (int hh = 0; hh < 4; ++hh) {
#pragma unroll
        for (int ct = 0; ct < 4; ++ct) cur4[hh][ct] = *(const u32x2*)(Z + (row0 + t) * NZ + ZC_CU + hh * 64 + 16 * ct + 4 * gq);
        bs4[hh] = c.in[I_BS][(layer * NH + hh) * 128 + t]; }
    __builtin_amdgcn_sched_barrier(0);
#pragma unroll
    for (int hh = 0; hh < 4; ++hh) {
        const u32x2* cur = cur4[hh]; const float bsv = bs4[hh];
        f32x4 acc[4];
#pragma unroll
        for (int ct = 0; ct < 4; ++ct) acc[ct] = (f32x4){0.f, 0.f, 0.f, 0.f};
#pragma unroll
        for (int ks = 0; ks < 4; ++ks) if (2 * ks <= w) {
#pragma unroll
            for (int ct = 0; ct < 4; ++ct) acc[ct] = __builtin_amdgcn_mfma_f32_16x16x32_bf16(lds_tfrag<GM_PITCH>(VS, ks, hh * 64 + 16 * ct + i, gq), wf[hh][ks], acc[ct], 0, 0, 0);
        }
#pragma unroll
        for (int ct = 0; ct < 4; ++ct) { const u32x2 u = cur[ct];
            const float r0 = gelu_tanh(bflo(u.x)) * (acc[ct][0] + bsv), r1 = gelu_tanh(bfhi(u.x)) * (acc[ct][1] + bsv), r2 = gelu_tanh(bflo(u.y)) * (acc[ct][2] + bsv), r3 = gelu_tanh(bfhi(u.y)) * (acc[ct][3] + bsv);
            u32x2 wv; wv.x = pk2(r0, r1); wv.y = pk2(r2, r3); *(u32x2*)(c.MIX() + (row0 + t) * DM + 512 + hh * 64 + 16 * ct + 4 * gq) = wv; }
    }
}

DEVI void copy_item(const Ctx& c, int layer, int it) {
    constexpr int PER_T_P = 2 * WB * 256 / 16384  , PER_T_S = DECB * WB * 256 / 16384  ;
    const bf16_t* Z = c.Z();
    if (it < 2 * PER_T_P) {
        const int kv = it / PER_T_P, r = it % PER_T_P; float* o = c.out + (kv ? O_VWP : O_KWP) + (size_t)layer * 2 * WB * 256 + (size_t)r * 16384; const int zc = kv ? ZC_AV : ZC_AK;
        for (int i = c.tid; i < 4096; i += NTHREADS) { const size_t e = (size_t)r * 16384 + 4 * i; const int b = (int)(e / (WB * 256)), rr = (int)((e / 256) % WB), col = (int)(e % 256);
            const u32x2 u = *(const u32x2*)(Z + ((size_t)b * TSEQ + (TSEQ - WB) + rr) * NZ + zc + col); *(f32x4*)(o + 4 * i) = (f32x4){bflo(u.x), bfhi(u.x), bflo(u.y), bfhi(u.y)}; }
    } else {
        it -= 2 * PER_T_P; const int kv = it / PER_T_S, r = it % PER_T_S; float* o = c.out + (kv ? O_VWS : O_KWS) + (size_t)layer * DECB * WB * 256 + (size_t)r * 16384; const int zc = kv ? ZC_AV : ZC_AK;
        const float* src = c.in[kv ? I_CV : I_CK] + (size_t)layer * DECB * WB * 256;
        if ((r & 31) != 31) {
            const f32x4* s4 = (const f32x4*)(src + (size_t)r * 16384 + DECT * 256); f32x4* o4 = (f32x4*)o; f32x4 v[8];
#pragma unroll
            for (int k = 0; k < 8; ++k) v[k] = __builtin_nontemporal_load(s4 + c.tid + k * NTHREADS);
#pragma unroll
            for (int k = 0; k < 8; ++k) __builtin_nontemporal_store(v[k], o4 + c.tid + k * NTHREADS);
            return;
        }
        for (int i = c.tid; i < 4096; i += NTHREADS) { const size_t e = (size_t)r * 16384 + 4 * i; const int b = (int)(e / (WB * 256)), rr = (int)((e / 256) % WB), col = (int)(e % 256);
            f32x4 val;
            if (rr < WB - DECT) val = *(const f32x4*)(src + ((size_t)b * WB + rr + DECT) * 256 + col);
            else { const u32x2 u = *(const u32x2*)(Z + ((size_t)NPR + b * DECT + (rr - (WB - DECT))) * NZ + zc + col); val = (f32x4){bflo(u.x), bfhi(u.x), bflo(u.y), bfhi(u.y)}; }
            *(f32x4*)(o + 4 * i) = val; }
    }
}
constexpr int N_BIG = 2 * DECB * 8;
DEVI void big_copy_item(const Ctx& c, int layer, int it) {
    const int kv = it >> 8, b = (it >> 3) & 31, j = it & 7, n16 = (j == 7) ? 3 : 4;
    const size_t off = ((size_t)(layer * DECB + b) * WB) * 256 + (size_t)j * 4 * 16384;
    const f32x4* s4 = (const f32x4*)(c.in[kv ? I_CV : I_CK] + off + DECT * 256); f32x4* o4 = (f32x4*)(c.out + (kv ? O_VWS : O_KWS) + off);
    f32x4 v[32];
#pragma unroll
    for (int k = 0; k < 32; ++k) if (k < 8 * n16) v[k] = __builtin_nontemporal_load(s4 + c.tid + k * NTHREADS);
#pragma unroll
    for (int k = 0; k < 32; ++k) if (k < 8 * n16) __builtin_nontemporal_store(v[k], o4 + c.tid + k * NTHREADS);
}
DEVI void phase_mix_local(const Ctx& c0, int layer0, int qslot) {
    WorkQueue q; q.start(c0, (unsigned*)(c0.ws + WS_CTL) + CW_QUEUE + 64 * (2 * layer0) + 64 * 8 * qslot);
    for (;;) {
        const int pos = q.pop(c0);
        if (pos >= 2208) break;
        int it; bool big = false;
        if (pos < 64) it = 1440 + pos;
        else if (pos >= 64 + 102 * 21) { big = true; it = 510 + (pos - (64 + 102 * 21)); }
        else { const int p = pos - 64, g = p / 21, m = p % 21;
            if ((m & 3) == 3) { big = true; it = g * 5 + (m >> 2); }
            else { const int nb = g * 16 + m - ((m + 1) >> 2);
                if (nb < 416) it = nb;
                else { const int p2 = nb - 416, g2 = p2 / 19, m2 = p2 % 19; it = (m2 < 16) ? 416 + g2 * 16 + m2 : 1504 + g2 * 3 + (m2 - 16); } } }
        const Ctx c = relaunder(c0); int layer = layer0; asm volatile("" : "+s"(layer));
        float* MU = (float*)(c.ws + WS_MU); float* HU = (float*)(c.ws + WS_HU);
        if (big || it >= 256) q.prefetch(c);
        if (big) big_copy_item(c, layer, it);
        else if (it < 256) { const int itu = __builtin_amdgcn_readfirstlane(it); const int blk = itu & 31, hh = (itu >> 5) & 3, b = itu >> 7; for (int rp = 0; rp < REP_ATT; ++rp) attn_block_item(c, layer, b, hh, blk, q); }
        else if (it < 384) { for (int rp = 0; rp < REP_GMLP; ++rp) gmlp_chunk_item(c, layer, (size_t)(it - 256) * 128); }
        else if (it < 416) { const int b = it - 384; gmlp_item(c, layer, (size_t)NPR + b * DECT, DECT, c.out + O_CVS + ((size_t)layer * DECB + b) * DECT * 256); }
        else if (it < 928) { const int i2 = it - 416, b = i2 >> 8, hh = (i2 >> 6) & 3, ch = i2 & 63;
            for (int rp = 0; rp < REP_STATE; ++rp) mlstm_chunk_state(c, layer, hh, (size_t)b * TSEQ + ch * 128, MU + (size_t)i2 * 4096, (float*)((char*)MU + REC_N_OFF) + i2 * 64, (float*)((char*)MU + REC_M_OFF) + i2, (float*)((char*)MU + REC_B_OFF) + i2); }
        else if (it < 1440) { const int i2 = it - 928, b = i2 >> 8, hh = (i2 >> 6) & 3, ch = i2 & 63;
            for (int rp = 0; rp < REP_STATE; ++rp) hgrn_chunk_state(c, layer, hh, (size_t)b * TSEQ + ch * 128, HU + (size_t)i2 * 4096, (float*)((char*)HU + REC_N_OFF) + i2 * 64); }
        else if (it < 1504) { const int qh = __builtin_amdgcn_readfirstlane((it - 1440) * 8 + c.wave); const int t = qh & 3, hh = (qh >> 2) & 3, b = qh >> 4; for (int rp = 0; rp < REP_SATT; ++rp) attn_sample_qh(c, layer, b, hh, t); }
        else if (it < 1632) copy_item(c, layer, it - 1504);
        else { const int s = it - 1632; copy_item(c, layer, 128 + (s >> 5) * 1024 + (s & 31) * 32 + 31); }
    }
}

DEVI void phase_scan(const Ctx& c, int layer) {
    float* MU = (float*)(c.ws + WS_MU); float* MCS = (float*)(c.ws + WS_MCS); float* HU = (float*)(c.ws + WS_HU); float* HSS = (float*)(c.ws + WS_HSS);
    const int tid = c.tid; constexpr int GRP = 16;
    for (int it = c.bid; it < 128; it += c.G) {
        const int seq = it >> 3, e = (it & 7) * 512 + tid;
        if (seq < 8) {
            const float* un = (const float*)((const char*)MU + REC_N_OFF); const float* um = (const float*)((const char*)MU + REC_M_OFF); const float* ub = (const float*)((const char*)MU + REC_B_OFF);
            float* csn = (float*)((char*)MCS + REC_N_OFF); float* csm = (float*)((char*)MCS + REC_M_OFF);
            const bool lead = (it & 7) == 0; const bool do_n = lead && tid < 64;
            float C = 0.f, nn = 0.f, m = 0.f;
#pragma unroll 1
            for (int ch0 = 0; ch0 < NCHUNK; ch0 += GRP) {
                const float* up = MU + (size_t)(seq * NCHUNK + ch0) * 4096 + e; float* cp = MCS + (size_t)(seq * NCHUNK + ch0) * 4096 + e; const int item0 = seq * NCHUNK + ch0;
                float u[GRP], nu[GRP], Bv[GRP], mlv[GRP];
#pragma unroll
                for (int q = 0; q < GRP; ++q) { u[q] = up[(size_t)q * 4096]; Bv[q] = ub[item0 + q]; mlv[q] = um[item0 + q]; nu[q] = do_n ? un[(item0 + q) * 64 + tid] : 0.f; }
#pragma unroll
                for (int q = 0; q < GRP; ++q) {
                    cp[(size_t)q * 4096] = C; if (do_n) csn[(item0 + q) * 64 + tid] = nn; if (lead && tid == 0) csm[item0 + q] = m;
                    const float mn = fmaxf(Bv[q] + m, mlv[q]); const float a = __expf(Bv[q] + m - mn), bb = __expf(mlv[q] - mn);
                    C = a * C + bb * u[q]; nn = a * nn + bb * nu[q]; m = mn; }
            }
            c.out[O_CP + ((size_t)layer * 8 + seq) * 4096 + e] = C;
            if (lead && tid == 0) c.out[O_MP + layer * 8 + seq] = m;
            if (do_n) c.out[O_NP + ((size_t)layer * 8 + seq) * 64 + tid] = nn;
        } else {
            const int bh = seq - 8, d = e & 63, v = e >> 6; const float* dec = (const float*)((const char*)HU + REC_N_OFF);
            float S = 0.f;
#pragma unroll 1
            for (int ch0 = 0; ch0 < NCHUNK; ch0 += GRP) {
                const float* up = HU + (size_t)(bh * NCHUNK + ch0) * 4096 + e; float* sp = HSS + (size_t)(bh * NCHUNK + ch0) * 4096 + e; const float* dp = dec + (bh * NCHUNK + ch0) * 64 + d;
                float u[GRP], dd[GRP];
#pragma unroll
                for (int q = 0; q < GRP; ++q) { u[q] = up[(size_t)q * 4096]; dd[q] = dp[q * 64]; }
#pragma unroll
                for (int q = 0; q < GRP; ++q) { sp[(size_t)q * 4096] = S; S = dd[q] * S + u[q]; }
            }
            c.out[O_SP + ((size_t)layer * 8 + bh) * 4096 + d * 64 + v] = S;
        }
    }
}

DEVI void phase_mix_out(const Ctx& c0, int layer0, int qslot) {
    WorkQueue q; q.start(c0, (unsigned*)(c0.ws + WS_CTL) + CW_QUEUE + 64 * (2 * layer0 + 1) + 64 * 8 * qslot);
    for (;;) {
        const int it = q.pop(c0);
        if (it >= 1280) break;
        const Ctx c = relaunder(c0); int layer = layer0; asm volatile("" : "+s"(layer));
        float* MCS = (float*)(c.ws + WS_MCS); float* HSS = (float*)(c.ws + WS_HSS);
        q.prefetch(c);
        if (it < 512) { const int b = it >> 8, hh = (it >> 6) & 3, ch = it & 63; RecIO io{}; io.st_in = MCS + (size_t)it * 4096; io.n_in = (const float*)((const char*)MCS + REC_N_OFF) + it * 64; io.m_in = (const float*)((const char*)MCS + REC_M_OFF) + it;
            for (int rp = 0; rp < REP_OUT; ++rp) mlstm_chunk_out(c, layer, hh, (size_t)b * TSEQ + ch * 128, io.st_in, io.n_in, io.m_in); }
        else if (it < 1024) { const int i2 = it - 512, b = i2 >> 8, hh = (i2 >> 6) & 3, ch = i2 & 63; RecIO io{}; io.st_in = HSS + (size_t)i2 * 4096; io.native_in = true;
            for (int rp = 0; rp < REP_OUT; ++rp) hgrn_chunk_out(c, layer, hh, (size_t)b * TSEQ + ch * 128, io.st_in); }
        else if (it < 1152) { const int i2 = it - 1024, b = i2 >> 2, hh = i2 & 3; const size_t sidx = (size_t)(layer * DECB + b) * NH + hh; RecIO io{};
            io.st_in = c.in[I_MC] + sidx * 4096; io.n_in = c.in[I_MN] + sidx * 64; io.m_in = c.in[I_MM] + sidx;
            io.st_out = c.out + O_CS + sidx * 4096; io.n_out = c.out + O_NS + sidx * 64; io.m_out = c.out + O_MS + sidx;
            for (int rp = 0; rp < REP_SREC; ++rp) mlstm_item<true>(c, layer, hh, (size_t)NPR + b * DECT, DECT, io, 0.f); }
        else { const int i2 = it - 1152, b = i2 >> 2, hh = i2 & 3; const size_t sidx = (size_t)(layer * DECB + b) * NH + hh; RecIO io{};
            io.st_in = c.in[I_HS] + sidx * 4096; io.st_out = c.out + O_SS + sidx * 4096;
            for (int rp = 0; rp < REP_SREC; ++rp) hgrn_item<true>(c, layer, hh, (size_t)NPR + b * DECT, DECT, io); }
    }
}

DEVI void phase_final(const Ctx& c) {
    const int gw = c.bid * 8 + c.wave, NGW = c.G * 8; const bf16_t* x = c.X2(); const float* g = c.in[I_GFIN];
    f32x4 gv[4];
#pragma unroll
    for (int j = 0; j < 4; ++j) gv[j] = *(const f32x4*)(g + 256 * j + 4 * c.lane);
    for (int row0 = gw; row0 < NTOK; row0 += 3 * NGW) {
        u32x2 xb[3][4]; float rs[3];
#pragma unroll
        for (int r = 0; r < 3; ++r) { const int row = row0 + r * NGW < NTOK ? row0 + r * NGW : row0; const bf16_t* xr = x + (size_t)row * DM;
#pragma unroll
            for (int j = 0; j < 4; ++j) xb[r][j] = *(const u32x2*)(xr + 256 * j + 4 * c.lane);
            rs[r] = row_rs(c.SSQ(), row); }
        __builtin_amdgcn_sched_barrier(0);
#pragma unroll
        for (int r = 0; r < 3; ++r) { const int row = row0 + r * NGW; if (row < NTOK) {
            float* o = c.out + ((row < NPR) ? O_YP + (size_t)row * DM : O_YS + (size_t)(row - NPR) * DM);
#pragma unroll
            for (int j = 0; j < 4; ++j) { const f32x4 v = (f32x4){bflo(xb[r][j].x), bfhi(xb[r][j].x), bflo(xb[r][j].y), bfhi(xb[r][j].y)}; __builtin_nontemporal_store(v * rs[r] * gv[j], (f32x4*)(o + 256 * j + 4 * c.lane)); } } }
    }
}

#define XB_TMO      128
#define XB_XCNT(j)  (256  + 64 * (j))
#define XB_XSUB(j)  (1280 + 64 * (j))
#define XB_XGEN(j)  (2304 + 64 * (j))
#define XB_TOP      3328
#define XB_TOPGEN   3392
#define XCD_BAR_WORDS 3456
#define XB_SPIN_CAP (1u << 18)

__device__ __forceinline__ unsigned xb_ld(unsigned* p)              { return __hip_atomic_load(p, __ATOMIC_RELAXED, __HIP_MEMORY_SCOPE_AGENT); }
__device__ __forceinline__ unsigned xb_add(unsigned* p, unsigned v) { return __hip_atomic_fetch_add(p, v, __ATOMIC_RELAXED, __HIP_MEMORY_SCOPE_AGENT); }
__device__ __forceinline__ unsigned xb_xcc_id() { return (unsigned)__builtin_amdgcn_s_getreg((3 << 11) | 20) & 0xFu; }
#define XB_SPIN(cond, bar) do { unsigned _sp = 0; while (cond) { __builtin_amdgcn_s_sleep(1); \
    if ((++_sp & 255u) == 0u) { if (xb_ld(&(bar)[XB_TMO])) break; if (_sp > XB_SPIN_CAP) { atomicAdd(&(bar)[XB_TMO], 1u); break; } } } } while (0)

struct XcdBarrier {
    unsigned* bar; unsigned x;
    volatile LAS unsigned* st;
};

__device__ __forceinline__ XcdBarrier xcd_barrier_post(unsigned* bar, volatile LAS unsigned* st, bool leader) {
    XcdBarrier b; b.bar = bar; b.x = xb_xcc_id(); b.st = st;
    if (leader) (void)xb_add(&bar[XB_XCNT(b.x)], 1u);
    return b;
}
__device__ __forceinline__ void xcd_barrier_complete(unsigned* bar, unsigned x, unsigned& nloc, unsigned& nx) {
    const unsigned G = gridDim.x * gridDim.y * gridDim.z;
    unsigned sum, cnt, mine, sp = 0u;
    for (;;) {
        sum = 0u; cnt = 0u; mine = 0u;
#pragma unroll
        for (unsigned j = 0; j < 16; ++j) { const unsigned c = xb_ld(&bar[XB_XCNT(j)]); sum += c; cnt += (c > 0u) ? 1u : 0u; mine = (j == x) ? c : mine; }
        if (sum == G) break;
        __builtin_amdgcn_s_sleep(1);
        if ((++sp & 255u) == 0u) { if (xb_ld(&bar[XB_TMO])) break; if (sp > XB_SPIN_CAP) { atomicAdd(&bar[XB_TMO], 1u); break; } }
    }
    nloc = mine > 0u ? mine : 1u; nx = cnt > 0u ? cnt : 1u;
}

__device__ __forceinline__ void xcd_barrier(const XcdBarrier& b, bool leader) {
    asm volatile("s_waitcnt vmcnt(0)" ::: "memory");
    __syncthreads();
    if (leader) {
        unsigned* bar = b.bar;
        __builtin_amdgcn_s_waitcnt(0);
        unsigned nloc = b.st[0], nx = b.st[1];
        if (nloc == 0u) { xcd_barrier_complete(bar, b.x, nloc, nx); b.st[0] = nloc; b.st[1] = nx; }
        const unsigned old = xb_add(&bar[XB_XSUB(b.x)], 1u);
        const unsigned gen = old / nloc;
        if (old + 1u == (gen + 1u) * nloc) {
            __builtin_amdgcn_fence(__ATOMIC_RELEASE, "agent");
            asm volatile("s_waitcnt vmcnt(0)" ::: "memory");
            const unsigned og = xb_add(&bar[XB_TOP], 1u);
            const unsigned tg = og / nx;
            if (og + 1u == (tg + 1u) * nx) xb_add(&bar[XB_TOPGEN], 1u);
            else XB_SPIN(xb_ld(&bar[XB_TOPGEN]) == tg, bar);
            __builtin_amdgcn_fence(__ATOMIC_ACQUIRE, "agent");
            xb_add(&bar[XB_XGEN(b.x)], 1u);
            asm volatile("s_waitcnt vmcnt(0)" ::: "memory");
        } else {
            XB_SPIN(xb_ld(&bar[XB_XGEN(b.x)]) == gen, bar);
            __builtin_amdgcn_fence(__ATOMIC_ACQUIRE, "agent");
            asm volatile("s_waitcnt vmcnt(0)" ::: "memory");
        }
    }
    __syncthreads();
}

constexpr int PH_PER_LAYER = 9;
DEVI Ctx make_ctx(const Params& p, unsigned char* lds_raw, int wave0) {
    int tid_ = wave0 * 64 + lane_opaque(); asm volatile("" : "+v"(tid_));
    const __attribute__((address_space(4))) Params* kp = (const __attribute__((address_space(4))) Params*)__builtin_amdgcn_kernarg_segment_ptr(); asm volatile("" : "+s"(kp));
    const __attribute__((address_space(4))) ParamsDev* kd = (const __attribute__((address_space(4))) ParamsDev*)kp; Ctx c; c.in.p = kd->in; c.out = (float*)kd->out; c.ws = (unsigned char*)kd->ws; c.lds = (LAS unsigned char*)lds_raw; c.tid = tid_; c.lane = c.tid & 63; c.wave = __builtin_amdgcn_readfirstlane(c.tid >> 6); c.G = gridDim.x; c.bid = blockIdx.x;
    return c;
}
template <int SUB> DEVI void run_sub(const Ctx& c, const Params& p, int layer, int qslot = 0) {
    const bf16_t* xin_p = c.X2(); const bf16_t* xin_s = c.X2() + (size_t)NPR * DM;
    if constexpr (SUB == 1) { pg8::Gemm g{c.X2(), (const bf16_t*)(c.ws + WS_WIN) + (size_t)layer * NZ * DM, MPAD, NZ, DM}; pg8::StaticOrder S; S.init(MPAD, NZ, c.G, c.bid);
        EpiRowScaleBf16<0> E{c.Z(), NZ, c.SSQ(), c.lds + EPI_STG}; pg8::gemm_phase<EpiRowScaleBf16<0>, pg8::StaticOrder, true, true>(c.lds, g, S, E, c.tid);
        if (layer == 0) {
            const int nwg = (MPAD / 256) * (NZ / 256), full = nwg % c.G;
            if (full != 0 && c.bid >= full) convert_weights(c, CONV_ITEMS_PER_LAYER, 2 * CONV_ITEMS_PER_LAYER, (c.bid - full) * 8 + c.wave, (c.G - full) * 8);
            else if (full == 0) convert_weights(c, CONV_ITEMS_PER_LAYER, 2 * CONV_ITEMS_PER_LAYER, c.bid * 8 + c.wave, c.G * 8); } }
    else if constexpr (SUB == 2) phase_mix_local(c, layer, qslot);
    else if constexpr (SUB == 3) phase_scan(c, layer);
    else if constexpr (SUB == 4) phase_mix_out(c, layer, qslot);
    else if constexpr (SUB == 5) { const bf16_t* wt = (const bf16_t*)(c.ws + WS_WOUT) + (size_t)layer * DM * DM;
        { SkEpiResidualNorm se{xin_s, c.X1() + (size_t)NPR * DM, c.SSQ() + (size_t)NPR * 16}; skinny_gemm(c, c.MIX() + (size_t)NPR * DM, wt, DM, DM, se); }
        pg8::Gemm g{c.MIX(), wt, NPR, DM, DM}; pg8::StaticOrder S; S.init(NPR, DM, c.G, c.bid);
        EpiResidualNorm E{xin_p, c.X1(), c.SSQ(), c.lds + EPI_STG}; pg8::gemm_phase<EpiResidualNorm, pg8::StaticOrder, true, true>(c.lds, g, S, E, c.tid); }
    else if constexpr (SUB == 7) { const bf16_t* wt = (const bf16_t*)(c.ws + WS_WUP) + (size_t)layer * FF * DM;
        { SkEpiRelu2 se{c.Hb() + (size_t)NPR * FF, c.SSQ() + (size_t)NPR * 16}; skinny_gemm(c, c.X1() + (size_t)NPR * DM, wt, FF, DM, se); }
        pg8::Gemm g{c.X1(), wt, NPR, FF, DM}; pg8::StaticOrder S; S.init(NPR, FF, c.G, c.bid);
        EpiRowScaleBf16<1> E{c.Hb(), FF, c.SSQ(), c.lds + EPI_STG}; pg8::gemm_phase<EpiRowScaleBf16<1>, pg8::StaticOrder, true, true>(c.lds, g, S, E, c.tid); }
    else if constexpr (SUB == 8) { const bf16_t* wt = (const bf16_t*)(c.ws + WS_WDN) + (size_t)layer * DM * FF;
        { SkEpiResidualNorm se{c.X1() + (size_t)NPR * DM, c.X2() + (size_t)NPR * DM, c.SSQ() + (size_t)NPR * 16}; skinny_gemm(c, c.Hb() + (size_t)NPR * FF, wt, DM, FF, se); }
        pg8::Gemm g{c.Hb(), wt, NPR, DM, FF}; pg8::StaticOrder S; S.init(NPR, DM, c.G, c.bid);
        EpiResidualNorm E{c.X1(), c.X2(), c.SSQ(), c.lds + EPI_STG}; pg8::gemm_phase<EpiResidualNorm, pg8::StaticOrder, true, true>(c.lds, g, S, E, c.tid); }
    else if constexpr (SUB == 9) phase_prologue(c);
    else phase_final(c);
}
template <int SUB> __global__ void __launch_bounds__(NTHREADS, 2) k_sub(Params p, int layer) {
    extern __shared__ __attribute__((aligned(16))) unsigned char lds_raw[];
    const Ctx c = make_ctx(p, lds_raw, __builtin_amdgcn_readfirstlane((int)threadIdx.x >> 6));
    run_sub<SUB>(c, p, layer);
}
template <int SUB> static void launch_sub(const Params& p, int layer, int grid, hipStream_t stream) {
    static bool attr_set = false;
    if (!attr_set) { (void)hipFuncSetAttribute((const void*)k_sub<SUB>, hipFuncAttributeMaxDynamicSharedMemorySize, LDS_BYTES); attr_set = true; }
    hipLaunchKernelGGL(k_sub<SUB>, dim3(grid), dim3(NTHREADS), LDS_BYTES, stream, p, layer);
}

#ifndef REP_A
#define REP_A 1
#endif
#ifndef REP_B
#define REP_B 1
#endif
#ifndef REP_C
#define REP_C 1
#endif
#ifndef REP_D
#define REP_D 1
#endif
#ifndef REP_G1
#define REP_G1 1
#endif
#ifndef REP_G2
#define REP_G2 1
#endif
#ifndef REP_G3
#define REP_G3 1
#endif
#ifndef REP_G4
#define REP_G4 1
#endif
#ifndef REP_ML
#define REP_ML 1
#endif
#ifndef REP_MO
#define REP_MO 1
#endif
#ifndef REP_BAR
#define REP_BAR 1
#endif
#define GRID_BAR() do { for (int rb_ = 0; rb_ < REP_BAR; ++rb_) { XcdBarrier b_; b_.bar = (unsigned*)(c.ws + WS_CTL); b_.x = xb_xcc_id(); b_.st = (volatile LAS unsigned*)(c.lds + LDS_BYTES - 64); xcd_barrier(b_, wave0 == 0 && lane_opaque() == 0); c = make_ctx(p, lds_raw, wave0); } } while (0)
__global__ void __launch_bounds__(NTHREADS, 2) mk_fwd(Params p) {
    extern __shared__ __attribute__((aligned(16))) unsigned char lds_raw[];
    const int wave0 = __builtin_amdgcn_readfirstlane((int)threadIdx.x >> 6);
    Ctx c = make_ctx(p, lds_raw, wave0);
    volatile LAS unsigned* st = (volatile LAS unsigned*)(c.lds + LDS_BYTES - 64);
    if (c.tid < 16) st[c.tid] = 0u;
    __syncthreads();
    (void)xcd_barrier_post((unsigned*)(c.ws + WS_CTL), st, c.tid == 0);
    c = make_ctx(p, lds_raw, wave0);
    if (p.ph_lo < 0) cg::this_grid().sync();
    for (int rep = 0; rep < REP_D; ++rep) run_sub<9>(c, p, 0);
    GRID_BAR();
#pragma unroll 1
    for (int layer = 0; layer < NLAYER; ++layer) {
        for (int rep = 0; rep < REP_A * REP_G1; ++rep) run_sub<1>(c, p, layer);
        GRID_BAR();
        for (int rep = 0; rep < REP_ML; ++rep) run_sub<2>(c, p, layer, rep);
        GRID_BAR();
        for (int rep = 0; rep < REP_D; ++rep) run_sub<3>(c, p, layer);
        GRID_BAR();
        for (int rep = 0; rep < REP_MO; ++rep) run_sub<4>(c, p, layer, rep);
        GRID_BAR();
        for (int rep = 0; rep < REP_A * REP_G2; ++rep) run_sub<5>(c, p, layer);
        GRID_BAR();
        for (int rep = 0; rep < REP_A * REP_G3; ++rep) run_sub<7>(c, p, layer);
        GRID_BAR();
        for (int rep = 0; rep < REP_A * REP_G4; ++rep) run_sub<8>(c, p, layer);
        GRID_BAR();
    }
    for (int rep = 0; rep < REP_D; ++rep) run_sub<10>(c, p, 0);
}

extern "C" void kernel_launch(void* const* d_in, const int* in_sizes, int n_in, void* d_out, int out_size, void* d_ws, size_t ws_size, hipStream_t stream) {
    static int grid = 0;
    if (grid == 0) {
        if (n_in != N_IN || (size_t)out_size != O_END || ws_size < WS_END) { fprintf(stderr, "kernel_launch: unexpected shapes: n_in %d out %d (want %zu) ws %zu (want %zu)\n", n_in, out_size, (size_t)O_END, ws_size, (size_t)WS_END); grid = -1; return; }
        int dev = 0, cus = 0, per_cu = 0;
        (void)hipGetDevice(&dev); (void)hipDeviceGetAttribute(&cus, hipDeviceAttributeMultiprocessorCount, dev);
        if (hipFuncSetAttribute((const void*)mk_fwd, hipFuncAttributeMaxDynamicSharedMemorySize, LDS_BYTES) != hipSuccess) { fprintf(stderr, "kernel_launch: hipFuncSetAttribute failed\n"); grid = -1; return; }
        if (hipOccupancyMaxActiveBlocksPerMultiprocessor(&per_cu, (const void*)mk_fwd, NTHREADS, LDS_BYTES) != hipSuccess || per_cu < 1) { fprintf(stderr, "kernel_launch: occupancy query says %d blocks per CU\n", per_cu); (void)hipGetLastError(); grid = -1; return; }
        grid = (cus > 0 ? cus : 256);
    }
    if (grid < 0) return;
    (void)hipMemsetAsync((char*)d_ws + WS_CTL, 0, CTL_ZERO_BYTES, stream);
    Params p{};
    for (int i = 0; i < N_IN; ++i) p.in[i] = (const float*)d_in[i];
    p.out = (float*)d_out; p.ws = (unsigned char*)d_ws;
    void* args[] = {&p};
    const hipError_t e = hipLaunchCooperativeKernel((const void*)mk_fwd, dim3(grid), dim3(NTHREADS), args, LDS_BYTES, stream);
    if (e != hipSuccess) fprintf(stderr, "kernel_launch: cooperative launch failed: %s (grid %d)\n", hipGetErrorString(e), grid);
}
```

```cpp
#include <hip/hip_runtime.h>
#include <hip/hip_cooperative_groups.h>
#include <cstdio>
#include <cstdint>
namespace cg = cooperative_groups;

namespace pg8 {
#define PG8_LAS __attribute__((address_space(3)))
typedef unsigned short bf16_t;
typedef short bf16x8 __attribute__((ext_vector_type(8)));
typedef float f32x4 __attribute__((ext_vector_type(4)));
typedef unsigned u32x4 __attribute__((ext_vector_type(4)));
constexpr int BM = 256, BK = 64, HALF = 128, HTB = HALF * BK * 2  , STAGE_BYTES = 8 * HTB, NXCD = 8, WGM = 8;

__host__ __device__ __forceinline__ int lds_byte(int r, int c) { const int st = (r >> 4) * 2 + (c >> 5), rr = r & 15, cc = c & 31, ob = rr * 64 + cc * 2; return st * 1024 + (ob ^ (((ob >> 9) & 1) << 5)); }
__host__ __device__ __forceinline__ void stage_rc(int b, int& R, int& C) { const int st = b / 1024, sb = b % 1024, swz = sb ^ (((sb >> 9) & 1) << 5); R = (st >> 1) * 16 + swz / 64; C = (st & 1) * 32 + (swz % 64) / 2; }
__host__ __device__ __forceinline__ int perm32(int rho) { const int n = rho >> 4, i = rho & 15; return 8 * (i >> 2) + 4 * n + (i & 3); }

struct Unit { int pm, pn; };
struct Gemm { const bf16_t* A; const bf16_t* Bt; int M, N, K; };

struct StaticOrder {
    int nM, nN, nwg, G, c;
    __host__ __device__ void init(int M, int N, int G_, int c_) { nM = M / BM; nN = N / BM; nwg = nM * nN; G = G_; c = c_; }
    __host__ __device__ bool next(int i, Unit& u) const {
        const long L = (long)i * G + c; if (L >= nwg) return false;
        int wgid = (int)L; { const int q = nwg / NXCD, r = nwg % NXCD, xcd = wgid % NXCD, off = wgid / NXCD; wgid = (xcd < r ? xcd * (q + 1) : r * (q + 1) + (xcd - r) * q) + off; }
        const int nig = WGM * nN, gid = wgid / nig, fm = gid * WGM, gsz = (nM - fm) < WGM ? (nM - fm) : WGM;
        u.pm = fm + ((wgid % nig) % gsz); u.pn = (wgid % nig) / gsz; return true;
    }
    __device__ __forceinline__ void a_ready(const Unit&) const {}
    __device__ __forceinline__ void done(const Unit&) const {}
};

template <class Epi, class Sched, bool ALIGN_EPI = false, bool SP2 = false>
__device__ __forceinline__ void gemm_phase(PG8_LAS unsigned char* lds, const Gemm g, const Sched& S, const Epi& E, int tid_in) {
    int tid_ = tid_in; asm volatile("" : "+v"(tid_));
    const int tid = tid_, wid = __builtin_amdgcn_readfirstlane(tid >> 6), lane = tid & 63, wr = wid >> 2, wc = wid & 3, fr = lane & 15, fq = lane >> 4;
    const int K = g.K, nt = K / BK;
    unsigned voffA[2], voffB[2];
#pragma unroll
    for (int i = 0; i < 2; ++i) { int R, C; stage_rc(tid * 16 + i * 8192, R, C); const int Rb = Epi::WIDE ? ((R >> 5) * 64 + perm32(R & 31)) : (Epi::PERM ? ((R & ~31) + perm32(R & 31)) : R);
        voffA[i] = (unsigned)(R * K + C) * 2u; voffB[i] = (unsigned)(Rb * K + C) * 2u; }
    const size_t kstep = (size_t)(BK * 2);
    const size_t hstep = (size_t)HALF * K * 2;
    const size_t hstepB = Epi::WIDE ? (size_t)32 * K * 2 : hstep;
    const size_t tstep = 2 * hstep;
    const unsigned ldsw = (unsigned)wid * 1024u;
    const int aoff = lds_byte(wr * 64 + fr, fq * 8), boff = lds_byte(wc * 32 + fr, fq * 8);
#define PG8_SA(b, h) (((b) * 2 + (h)) * HTB)
#define PG8_SB(b, h) ((4 + (b) * 2 + (h)) * HTB)
#define PG8_STAGE(bufoff, gbase, voff) do { _Pragma("unroll") for (int _i = 0; _i < 2; ++_i) \
        __builtin_amdgcn_global_load_lds((const unsigned*)((const char*)(gbase) + (voff)[_i]), (PG8_LAS unsigned*)(lds + (bufoff) + ldsw + _i * 8192), 16, 0, 0); } while (0)
#define PG8_LDA(dst, b, h) do { _Pragma("unroll") for (int m = 0; m < 4; ++m) _Pragma("unroll") for (int k = 0; k < 2; ++k) dst[m][k] = *(const PG8_LAS bf16x8*)(lds + PG8_SA(b, h) + aoff + m * 2048 + k * 1024); } while (0)
#define PG8_LDB(dst, b, h) do { _Pragma("unroll") for (int n = 0; n < 2; ++n) _Pragma("unroll") for (int k = 0; k < 2; ++k) dst[n][k] = *(const PG8_LAS bf16x8*)(lds + PG8_SB(b, h) + boff + n * 2048 + k * 1024); } while (0)
#define PG8_MMA(ai, bj, At, Bt) do { __builtin_amdgcn_s_setprio(1); _Pragma("unroll") for (int m = 0; m < 4; ++m) _Pragma("unroll") for (int n = 0; n < 2; ++n) _Pragma("unroll") for (int k = 0; k < 2; ++k) \
        acc[ai][bj][m][n] = __builtin_amdgcn_mfma_f32_16x16x32_bf16(Bt[n][k], At[m][k], acc[ai][bj][m][n], 0, 0, 0); __builtin_amdgcn_s_setprio(0); } while (0)
#define PG8_WAIT_V(n) asm volatile("s_waitcnt vmcnt(" #n ")" ::: "memory")
#define PG8_WAIT_L(n) asm volatile("s_waitcnt lgkmcnt(" #n ")" ::: "memory")
#define PG8_BAR __builtin_amdgcn_s_barrier()
#define PG8_SCHED __builtin_amdgcn_sched_barrier(0)
    Unit cur, nxt; int ui = 0;
    if (!S.next(0, cur)) return;
    f32x4 acc[2][2][4][2];
#pragma unroll
    for (int a = 0; a < 2; ++a)
#pragma unroll
        for (int b = 0; b < 2; ++b)
#pragma unroll
            for (int m = 0; m < 4; ++m)
#pragma unroll
                for (int n = 0; n < 2; ++n) acc[a][b][m][n] = (f32x4){0.f, 0.f, 0.f, 0.f};
    bf16x8 At[4][2], B0[2][2], B1[2][2];
    const char* cA = (const char*)g.A + (size_t)cur.pm * tstep; const char* cB = (const char*)g.Bt + (size_t)cur.pn * tstep;
    S.a_ready(cur);
    if constexpr (SP2) {
        PG8_STAGE(PG8_SB(0, 0), cB, voffB); PG8_STAGE(PG8_SB(0, 1), cB + hstepB, voffB); PG8_STAGE(PG8_SA(0, 0), cA, voffA); PG8_STAGE(PG8_SA(0, 1), cA + hstep, voffA);
        if (wr == 1) PG8_BAR;
        PG8_WAIT_V(2); PG8_BAR;
        PG8_STAGE(PG8_SB(1, 0), cB + kstep, voffB); PG8_STAGE(PG8_SA(1, 0), cA + kstep, voffA); PG8_STAGE(PG8_SB(1, 1), cB + hstepB + kstep, voffB);
        PG8_WAIT_V(6); PG8_BAR;
    } else {
        PG8_STAGE(PG8_SB(0, 0), cB, voffB); PG8_STAGE(PG8_SA(0, 0), cA, voffA); PG8_STAGE(PG8_SB(0, 1), cB + hstepB, voffB); PG8_STAGE(PG8_SA(0, 1), cA + hstep, voffA);
        if (wr == 1) PG8_BAR;
        PG8_WAIT_V(4); PG8_BAR;
        PG8_STAGE(PG8_SB(1, 0), cB + kstep, voffB); PG8_STAGE(PG8_SA(1, 0), cA + kstep, voffA); PG8_STAGE(PG8_SB(1, 1), cB + hstepB + kstep, voffB);
        PG8_WAIT_V(6); PG8_BAR;
    }
    for (;;) {
        const bool has_next = S.next(ui + 1, nxt);
        const char* nA = has_next ? (const char*)g.A + (size_t)nxt.pm * tstep : cA; const char* nB = has_next ? (const char*)g.Bt + (size_t)nxt.pn * tstep : cB;
        for (int t = 0; t < nt; t += 2) {
            const bool last = (t == nt - 2);
            const char* a1 = cA + (size_t)(t + 1) * kstep;
            const char* a2 = last ? nA : cA + (size_t)(t + 2) * kstep; const char* b2 = last ? nB : cB + (size_t)(t + 2) * kstep;
            const char* a3 = a2 + kstep; const char* b3 = b2 + kstep;
            if (last && has_next) S.a_ready(nxt);
            if constexpr (SP2) {
            PG8_LDB(B0, 0, 0); PG8_LDB(B1, 0, 1); PG8_SCHED; PG8_LDA(At, 0, 0); PG8_STAGE(PG8_SA(1, 1), a1 + hstep, voffA);
            PG8_WAIT_V(8); PG8_WAIT_L(0); PG8_BAR; PG8_MMA(0, 0, At, B0); PG8_MMA(0, 1, At, B1); PG8_BAR; PG8_SCHED;
            PG8_LDA(At, 0, 1); PG8_STAGE(PG8_SB(0, 0), b2, voffB); PG8_STAGE(PG8_SB(0, 1), b2 + hstepB, voffB); PG8_STAGE(PG8_SA(0, 0), a2, voffA);
            PG8_WAIT_V(8); PG8_WAIT_L(0); PG8_BAR; PG8_MMA(1, 0, At, B0); PG8_MMA(1, 1, At, B1); PG8_BAR; PG8_SCHED;
            PG8_LDB(B0, 1, 0); PG8_LDB(B1, 1, 1); PG8_SCHED; PG8_LDA(At, 1, 0); PG8_STAGE(PG8_SA(0, 1), a2 + hstep, voffA);
            PG8_WAIT_V(8); PG8_WAIT_L(0); PG8_BAR; PG8_MMA(0, 0, At, B0); PG8_MMA(0, 1, At, B1); PG8_BAR; PG8_SCHED;
            PG8_LDA(At, 1, 1); PG8_STAGE(PG8_SB(1, 0), b3, voffB); PG8_STAGE(PG8_SB(1, 1), b3 + hstepB, voffB); PG8_STAGE(PG8_SA(1, 0), a3, voffA);
            PG8_WAIT_V(8); PG8_WAIT_L(0); PG8_BAR; PG8_MMA(1, 0, At, B0); PG8_MMA(1, 1, At, B1); PG8_BAR; PG8_SCHED;
            } else {
            PG8_LDB(B0, 0, 0); PG8_SCHED; PG8_LDA(At, 0, 0); PG8_STAGE(PG8_SA(1, 1), a1 + hstep, voffA);
            PG8_WAIT_L(8); PG8_BAR; PG8_WAIT_L(0); PG8_MMA(0, 0, At, B0); PG8_BAR; PG8_SCHED;
            PG8_LDB(B1, 0, 1); PG8_STAGE(PG8_SB(0, 0), b2, voffB);
            PG8_BAR; PG8_WAIT_L(0); PG8_MMA(0, 1, At, B1); PG8_BAR;
            PG8_LDA(At, 0, 1); PG8_STAGE(PG8_SA(0, 0), a2, voffA);
            PG8_BAR; PG8_WAIT_L(0); PG8_MMA(1, 0, At, B0); PG8_BAR; PG8_SCHED;
            PG8_STAGE(PG8_SB(0, 1), b2 + hstepB, voffB);
            PG8_WAIT_V(6); PG8_BAR; PG8_MMA(1, 1, At, B1); PG8_BAR;
            PG8_LDB(B0, 1, 0); PG8_SCHED; PG8_LDA(At, 1, 0); PG8_STAGE(PG8_SA(0, 1), a2 + hstep, voffA);
            PG8_WAIT_L(8); PG8_BAR; PG8_WAIT_L(0); PG8_MMA(0, 0, At, B0); PG8_BAR; PG8_SCHED;
            PG8_LDB(B1, 1, 1); PG8_STAGE(PG8_SB(1, 0), b3, voffB);
            PG8_BAR; PG8_WAIT_L(0); PG8_MMA(0, 1, At, B1); PG8_BAR;
            PG8_LDA(At, 1, 1); PG8_STAGE(PG8_SA(1, 0), a3, voffA);
            PG8_BAR; PG8_WAIT_L(0); PG8_MMA(1, 0, At, B0); PG8_BAR; PG8_SCHED;
            PG8_STAGE(PG8_SB(1, 1), b3 + hstepB, voffB);
            PG8_WAIT_V(6); PG8_BAR; PG8_MMA(1, 1, At, B1); PG8_BAR;
            }
        }
        if constexpr (ALIGN_EPI) { if (wr == 0) PG8_BAR; }
        if constexpr (!Epi::AFTER_DRAIN) { E(acc, cur, wr, wc, fr, fq); S.done(cur); }
        if (!has_next) break;
#pragma unroll
        for (int a = 0; a < 2; ++a)
#pragma unroll
            for (int b = 0; b < 2; ++b)
#pragma unroll
                for (int m = 0; m < 4; ++m)
#pragma unroll
                    for (int n = 0; n < 2; ++n) acc[a][b][m][n] = (f32x4){0.f, 0.f, 0.f, 0.f};
        cur = nxt; cA = nA; cB = nB; ++ui;
        if constexpr (ALIGN_EPI) { if (wr == 1) PG8_BAR; }
    }
    PG8_WAIT_V(0);
    if constexpr (!ALIGN_EPI) { if (wr == 0) PG8_BAR; }
    PG8_BAR;
    if constexpr (Epi::AFTER_DRAIN) { E.fused(acc, cur, wr, wc, fr, fq, lds, wid, lane); S.done(cur); }
#undef PG8_SA
#undef PG8_SB
#undef PG8_STAGE
#undef PG8_LDA
#undef PG8_LDB
#undef PG8_MMA
#undef PG8_WAIT_V
#undef PG8_WAIT_L
#undef PG8_BAR
#undef PG8_SCHED
}
}

#define LAS __attribute__((address_space(3)))
#define DEVI __device__ __forceinline__
typedef unsigned short bf16_t;
typedef float f32x4 __attribute__((ext_vector_type(4)));
typedef unsigned u32x4 __attribute__((ext_vector_type(4)));
typedef unsigned u32x2 __attribute__((ext_vector_type(2)));
typedef short bf16x8_t __attribute__((ext_vector_type(8)));

constexpr int DM = 1024, TSEQ = 8192, NPR = 16384  , NSR = 128  , NTOK = NPR + NSR, MPAD = 16640  ;
constexpr int DIN = 3336, NZ = 3584, FF = 4096, NH = 4, DH = 64, NLAYER = 2, WB = 2048, DECB = 32, DECT = 4;
constexpr float EPSN = 1e-6f, NEGV = -1e30f;
constexpr int ZC_AQ = 0, ZC_AK = 256, ZC_AV = 512, ZC_BQ = 768, ZC_BK = 1024, ZC_BV = 1280, ZC_BO = 1536, ZC_CU = 1792, ZC_CV = 2048, ZC_DQ = 2304, ZC_DF = 2560, ZC_DI = 2816, ZC_DG = 3072;
constexpr int SRC_GATE = 1792, ZC_GI = 3328, ZC_GF = 3332;
enum { I_XP = 0, I_XS, I_CK, I_CV, I_MC, I_MN, I_MM, I_HS, I_RB, I_WIN, I_WOUT, I_GATTN, I_GMLP, I_WUP, I_WDN, I_BI, I_BF, I_GML, I_GCV, I_WS, I_BS, I_LB, I_GHG, I_GFIN, N_IN };
constexpr size_t O_YP = 0, O_YS = O_YP + (size_t)NPR * DM, O_KWP = O_YS + (size_t)NSR * DM, O_VWP = O_KWP + (size_t)NLAYER * 2 * WB * 256, O_KWS = O_VWP + (size_t)NLAYER * 2 * WB * 256,
                 O_VWS = O_KWS + (size_t)NLAYER * DECB * WB * 256, O_CP = O_VWS + (size_t)NLAYER * DECB * WB * 256, O_NP = O_CP + (size_t)NLAYER * 2 * NH * 4096, O_MP = O_NP + (size_t)NLAYER * 2 * NH * 64,
                 O_CS = O_MP + (size_t)NLAYER * 2 * NH, O_NS = O_CS + (size_t)NLAYER * DECB * NH * 4096, O_MS = O_NS + (size_t)NLAYER * DECB * NH * 64, O_SP = O_MS + (size_t)NLAYER * DECB * NH,
                 O_SS = O_SP + (size_t)NLAYER * 2 * NH * 4096, O_CVS = O_SS + (size_t)NLAYER * DECB * NH * 4096, O_END = O_CVS + (size_t)NLAYER * DECB * DECT * 256;
constexpr size_t MiB = 1u << 20;
constexpr size_t WS_CTL = 0, CTL_ZERO_BYTES = 64 * 1024;
constexpr size_t WS_WIN = 1 * MiB, WS_WOUT = 15 * MiB, WS_WUP = 19 * MiB, WS_WDN = 35 * MiB;
constexpr size_t WS_XN = 51 * MiB;
constexpr size_t WS_SMALL = 84 * MiB;
constexpr size_t WS_Z = 86 * MiB, WS_MIX = 200 * MiB, WS_H = WS_Z;
constexpr size_t WS_X1 = 233 * MiB, WS_X2 = 298 * MiB;
constexpr size_t WS_MU = 363 * MiB, WS_MCS = 372 * MiB, WS_HU = 381 * MiB, WS_HSS = 390 * MiB, WS_END = 399 * MiB;
static_assert(WS_Z + (size_t)MPAD * NZ * 2 <= WS_MIX && WS_MIX + (size_t)MPAD * DM * 2 <= WS_X1 && WS_H + (size_t)MPAD * FF * 2 <= WS_X1, "ws map");
static_assert(WS_WIN + 2 * (size_t)NZ * DM * 2 <= WS_WOUT && WS_XN + (size_t)MPAD * DM * 2 <= WS_SMALL, "ws map 2");
constexpr int CONV_ITEMS_WIN = 16 * ((3328 + 32) / 32);
constexpr int CONV_ITEMS_PER_LAYER = 16 * ((3328 + 32) / 32) + 16 * 32 + 16 * (4096 / 32) + 64 * 32;
constexpr size_t SM_SSQ = 0, SM_BT = 1280 * 1024;
constexpr int NCHUNK = 64, NITEM_REC = 2 * NH * NCHUNK;
constexpr size_t REC_N_OFF = (size_t)NITEM_REC * 4096 * 4, REC_M_OFF = REC_N_OFF + (size_t)NITEM_REC * 64 * 4, REC_B_OFF = REC_M_OFF + (size_t)NITEM_REC * 4;
static_assert(REC_B_OFF + NITEM_REC * 4 <= 9 * MiB, "rec scratch");

constexpr int LDS_BYTES = 148480, NTHREADS = 512, EPI_STG = 131072;
#ifndef REP_ATT
#define REP_ATT 1
#endif
#ifndef REP_GMLP
#define REP_GMLP 1
#endif
#ifndef REP_STATE
#define REP_STATE 1
#endif
#ifndef REP_OUT
#define REP_OUT 1
#endif
#ifndef REP_COPY
#define REP_COPY 1
#endif
#ifndef REP_SATT
#define REP_SATT 1
#endif
#ifndef REP_SREC
#define REP_SREC 1
#endif


struct Params { const float* in[N_IN]; float* out; unsigned char* ws; int ph_lo, ph_hi; };

DEVI float bf2f(unsigned v) { return __uint_as_float(v << 16); }
DEVI unsigned pk2(float lo, float hi) { unsigned r; asm("v_cvt_pk_bf16_f32 %0, %1, %2" : "=v"(r) : "v"(lo), "v"(hi)); return r; }
DEVI unsigned f2bf(float f) { return pk2(f, 0.f) & 0xffffu; }
DEVI float bflo(unsigned u) { return __uint_as_float(u << 16); }
DEVI float bfhi(unsigned u) { return __uint_as_float(u & 0xffff0000u); }
DEVI void unpack8(const u32x4 u, float* f) { f[0] = bflo(u.x); f[1] = bfhi(u.x); f[2] = bflo(u.y); f[3] = bfhi(u.y); f[4] = bflo(u.z); f[5] = bfhi(u.z); f[6] = bflo(u.w); f[7] = bfhi(u.w); }
DEVI int lane_opaque() { unsigned z = 0u; asm volatile("" : "+s"(z)); return (int)__builtin_amdgcn_mbcnt_hi(~0u, __builtin_amdgcn_mbcnt_lo(~0u, z)); }
DEVI float shfl_xor_f(float v, int m) {
    const unsigned b = __builtin_bit_cast(unsigned, v);
    if (m == 32) { const auto r = __builtin_amdgcn_permlane32_swap(b, b, false, false); return __builtin_bit_cast(float, (lane_opaque() & 32) ? r[0] : r[1]); }
    if (m == 16) { const auto r = __builtin_amdgcn_permlane16_swap(b, b, false, false); return __builtin_bit_cast(float, (lane_opaque() & 16) ? r[0] : r[1]); }
    return __builtin_bit_cast(float, __builtin_amdgcn_ds_bpermute((lane_opaque() ^ m) << 2, __builtin_bit_cast(int, v)));
}
DEVI float shfl_up_f(float v, int o) { const int l = lane_opaque(); const int s = l - o; return __builtin_bit_cast(float, __builtin_amdgcn_ds_bpermute((s < 0 ? l : s) << 2, __builtin_bit_cast(int, v))); }
typedef short v4i16_t __attribute__((ext_vector_type(4)));
template <int PITCH = 144> DEVI bf16x8_t lds_tfrag(const LAS unsigned char* stage, int ks, int col, int gq) {
    const int i = col & 15, q = i >> 2, p = i & 3;
    const LAS unsigned char* a0 = stage + (32 * ks + 4 * gq + q) * PITCH + ((col - i) + 4 * p) * 2;
    const v4i16_t lo = __builtin_amdgcn_ds_read_tr16_b64_v4i16((LAS v4i16_t*)a0), hi = __builtin_amdgcn_ds_read_tr16_b64_v4i16((LAS v4i16_t*)(a0 + 16 * PITCH));
    return (bf16x8_t){lo[0], lo[1], lo[2], lo[3], hi[0], hi[1], hi[2], hi[3]};
}
DEVI float wave_sum(float v) {
#pragma unroll
    for (int o = 1; o < 64; o <<= 1) v += shfl_xor_f(v, o);
    return v;
}
DEVI float wave_max(float v) {
#pragma unroll
    for (int o = 1; o < 64; o <<= 1) v = fmaxf(v, shfl_xor_f(v, o));
    return v;
}
DEVI float sum8(float v) {
    v += __builtin_bit_cast(float, __builtin_amdgcn_update_dpp(0, __builtin_bit_cast(int, v), 0xB1, 0xF, 0xF, true));
    v += __builtin_bit_cast(float, __builtin_amdgcn_update_dpp(0, __builtin_bit_cast(int, v), 0x4E, 0xF, 0xF, true));
    v += __builtin_bit_cast(float, __builtin_amdgcn_update_dpp(0, __builtin_bit_cast(int, v), 0x141, 0xF, 0xF, true));
    return v;
}
DEVI float sum16(float v) {
    v = sum8(v);
    v += __builtin_bit_cast(float, __builtin_amdgcn_update_dpp(0, __builtin_bit_cast(int, v), 0x140, 0xF, 0xF, true));
    return v;
}
DEVI float frcp(float x) { return __builtin_amdgcn_rcpf(x); }
DEVI float sigmoidf_(float x) { return frcp(1.0f + __expf(-x)); }
DEVI float log1pexp_neg(float a) { return __logf(1.0f + __expf(-a)); }
DEVI float log_sigmoid(float x) { return fminf(x, 0.f) - log1pexp_neg(fabsf(x)); }
DEVI float gelu_tanh(float x) { const float u = 0.7978845608028654f * (x + 0.044715f * x * x * x); return x * frcp(1.0f + __expf(-2.0f * u)); }

#define GAS __attribute__((address_space(1)))
struct InPtrs { GAS const float* const __attribute__((address_space(4)))* p; DEVI const float* operator[](int i) const { return (const float*)p[i]; } };
struct ParamsDev { GAS const float* in[N_IN]; GAS float* out; GAS unsigned char* ws; int ph_lo, ph_hi; };
struct Ctx {
    InPtrs in; float* out; unsigned char* ws;
    LAS unsigned char* lds; int tid, lane, wave, G, bid;
    DEVI bf16_t* Z() const { return (bf16_t*)(ws + WS_Z); }
    DEVI bf16_t* MIX() const { return (bf16_t*)(ws + WS_MIX); }
    DEVI bf16_t* Hb() const { return (bf16_t*)(ws + WS_H); }
    DEVI bf16_t* X1() const { return (bf16_t*)(ws + WS_X1); }
    DEVI bf16_t* X2() const { return (bf16_t*)(ws + WS_X2); }
    DEVI float* SSQ() const { return (float*)(ws + WS_SMALL + SM_SSQ); }
    DEVI float* BT() const { return (float*)(ws + WS_SMALL + SM_BT); }
};

DEVI Ctx relaunder(const Ctx& c0) {
    Ctx c = c0; int t = c0.wave * 64 + lane_opaque(); asm volatile("" : "+v"(t)); c.tid = t; c.lane = t & 63; c.wave = c0.wave;
    auto inp = c0.in.p; asm volatile("" : "+s"(inp)); c.in.p = inp; GAS unsigned char* w = (GAS unsigned char*)c0.ws; asm volatile("" : "+s"(w)); c.ws = (unsigned char*)w; GAS float* o = (GAS float*)c0.out; asm volatile("" : "+s"(o)); c.out = (float*)o; return c;
}
constexpr int CW_QUEUE = 4096;
struct WorkQueue {
    unsigned* ctr; int nxt;
    DEVI void prefetch(const Ctx& c) { int t = 0; if (c.wave == 0 && lane_opaque() == 0) t = (int)__hip_atomic_fetch_add(ctr, 1u, __ATOMIC_RELAXED, __HIP_MEMORY_SCOPE_AGENT); nxt = t; }
    DEVI void start(const Ctx& c, unsigned* counter) { ctr = counter; nxt = 0; prefetch(c); }
    DEVI int pop(const Ctx& c) {
        LAS int* slot = (LAS int*)(c.lds + LDS_BYTES - 32);
        __syncthreads();
        if (c.wave == 0 && lane_opaque() == 0) *slot = nxt;
        __syncthreads();
        return *slot;
    }
};

DEVI float row_rs(const float* ssq, int row) {
    const f32x4* p = (const f32x4*)(ssq + (size_t)row * 16); const f32x4 a = p[0], b = p[1], c2 = p[2], d = p[3];
    const float s = ((a[0] + a[1]) + (a[2] + a[3])) + ((b[0] + b[1]) + (b[2] + b[3])) + ((c2[0] + c2[1]) + (c2[2] + c2[3])) + ((d[0] + d[1]) + (d[2] + d[3]));
    return rsqrtf(s * (1.0f / DM) + EPSN);
}
template <int ACT  > struct EpiRowScaleBf16 {
    static constexpr bool PERM = true, WIDE = true, AFTER_DRAIN = false;
    bf16_t* O; int ldc; const float* ssq; LAS unsigned char* stg;
    __device__ __forceinline__ void operator()(const pg8::f32x4 (&acc)[2][2][4][2], const pg8::Unit& u, int wr, int wc, int fr, int fq) const {
        const int row0 = u.pm * 256 + wr * 64 + fr;
        const int lane = fr + 16 * fq, rr = lane >> 3, sg = lane & 7;
        LAS unsigned char* my = stg + (wr * 4 + wc) * 2048;
        float rsv[2];
#pragma unroll
        for (int j = 0; j < 2; ++j) { const int row = row0 + (fq >> 1) * 128 + (2 * (fq & 1) + j) * 16; rsv[j] = row_rs(ssq, row < NTOK ? row : NTOK - 1); }
        bf16_t* obase = O + (size_t)(u.pm * 256 + wr * 64 + rr) * ldc + u.pn * 256 + wc * 64 + sg * 8;
#pragma unroll
        for (int ai = 0; ai < 2; ++ai)
#pragma unroll
            for (int m = 0; m < 4; ++m) {
                const float s = __builtin_bit_cast(float, __builtin_amdgcn_ds_bpermute((fr + 16 * (2 * ai + (m >> 1))) << 2, __builtin_bit_cast(int, rsv[m & 1])));
#pragma unroll
                for (int bj = 0; bj < 2; ++bj) {
                    pg8::f32x4 v0 = acc[ai][bj][m][0] * s, v1 = acc[ai][bj][m][1] * s;
                    if (ACT == 1) {
#pragma unroll
                        for (int e = 0; e < 4; ++e) { const float a = fmaxf(v0[e], 0.f), b = fmaxf(v1[e], 0.f); v0[e] = a * a; v1[e] = b * b; }
                    }
                    u32x4 w; w.x = pk2(v0[0], v0[1]); w.y = pk2(v0[2], v0[3]); w.z = pk2(v1[0], v1[1]); w.w = pk2(v1[2], v1[3]);
                    *(LAS u32x4*)(my + fr * 128 + (((bj * 4 + fq) ^ (fr & 7)) * 16)) = w;
                }
#pragma unroll
                for (int k = 0; k < 2; ++k) { const int r = rr + 8 * k; const u32x4 w = *(const LAS u32x4*)(my + r * 128 + ((sg ^ (r & 7)) * 16));
                    *(u32x4*)(obase + (size_t)(ai * 128 + m * 16 + 8 * k) * ldc) = w; }
            }
    }
};
struct EpiResidualNorm {
    static constexpr bool PERM = false, WIDE = false, AFTER_DRAIN = false;
    const bf16_t* base; bf16_t* out; float* ssq; LAS unsigned char* stg;
    __device__ __forceinline__ void operator()(const pg8::f32x4 (&acc)[2][2][4][2], const pg8::Unit& u, int wr, int wc, int fr, int fq) const {
        const int lane = fr + 16 * fq, rr = lane >> 3, sg = lane & 7;
        LAS unsigned char* my = stg + (wr * 4 + wc) * 2048;
        const int rbase = u.pm * 256 + wr * 64, cb = u.pn * 256 + wc * 32 + 4 * sg;
        u32x2 pre[4][2][2];
#define RN_LOAD(G) do { _Pragma("unroll") for (int k = 0; k < 2; ++k) _Pragma("unroll") for (int bj = 0; bj < 2; ++bj) \
            pre[(G) & 3][k][bj] = *(const u32x2*)(base + (size_t)(rbase + ((G) >> 2) * 128 + ((G) & 3) * 16 + rr + 8 * k) * DM + cb + bj * 128); } while (0)
        RN_LOAD(0); RN_LOAD(1); RN_LOAD(2); RN_LOAD(3);
        __builtin_amdgcn_sched_barrier(0);
#pragma unroll
        for (int G = 0; G < 8; ++G) {
            const int ai = G >> 2, m = G & 3; float ss[2] = {0.f, 0.f};
#pragma unroll
            for (int bj = 0; bj < 2; ++bj) {
#pragma unroll
                for (int n = 0; n < 2; ++n) *(LAS pg8::f32x4*)(my + fr * 128 + (((n * 4 + fq) ^ (fr & 7)) * 16)) = acc[ai][bj][m][n];
#pragma unroll
                for (int k = 0; k < 2; ++k) { const int r = rr + 8 * k; const pg8::f32x4 v = *(const LAS pg8::f32x4*)(my + r * 128 + ((sg ^ (r & 7)) * 16));
                    const u32x2 pb = pre[G & 3][k][bj]; const pg8::f32x4 x = (pg8::f32x4){bflo(pb.x), bfhi(pb.x), bflo(pb.y), bfhi(pb.y)} + v; const size_t o = (size_t)(rbase + ai * 128 + m * 16 + r) * DM + cb + bj * 128;
                    { u32x2 xb; xb.x = pk2(x[0], x[1]); xb.y = pk2(x[2], x[3]); *(u32x2*)(out + o) = xb; } ss[k] += (x[0] * x[0] + x[1] * x[1]) + (x[2] * x[2] + x[3] * x[3]); }
            }
            if (G + 4 < 8) RN_LOAD(G + 4);
#pragma unroll
            for (int k = 0; k < 2; ++k) { const float s = sum8(ss[k]); if (sg == 0) ssq[(size_t)(rbase + ai * 128 + m * 16 + rr + 8 * k) * 16 + u.pn * 4 + wc] = s; }
        }
#undef RN_LOAD
    }
};

template <class E> DEVI void skinny_gemm(const Ctx& c, const bf16_t* A, const bf16_t* Bt, int N, int K, const E& epi) {
    const int lane = c.lane, fr = lane & 15, gq = lane >> 4, ngrp = N >> 6, total = ngrp * 8, kw = K >> 3;
    LAS float* red = (LAS float*)c.lds;
    bf16x8_t a0[4], b0[4][4], a1[4], b1[4][4];
    const bf16_t* ap = A; const bf16_t* bp = Bt;
#define SK_PTRS(T) { const int ng_ = (T) % ngrp, mg_ = (T) / ngrp; ap = A + (size_t)(mg_ * 16 + fr) * K + c.wave * kw + 8 * gq; bp = Bt + (size_t)(ng_ * 64 + fr) * K + c.wave * kw + 8 * gq; }
#define SK_LOAD(AF, BF, KC) { _Pragma("unroll") for (int s4 = 0; s4 < 4; ++s4) { AF[s4] = *(const bf16x8_t*)(ap + (KC) + 32 * s4); _Pragma("unroll") for (int e = 0; e < 4; ++e) BF[s4][e] = *(const bf16x8_t*)(bp + (size_t)(16 * e) * K + (KC) + 32 * s4); } }
#define SK_MMA(AF, BF) { _Pragma("unroll") for (int s4 = 0; s4 < 4; ++s4) { _Pragma("unroll") for (int e = 0; e < 4; ++e) acc[e] = __builtin_amdgcn_mfma_f32_16x16x32_bf16(BF[s4][e], AF[s4], acc[e], 0, 0, 0); } }
    if (c.bid < total) { SK_PTRS(c.bid); SK_LOAD(a0, b0, 0); }
    for (int task = c.bid; task < total; task += c.G) {
        const int ng = task % ngrp, mg = task / ngrp;
        f32x4 acc[4];
#pragma unroll
        for (int e = 0; e < 4; ++e) acc[e] = (f32x4){0.f, 0.f, 0.f, 0.f};
#pragma unroll 1
        for (int kc = 0; kc < kw; kc += 256) {
            const bool h1 = kc + 128 < kw;
            if (h1) SK_LOAD(a1, b1, kc + 128);
            __builtin_amdgcn_sched_barrier(0);
            SK_MMA(a0, b0);
            __builtin_amdgcn_sched_barrier(0);
            if (h1) {
                if (kc + 256 < kw) SK_LOAD(a0, b0, kc + 256);
                __builtin_amdgcn_sched_barrier(0);
                SK_MMA(a1, b1);
                __builtin_amdgcn_sched_barrier(0);
            }
        }
        if (task + c.G < total) { SK_PTRS(task + c.G); SK_LOAD(a0, b0, 0); }
        __builtin_amdgcn_sched_barrier(0);
        __syncthreads();
#pragma unroll
        for (int e = 0; e < 4; ++e) *(LAS f32x4*)(red + ((c.wave * 4 + e) * 64 + lane) * 4) = acc[e];
        __syncthreads();
        { const int row = c.tid >> 5, cp = c.tid & 31, col = 2 * cp, e = col >> 4, g2 = (col >> 2) & 3, r = col & 3; float s0 = 0.f, s1 = 0.f;
#pragma unroll
          for (int w = 0; w < 8; ++w) { const LAS float* p = red + ((w * 4 + e) * 64 + (g2 * 16 + row)) * 4 + r; s0 += p[0]; s1 += p[1]; }
          float ss = epi.pair(mg * 16 + row, ng * 64 + col, s0, s1);
          ss += shfl_xor_f(ss, 1); ss += shfl_xor_f(ss, 2); ss += shfl_xor_f(ss, 4); ss += shfl_xor_f(ss, 8); ss += shfl_xor_f(ss, 16);
          if (cp == 0) epi.rowsum(mg * 16 + row, ng, ss); }
    }
#undef SK_PTRS
#undef SK_LOAD
#undef SK_MMA
    __syncthreads();
}
struct SkEpiResidualNorm {
    const bf16_t* base; bf16_t* out; float* ssq;
    DEVI float pair(int row, int col, float v0, float v1) const { const size_t o = (size_t)row * DM + col; const unsigned bb = *(const unsigned*)(base + o); const float x0 = bflo(bb) + v0, x1 = bfhi(bb) + v1; *(unsigned*)(out + o) = pk2(x0, x1); return x0 * x0 + x1 * x1; }
    DEVI void rowsum(int row, int slot, float s) const { ssq[(size_t)row * 16 + slot] = s; }
};
struct SkEpiRelu2 { bf16_t* H; const float* ssq;
    DEVI float pair(int row, int col, float v0, float v1) const { const float rs = row_rs(ssq, row); const float a = fmaxf(v0 * rs, 0.f), b = fmaxf(v1 * rs, 0.f); *(unsigned*)(H + (size_t)row * FF + col) = pk2(a * a, b * b); return 0.f; }
    DEVI void rowsum(int, int, float) const {}
};

DEVI void transpose_item(const float* W, int ldw, int src_col0, int K, bf16_t* WT, int dst_row0, LAS float* scr, int k0, int lane, const float* gk) {
    float wv[32];
#pragma unroll
    for (int i = 0; i < 32; ++i) wv[i] = __builtin_nontemporal_load(W + (size_t)(k0 + 2 * i + (lane >> 5)) * ldw + src_col0 + (lane & 31));
#pragma unroll
    for (int i = 0; i < 32; ++i) scr[(2 * i + (lane >> 5)) * 33 + (lane & 31)] = gk ? wv[i] * gk[k0 + 2 * i + (lane >> 5)] : wv[i];
    asm volatile("s_waitcnt lgkmcnt(0)" ::: "memory");
    const int c = lane & 7;
#pragma unroll
    for (int j = 0; j < 4; ++j) { const int n = (lane >> 3) + 8 * j; const LAS float* s = scr + (8 * c) * 33 + n;
        u32x4 o; o.x = pk2(s[0 * 33], s[1 * 33]); o.y = pk2(s[2 * 33], s[3 * 33]); o.z = pk2(s[4 * 33], s[5 * 33]); o.w = pk2(s[6 * 33], s[7 * 33]);
        *(u32x4*)(WT + (size_t)(dst_row0 + n) * K + k0 + 8 * c) = o; }
    asm volatile("s_waitcnt lgkmcnt(0)" ::: "memory");
}
DEVI int rel_bucket(int dist) {
    if (dist < 16) return dist;
    int large = 16 + (int)(log((double)dist / 16.0) / log(128.0) * 16.0);
    large = large < 16 ? 16 : (large > 31 ? 31 : large);
    return large;
}
DEVI void convert_weights(const Ctx& c, int it0, int it1, int wi, int nw) {
    LAS float* scr = (LAS float*)(c.lds + c.wave * 16384);
    constexpr int NZS = 3328 + 32;
    constexpr int I_IN = 16 * (NZS / 32), I_OUT = 16 * 32, I_UP = 16 * (FF / 32), I_DN = 64 * 32, I_L = I_IN + I_OUT + I_UP + I_DN;
    static_assert(I_L == CONV_ITEMS_PER_LAYER, "conversion item count");
    for (int it = it0 + wi; it < it1; it += nw) {
        const int l = it / I_L; int r = it % I_L;
        if (r < I_IN) { const int kb = r / (NZS / 32), nb = r % (NZS / 32), n0 = nb * 32;
            transpose_item(c.in[I_WIN] + (size_t)l * DM * DIN, DIN, n0 == 3328 ? SRC_GATE : n0 + (n0 >= SRC_GATE ? 8 : 0), DM, (bf16_t*)(c.ws + WS_WIN) + (size_t)l * NZ * DM, n0, scr, kb * 64, c.lane, c.in[I_GATTN] + l * DM); continue; }
        r -= I_IN;
        if (r < I_OUT) { const int kb = r / 32, nb = r % 32; transpose_item(c.in[I_WOUT] + (size_t)l * DM * DM, DM, nb * 32, DM, (bf16_t*)(c.ws + WS_WOUT) + (size_t)l * DM * DM, nb * 32, scr, kb * 64, c.lane, nullptr); continue; }
        r -= I_OUT;
        if (r < I_UP) { const int kb = r / (FF / 32), nb = r % (FF / 32); transpose_item(c.in[I_WUP] + (size_t)l * DM * FF, FF, nb * 32, DM, (bf16_t*)(c.ws + WS_WUP) + (size_t)l * FF * DM, nb * 32, scr, kb * 64, c.lane, c.in[I_GMLP] + l * DM); continue; }
        r -= I_UP;
        { const int kb = r / 32, nb = r % 32; transpose_item(c.in[I_WDN] + (size_t)l * FF * DM, DM, nb * 32, FF, (bf16_t*)(c.ws + WS_WDN) + (size_t)l * DM * FF, nb * 32, scr, kb * 64, c.lane, nullptr); }
    }
}
DEVI void phase_prologue(const Ctx& c) {
    const int gw = c.bid * 8 + c.wave, NGW = c.G * 8;
    convert_weights(c, 0, CONV_ITEMS_WIN, gw, NGW);
    for (int idx = c.bid * NTHREADS + c.tid; idx < NLAYER * 224 * (DM / 8); idx += c.G * NTHREADS) { const int l = idx / (224 * (DM / 8)), r = idx % (224 * (DM / 8));
        *(u32x4*)((bf16_t*)(c.ws + WS_WIN) + (size_t)l * NZ * DM + (size_t)3360 * DM + (size_t)r * 8) = (u32x4){0u, 0u, 0u, 0u}; }
    for (int row0 = gw; row0 < NTOK; row0 += 3 * NGW) {
        f32x4 v[3][4];
#pragma unroll
        for (int r = 0; r < 3; ++r) { const int row = row0 + r * NGW < NTOK ? row0 + r * NGW : row0;
            const float* xr = (row < NPR) ? c.in[I_XP] + (size_t)row * DM : c.in[I_XS] + (size_t)(row - NPR) * DM;
#pragma unroll
            for (int j = 0; j < 4; ++j) v[r][j] = __builtin_nontemporal_load((const f32x4*)(xr + 256 * j + 4 * c.lane)); }
        __builtin_amdgcn_sched_barrier(0);
#pragma unroll
        for (int r = 0; r < 3; ++r) { const int row = row0 + r * NGW; if (row < NTOK) {
            float ss = 0.f; u32x2* xb = (u32x2*)(c.X2() + (size_t)row * DM);
#pragma unroll
            for (int j = 0; j < 4; ++j) { ss += (v[r][j][0] * v[r][j][0] + v[r][j][1] * v[r][j][1]) + (v[r][j][2] * v[r][j][2] + v[r][j][3] * v[r][j][3]);
                u32x2 w2; w2.x = pk2(v[r][j][0], v[r][j][1]); w2.y = pk2(v[r][j][2], v[r][j][3]); xb[64 * j + c.lane] = w2; }
            ss = wave_sum(ss);
            if (c.lane < 16) c.SSQ()[(size_t)row * 16 + c.lane] = c.lane == 0 ? ss : 0.f; } }
    }
    if (c.bid == 0) {
        for (int i = c.tid; i < 3 * 129 * 4; i += NTHREADS) { const int h = i & 3, j = (i >> 2) % 129, pat = (i >> 2) / 129; const int d = pat == 0 ? 1 : (pat == 1 ? 4 : 16);
            c.BT()[i] = c.in[I_RB][rel_bucket(j * d) * 4 + h]; }
    }
}

DEVI void attn_sample_qh(const Ctx& c, int layer, int b, int h, int t) {
    const bf16_t* Z = c.Z(); const int lane = c.lane, kg = lane >> 4, c4 = lane & 15;
    const size_t rbase = (size_t)(NPR + b * DECT);
    const size_t qrow = rbase + t;
    LAS float* pl = (LAS float*)(c.lds + c.wave * 1024);
    const u32x2 qu = *(const u32x2*)(Z + qrow * NZ + ZC_AQ + h * 64 + 4 * c4);
    const f32x4 q4 = (f32x4){bflo(qu.x), bfhi(qu.x), bflo(qu.y), bfhi(qu.y)};
    const float* bt = c.BT() + h;
    const float* ck = c.in[I_CK] + ((size_t)(layer * DECB + b) * WB) * 256 + h * 64;
    const float* cv = c.in[I_CV] + ((size_t)(layer * DECB + b) * WB) * 256 + h * 64;
    float Mx = NEGV, wsum = 0.f; f32x4 accv = (f32x4){0.f, 0.f, 0.f, 0.f};
#pragma unroll 1
    for (int pat = 0; pat < 3; ++pat) {
        const int d = 1 << (2 * pat);
        const float* btp = bt + pat * 129 * 4;
        const int pos0 = t - kg * d; const bool isz = pos0 >= 0; const int zp = isz ? pos0 : 0, cp = isz ? -1 : pos0;
        const unsigned loff = (unsigned)((3 - kg) * d * 256 + 4 * c4), loff0 = (unsigned)((WB + cp) * 256 + 4 * c4), loff32 = (unsigned)(4 * c4);
        float lg[33]; f32x4 kv[33];
        const u32x2 uk = *(const u32x2*)(Z + (rbase + zp) * NZ + ZC_AK + h * 64 + 4 * c4);
        kv[0] = *(const f32x4*)(ck + loff0);
#pragma unroll
        for (int it = 1; it < 32; ++it) kv[it] = *(const f32x4*)(ck + (size_t)(WB + t - (4 * it + 3) * d) * 256 + loff);
        kv[32] = *(const f32x4*)(ck + (size_t)(WB + t - 128 * d) * 256 + loff32);
        { const float b0 = btp[lane * 4], b1 = btp[(64 + lane) * 4], b2 = btp[128 * 4]; pl[lane] = b0; pl[64 + lane] = b1; pl[128 + lane] = b2; }
        __builtin_amdgcn_sched_barrier(0);
        kv[0] = (f32x4){isz ? bflo(uk.x) : kv[0][0], isz ? bfhi(uk.x) : kv[0][1], isz ? bflo(uk.y) : kv[0][2], isz ? bfhi(uk.y) : kv[0][3]};
#pragma unroll
        for (int it = 0; it < 33; ++it) {
            const float dot = sum16((q4[0] * kv[it][0] + q4[1] * kv[it][1]) + (q4[2] * kv[it][2] + q4[3] * kv[it][3]));
            lg[it] = (it < 32 || kg == 0) ? dot * 0.125f + pl[4 * it + kg] : NEGV;
        }
        __builtin_amdgcn_sched_barrier(0);
        const u32x2 uv = *(const u32x2*)(Z + (rbase + zp) * NZ + ZC_AV + h * 64 + 4 * c4);
        kv[0] = *(const f32x4*)(cv + loff0);
#pragma unroll
        for (int it = 1; it < 32; ++it) kv[it] = *(const f32x4*)(cv + (size_t)(WB + t - (4 * it + 3) * d) * 256 + loff);
        kv[32] = *(const f32x4*)(cv + (size_t)(WB + t - 128 * d) * 256 + loff32);
        __builtin_amdgcn_sched_barrier(0);
        float m = lg[0];
#pragma unroll
        for (int it = 1; it < 33; ++it) m = fmaxf(m, lg[it]);
        m = fmaxf(m, shfl_xor_f(m, 16)); m = fmaxf(m, shfl_xor_f(m, 32));
        float den = 0.f;
#pragma unroll
        for (int it = 0; it < 33; ++it) { lg[it] = __expf(lg[it] - m); den += lg[it]; }
        den += shfl_xor_f(den, 16); den += shfl_xor_f(den, 32);
        __builtin_amdgcn_sched_barrier(0);
        f32x4 o4 = (f32x4){isz ? bflo(uv.x) : kv[0][0], isz ? bfhi(uv.x) : kv[0][1], isz ? bflo(uv.y) : kv[0][2], isz ? bfhi(uv.y) : kv[0][3]} * lg[0];
#pragma unroll
        for (int it = 1; it < 33; ++it) o4 += kv[it] * lg[it];
#pragma unroll
        for (int e = 0; e < 4; ++e) { o4[e] += shfl_xor_f(o4[e], 16); o4[e] += shfl_xor_f(o4[e], 32); }
        const float lse = m + __logf(den), Mn = fmaxf(Mx, lse), sc = __expf(Mx - Mn), wp = __expf(lse - Mn);
        accv = accv * sc + o4 * (wp / den); wsum = wsum * sc + wp; Mx = Mn;
    }
    if (kg == 0) { const f32x4 r = accv * (1.0f / wsum); u32x2 w; w.x = pk2(r[0], r[1]); w.y = pk2(r[2], r[3]); *(u32x2*)(c.MIX() + qrow * DM + h * 64 + 4 * c4) = w; }
}

constexpr int AT_LBW = 192;
constexpr int AT_OA = 0, AT_LM = 65536, AT_LW = AT_LM + 1024, AT_LB = AT_LW + 1024, AT_VS = AT_LB + 3 * AT_LBW * 4, AT_VS_WAVE = 32 * 144;
static_assert(AT_VS % 16 == 0 && AT_VS + 8 * AT_VS_WAVE <= LDS_BYTES - 64, "attention LDS map");
DEVI void attn_block_item(const Ctx& c, int layer, int b, int h, int blk, WorkQueue& q) {
    const int lane = c.lane, i = lane & 15, gq = lane >> 4;
    LAS float* OA = (LAS float*)(c.lds + AT_OA); LAS float* LM = (LAS float*)(c.lds + AT_LM); LAS float* LW = (LAS float*)(c.lds + AT_LW); LAS float* LB = (LAS float*)(c.lds + AT_LB);
    LAS unsigned char* VS = c.lds + AT_VS + c.wave * AT_VS_WAVE;
    __syncthreads();
    for (int idx = c.tid; idx < 3 * AT_LBW; idx += NTHREADS) { const int pat = idx / AT_LBW, x = idx % AT_LBW - 16, j = 128 - x; LB[idx] = (j >= 0 && j <= 128) ? 1.4426950408889634f * c.BT()[(pat * 129 + j) * 4 + h] : 0.f; }
    __syncthreads();
    const int base = blk * 256;
    const char* zb = (const char*)(c.Z() + (size_t)b * TSEQ * NZ + h * 64);
#define AT_T0(PAT, TK) (base + ((PAT) == 0 ? 16 * (TK) : ((PAT) == 1 ? 64 * ((TK) >> 2) + ((TK) & 3) : (TK))))
    bf16x8_t qf[2], kfr[9][2];
#define AT_KQLOAD(PAT, TK) do { const int d_ = 1 << (2 * (PAT)), t0_ = AT_T0(PAT, TK); const unsigned lk_ = (unsigned)((d_ * i * NZ + 8 * gq) * 2); \
        { const char* qb = zb + ((size_t)(unsigned)t0_ * NZ + ZC_AQ) * 2; qf[0] = *(const bf16x8_t*)(qb + lk_); qf[1] = *(const bf16x8_t*)(qb + lk_ + 64); } \
        _Pragma("unroll") for (int kt = 0; kt < 9; ++kt) { int u_ = t0_ + d_ * (16 * kt - 128); u_ = u_ < 0 ? 0 : u_;     \
            const char* kb = zb + ((size_t)(unsigned)u_ * NZ + ZC_AK) * 2; kfr[kt][0] = *(const bf16x8_t*)(kb + lk_); kfr[kt][1] = *(const bf16x8_t*)(kb + lk_ + 64); } } while (0)
    AT_KQLOAD(0, c.wave);
#pragma unroll 1
    for (int ti = 0; ti < 6; ++ti) {
        {
            const int pat = ti >> 1, tk = c.wave + 8 * (ti & 1), d = 1 << (2 * pat);
            const int t0 = AT_T0(pat, tk);
            const int tq = t0 + d * i;
            const int kmin = 128 - (t0 >> (2 * pat));
            const int vrow0 = lane >> 3;
            u32x4 vr[5][4];
            const unsigned lv = (unsigned)((d * vrow0 * NZ + 8 * (lane & 7)) * 2);
#define AT_VLOAD(S5) do { _Pragma("unroll") for (int n = 0; n < ((S5) == 4 ? 2 : 4); ++n) { int uv = t0 + d * (32 * (S5) + 8 * n - 128); uv = uv < 0 ? 0 : uv;     \
                vr[(S5)][n] = *(const u32x4*)(zb + ((size_t)(unsigned)uv * NZ + ZC_AV) * 2 + lv); } } while (0)
            AT_VLOAD(0); AT_VLOAD(1); AT_VLOAD(2); AT_VLOAD(3); AT_VLOAD(4);
            __builtin_amdgcn_sched_barrier(0);
            f32x4 s[10];
#pragma unroll
            for (int kt = 0; kt < 9; ++kt) {
                f32x4 a = (f32x4){0.f, 0.f, 0.f, 0.f};
                a = __builtin_amdgcn_mfma_f32_16x16x32_bf16(kfr[kt][0], qf[0], a, 0, 0, 0);
                a = __builtin_amdgcn_mfma_f32_16x16x32_bf16(kfr[kt][1], qf[1], a, 0, 0, 0);
                s[kt] = a;
            }
            s[9] = (f32x4){0.f, 0.f, 0.f, 0.f};
            const LAS float* lb = LB + pat * AT_LBW + 16 + 4 * gq - i;
            float mx = NEGV;
#pragma unroll
            for (int half = 0; half < 2; ++half) {
                float bz[5][4];
#pragma unroll
                for (int k5 = 0; k5 < 5; ++k5) { const int kt = 5 * half + k5; if (kt < 9) {
#pragma unroll
                    for (int r = 0; r < 4; ++r) bz[k5][r] = lb[16 * kt + r]; } }
                __builtin_amdgcn_sched_barrier(0);
#pragma unroll
                for (int k5 = 0; k5 < 5; ++k5) { const int kt = 5 * half + k5; if (kt < 9) {
#pragma unroll
                    for (int r = 0; r < 4; ++r) {
                        const bool valid = kt == 0 ? (kmin <= 0 && 4 * gq + r >= i) : (kt == 8 ? (4 * gq + r <= i) : (16 * kt >= kmin));
                        const float lg = valid ? s[kt][r] * (0.125f * 1.4426950408889634f) + bz[k5][r] : NEGV;
                        s[kt][r] = lg; mx = fmaxf(mx, lg);
                    } } }
                __builtin_amdgcn_sched_barrier(0);
            }
            mx = fmaxf(mx, shfl_xor_f(mx, 16)); mx = fmaxf(mx, shfl_xor_f(mx, 32));
            float den = 0.f;
#pragma unroll
            for (int kt = 0; kt < 9; ++kt)
#pragma unroll
                for (int r = 0; r < 4; ++r) { const float pv = __builtin_amdgcn_exp2f(s[kt][r] - mx); s[kt][r] = pv; den += pv; }
            den += shfl_xor_f(den, 16); den += shfl_xor_f(den, 32);
            u32x4 pf[5];
#pragma unroll
            for (int s5 = 0; s5 < 5; ++s5) { pf[s5].x = pk2(s[2 * s5][0], s[2 * s5][1]); pf[s5].y = pk2(s[2 * s5][2], s[2 * s5][3]); pf[s5].z = pk2(s[2 * s5 + 1][0], s[2 * s5 + 1][1]); pf[s5].w = pk2(s[2 * s5 + 1][2], s[2 * s5 + 1][3]); }
            f32x4 o[4];
#pragma unroll
            for (int dt = 0; dt < 4; ++dt) o[dt] = (f32x4){0.f, 0.f, 0.f, 0.f};
#pragma unroll
            for (int s5 = 0; s5 < 5; ++s5) {
                __builtin_amdgcn_sched_barrier(0);
                if (s5 == 2 && ti == 5) q.prefetch(c);
                if (s5 == 2 && ti + 1 < 6) { const int np_ = (ti + 1) >> 1, ntk_ = c.wave + 8 * ((ti + 1) & 1); AT_KQLOAD(np_, ntk_); }
#pragma unroll
                for (int n = 0; n < 4; ++n) *(LAS u32x4*)(VS + (vrow0 + 8 * n) * 144 + (lane & 7) * 16) = (s5 == 4 && n >= 2) ? vr[4][n - 2] : vr[s5][n];
#pragma unroll
                for (int dt = 0; dt < 4; ++dt) {
                    union { u32x4 u; bf16x8_t v; } pp; pp.u = pf[s5];
                    o[dt] = __builtin_amdgcn_mfma_f32_16x16x32_bf16(lds_tfrag<144>(VS, 0, 16 * dt + i, gq), pp.v, o[dt], 0, 0, 0);
                }
            }
#undef AT_VLOAD
            const float inv = frcp(den), lse = mx + __builtin_amdgcn_logf(den); const int tok = tq - base;
            if (pat == 0) {
#pragma unroll
                for (int dt = 0; dt < 4; ++dt) *(LAS f32x4*)(OA + tok * 64 + 16 * dt + 4 * gq) = o[dt] * inv;
                if (gq == 0) { LM[tok] = lse; LW[tok] = 1.0f; }
            } else {
                const float Mo = LM[tok], Wo = LW[tok]; const float Mn = fmaxf(Mo, lse), sc = __builtin_amdgcn_exp2f(Mo - Mn), wl = __builtin_amdgcn_exp2f(lse - Mn), wp = wl * inv; const float wn = Wo * sc + wl;
                if (pat == 1) {
#pragma unroll
                    for (int dt = 0; dt < 4; ++dt) o[dt] = (*(const LAS f32x4*)(OA + tok * 64 + 16 * dt + 4 * gq)) * sc + o[dt] * wp;
#pragma unroll
                    for (int dt = 0; dt < 4; ++dt) *(LAS f32x4*)(OA + tok * 64 + 16 * dt + 4 * gq) = o[dt];
                    asm volatile("s_waitcnt lgkmcnt(0)" ::: "memory");
                    if (gq == 0) { LM[tok] = Mn; LW[tok] = wn; }
                } else {
                    const float rw = frcp(wn);
#pragma unroll
                    for (int dt = 0; dt < 4; ++dt) o[dt] = ((*(const LAS f32x4*)(OA + tok * 64 + 16 * dt + 4 * gq)) * sc + o[dt] * wp) * rw;
#pragma unroll
                    for (int dt = 0; dt < 4; ++dt) { const f32x4 r = o[dt];
                        u32x2 w; w.x = pk2(r[0], r[1]); w.y = pk2(r[2], r[3]); *(u32x2*)(c.MIX() + ((size_t)b * TSEQ + tq) * DM + h * 64 + 16 * dt + 4 * gq) = w; }
                }
            }
        }
        if (ti & 1) __syncthreads();
    }
#undef AT_KQLOAD
#undef AT_T0
}

DEVI void gmlp_item(const Ctx& c, int layer, size_t row0, int nrows, float* chunk_v_out) {
    LAS float* vr = (LAS float*)c.lds;
    const bf16_t* Z = c.Z(); const int lane = c.lane;
    const float* gcv = c.in[I_GCV] + layer * 256;
    __syncthreads();
    for (int r = c.wave; r < nrows; r += 8) {
        const u32x2 u = *(const u32x2*)(Z + (row0 + r) * NZ + ZC_CV + 4 * lane);
        float e0 = gelu_tanh(bflo(u.x)), e1 = gelu_tanh(bfhi(u.x)), e2 = gelu_tanh(bflo(u.y)), e3 = gelu_tanh(bfhi(u.y));
        const float ss = wave_sum((e0 * e0 + e1 * e1) + (e2 * e2 + e3 * e3));
        const float rs = rsqrtf(ss * (1.0f / 256.0f) + EPSN);
        const f32x4 gv = *(const f32x4*)(gcv + 4 * lane);
        f32x4 o; o[0] = e0 * rs * gv[0]; o[1] = e1 * rs * gv[1]; o[2] = e2 * rs * gv[2]; o[3] = e3 * rs * gv[3];
        *(LAS f32x4*)(vr + r * 260 + 4 * lane) = o;
        if (chunk_v_out) *(f32x4*)(chunk_v_out + (size_t)r * 256 + 4 * lane) = o;
    }
    __syncthreads();
    const int t = c.tid >> 2, hh = c.tid & 3;
    const float* wrow = c.in[I_WS] + ((size_t)(layer * NH + hh) * 128 + t) * 128;
    int smax = c.wave * 16 + 15; if (smax > nrows - 1) smax = nrows - 1;
    const float bsv = (t < nrows) ? c.in[I_BS][(layer * NH + hh) * 128 + t] : 0.f;
#pragma unroll 1
    for (int half = 0; half < 2; ++half) {
        float acc[32];
#pragma unroll
        for (int i = 0; i < 32; ++i) acc[i] = 0.f;
#pragma unroll 1
        for (int s = 0; s <= smax; ++s) {
            const float w = (s <= t && t < nrows) ? wrow[s] : 0.f;
            const LAS f32x4* vp = (const LAS f32x4*)(vr + s * 260 + hh * 64 + half * 32);
#pragma unroll
            for (int i = 0; i < 8; ++i) { const f32x4 v = vp[i]; acc[4 * i] += w * v[0]; acc[4 * i + 1] += w * v[1]; acc[4 * i + 2] += w * v[2]; acc[4 * i + 3] += w * v[3]; }
        }
        if (t < nrows) {
            const u32x4* up = (const u32x4*)(Z + (row0 + t) * NZ + ZC_CU + hh * 64 + half * 32);
            u32x4* mp = (u32x4*)(c.MIX() + (row0 + t) * DM + 512 + hh * 64 + half * 32);
#pragma unroll
            for (int i = 0; i < 4; ++i) { float uf[8]; unpack8(up[i], uf); float o[8];
#pragma unroll
                for (int e = 0; e < 8; ++e) o[e] = gelu_tanh(uf[e]) * (acc[8 * i + e] + bsv);
                u32x4 w; w.x = pk2(o[0], o[1]); w.y = pk2(o[2], o[3]); w.z = pk2(o[4], o[5]); w.w = pk2(o[6], o[7]); mp[i] = w; }
        }
    }
    __syncthreads();
}

constexpr int L_A0 = 0, L_A1 = 4096, L_A2 = 8192, L_A3 = 12288, L_HB = 16384, L_SC = 20480;
struct RecIO {
    const float* st_in;
    const float* n_in; const float* m_in;
    float* st_out; float* n_out; float* m_out; float* b_out;
    bool native_in, native_out;
};
template <bool OUT> DEVI void mlstm_item(const Ctx& c, int layer, int hh, size_t row0, int nt, const RecIO& io, float m_init) {
    LAS float* L = (LAS float*)c.lds; const bf16_t* Z = c.Z(); const int tid = c.tid, v = tid >> 3, g = tid & 7;
    float C[8], n[8], m;
    if (io.st_in) { const f32x4 a = *(const f32x4*)(io.st_in + tid * 8), b = *(const f32x4*)(io.st_in + tid * 8 + 4); C[0] = a[0]; C[1] = a[1]; C[2] = a[2]; C[3] = a[3]; C[4] = b[0]; C[5] = b[1]; C[6] = b[2]; C[7] = b[3];
        const f32x4 na = *(const f32x4*)(io.n_in + g * 8), nb = *(const f32x4*)(io.n_in + g * 8 + 4); n[0] = na[0]; n[1] = na[1]; n[2] = na[2]; n[3] = na[3]; n[4] = nb[0]; n[5] = nb[1]; n[6] = nb[2]; n[7] = nb[3]; m = io.m_in[0]; }
    else {
#pragma unroll
        for (int j = 0; j < 8; ++j) { C[j] = 0.f; n[j] = 0.f; } m = m_init; }
    float bsum = 0.f;
    const float gbi = c.in[I_BI][layer * 4 + hh], gbf = c.in[I_BF][layer * 4 + hh];
    for (int seg = 0; seg < nt; seg += 64) {
        const int ns = (nt - seg) < 64 ? (nt - seg) : 64;
        __syncthreads();
        { const int tt = tid >> 3;
          if (tt < ns) { const size_t zr = (row0 + seg + tt) * NZ + hh * 64 + g * 8; float f[8];
            if (OUT) { unpack8(*(const u32x4*)(Z + zr + ZC_BQ), f); *(LAS f32x4*)(L + L_A0 + tt * 64 + g * 8) = (f32x4){f[0], f[1], f[2], f[3]}; *(LAS f32x4*)(L + L_A0 + tt * 64 + g * 8 + 4) = (f32x4){f[4], f[5], f[6], f[7]}; }
            unpack8(*(const u32x4*)(Z + zr + ZC_BK), f); *(LAS f32x4*)(L + L_A1 + tt * 64 + g * 8) = (f32x4){f[0], f[1], f[2], f[3]} * 0.125f; *(LAS f32x4*)(L + L_A1 + tt * 64 + g * 8 + 4) = (f32x4){f[4], f[5], f[6], f[7]} * 0.125f;
            unpack8(*(const u32x4*)(Z + zr + ZC_BV), f); *(LAS f32x4*)(L + L_A2 + tt * 64 + g * 8) = (f32x4){f[0], f[1], f[2], f[3]}; *(LAS f32x4*)(L + L_A2 + tt * 64 + g * 8 + 4) = (f32x4){f[4], f[5], f[6], f[7]}; }
          if (tid < ns) { L[L_SC + tid] = bf2f(Z[(row0 + seg + tid) * NZ + ZC_GI + hh]) + gbi; L[L_SC + 64 + tid] = log_sigmoid(bf2f(Z[(row0 + seg + tid) * NZ + ZC_GF + hh]) + gbf); } }
        __syncthreads();
#pragma unroll 2
        for (int tt = 0; tt < ns; ++tt) {
            const float ii = L[L_SC + tt], lf = L[L_SC + 64 + tt];
            const float mn = fmaxf(lf + m, ii);
            const float a = __expf(lf + m - mn), bb = __expf(ii - mn);
            bsum += lf; m = mn;
            const float bv = bb * L[L_A2 + tt * 64 + v];
            const f32x4 k0 = *(const LAS f32x4*)(L + L_A1 + tt * 64 + g * 8), k1 = *(const LAS f32x4*)(L + L_A1 + tt * 64 + g * 8 + 4);
            const float kk[8] = {k0[0], k0[1], k0[2], k0[3], k1[0], k1[1], k1[2], k1[3]};
#pragma unroll
            for (int j = 0; j < 8; ++j) { C[j] = a * C[j] + bv * kk[j]; n[j] = a * n[j] + bb * kk[j]; }
            if (OUT) {
                const f32x4 q0 = *(const LAS f32x4*)(L + L_A0 + tt * 64 + g * 8), q1 = *(const LAS f32x4*)(L + L_A0 + tt * 64 + g * 8 + 4);
                const float qq[8] = {q0[0], q0[1], q0[2], q0[3], q1[0], q1[1], q1[2], q1[3]};
                float num = 0.f, nq = 0.f;
#pragma unroll
                for (int j = 0; j < 8; ++j) { num += C[j] * qq[j]; nq += n[j] * qq[j]; }
                num = sum8(num); nq = sum8(nq);
                const float den = fmaxf(fabsf(nq), __expf(-mn));
                if (g == 0) L[L_HB + tt * 64 + v] = num / den;
            }
        }
        if (OUT) {
            __syncthreads();
            const int tt = tid >> 3;
            if (tt < ns) {
                const f32x4 h0 = *(const LAS f32x4*)(L + L_HB + tt * 64 + g * 8), h1 = *(const LAS f32x4*)(L + L_HB + tt * 64 + g * 8 + 4);
                float hv[8] = {h0[0], h0[1], h0[2], h0[3], h1[0], h1[1], h1[2], h1[3]}; float ss = 0.f;
#pragma unroll
                for (int j = 0; j < 8; ++j) ss += hv[j] * hv[j];
                ss = sum8(ss);
                const float rs = rsqrtf(ss * (1.0f / 64.0f) + EPSN);
                const float* gm = c.in[I_GML] + layer * 256 + hh * 64 + g * 8; float bo[8];
                unpack8(*(const u32x4*)(Z + (row0 + seg + tt) * NZ + ZC_BO + hh * 64 + g * 8), bo); float o[8];
#pragma unroll
                for (int j = 0; j < 8; ++j) o[j] = sigmoidf_(bo[j]) * (hv[j] * rs * gm[j]);
                u32x4 w; w.x = pk2(o[0], o[1]); w.y = pk2(o[2], o[3]); w.z = pk2(o[4], o[5]); w.w = pk2(o[6], o[7]);
                *(u32x4*)(c.MIX() + (row0 + seg + tt) * DM + 256 + hh * 64 + g * 8) = w;
            }
        }
    }
    if (io.st_out) { *(f32x4*)(io.st_out + tid * 8) = (f32x4){C[0], C[1], C[2], C[3]}; *(f32x4*)(io.st_out + tid * 8 + 4) = (f32x4){C[4], C[5], C[6], C[7]};
        if (v == 0) { *(f32x4*)(io.n_out + g * 8) = (f32x4){n[0], n[1], n[2], n[3]}; *(f32x4*)(io.n_out + g * 8 + 4) = (f32x4){n[4], n[5], n[6], n[7]}; }
        if (tid == 0) { io.m_out[0] = m; if (io.b_out) io.b_out[0] = bsum; } }
    __syncthreads();
}
DEVI float hgrn_lb(const Ctx& c, int layer, int col) {
    if (layer == 0) return 0.f;
    const float a = c.in[I_LB][col], b = c.in[I_LB][256 + col]; const float mx = fmaxf(a, b); const float ea = __expf(a - mx), eb = __expf(b - mx);
    return eb * frcp(ea + eb);
}
DEVI void hgrn_lb8(const Ctx& c, int layer, int col0, float* out) {
    if (layer == 0) {
#pragma unroll
        for (int j = 0; j < 8; ++j) out[j] = 0.f;
        return; }
    const float* lb = c.in[I_LB];
    const f32x4 a0 = *(const f32x4*)(lb + col0), a1 = *(const f32x4*)(lb + col0 + 4), b0 = *(const f32x4*)(lb + 256 + col0), b1 = *(const f32x4*)(lb + 256 + col0 + 4);
#pragma unroll
    for (int j = 0; j < 8; ++j) { const float a = j < 4 ? a0[j & 3] : a1[j & 3], b = j < 4 ? b0[j & 3] : b1[j & 3]; const float mx = fmaxf(a, b); const float ea = __expf(a - mx), eb = __expf(b - mx); out[j] = eb * frcp(ea + eb); }
}
template <bool OUT> DEVI void hgrn_item(const Ctx& c, int layer, int hh, size_t row0, int nt, const RecIO& io) {
    LAS float* L = (LAS float*)c.lds; const bf16_t* Z = c.Z(); const int tid = c.tid, v = tid >> 3, g = tid & 7;
    float S[8], fs[8];
#pragma unroll
    for (int j = 0; j < 8; ++j) { fs[j] = 0.f;
        S[j] = io.st_in ? (io.native_in ? io.st_in[tid * 8 + j] : io.st_in[(g * 8 + j) * 64 + v]) : 0.f; }
    float lbv[8], llb[8], l1m[8];
    {
        hgrn_lb8(c, layer, hh * 64 + g * 8, lbv);
#pragma unroll
        for (int j = 0; j < 8; ++j) { llb[j] = __logf(fmaxf(lbv[j], 1e-30f)); l1m[j] = __logf(1.0f - lbv[j]); }
    }
    for (int seg = 0; seg < nt; seg += 64) {
        const int ns = (nt - seg) < 64 ? (nt - seg) : 64;
        __syncthreads();
        { const int tt = tid >> 3;
          if (tt < ns) { const size_t zr = (row0 + seg + tt) * NZ + hh * 64 + g * 8; float f[8];
            if (OUT) { unpack8(*(const u32x4*)(Z + zr + ZC_DQ), f); *(LAS f32x4*)(L + L_A0 + tt * 64 + g * 8) = (f32x4){f[0], f[1], f[2], f[3]}; *(LAS f32x4*)(L + L_A0 + tt * 64 + g * 8 + 4) = (f32x4){f[4], f[5], f[6], f[7]}; }
            unpack8(*(const u32x4*)(Z + zr + ZC_DF), f); float ff[8], kd[8];
#pragma unroll
            for (int j = 0; j < 8; ++j) { const float x1 = llb[j], x2 = l1m[j] + log_sigmoid(f[j]); const float mx = fmaxf(x1, x2); const float lfd = mx + log1pexp_neg(fabsf(x1 - x2));
                ff[j] = lfd; kd[j] = (1.0f - lbv[j]) * sigmoidf_(-f[j]); }
            *(LAS f32x4*)(L + L_A1 + tt * 64 + g * 8) = (f32x4){ff[0], ff[1], ff[2], ff[3]}; *(LAS f32x4*)(L + L_A1 + tt * 64 + g * 8 + 4) = (f32x4){ff[4], ff[5], ff[6], ff[7]};
            *(LAS f32x4*)(L + L_A2 + tt * 64 + g * 8) = (f32x4){kd[0], kd[1], kd[2], kd[3]}; *(LAS f32x4*)(L + L_A2 + tt * 64 + g * 8 + 4) = (f32x4){kd[4], kd[5], kd[6], kd[7]};
            unpack8(*(const u32x4*)(Z + zr + ZC_DI), f); *(LAS f32x4*)(L + L_A3 + tt * 64 + g * 8) = (f32x4){f[0], f[1], f[2], f[3]}; *(LAS f32x4*)(L + L_A3 + tt * 64 + g * 8 + 4) = (f32x4){f[4], f[5], f[6], f[7]}; } }
        __syncthreads();
#pragma unroll 2
        for (int tt = 0; tt < ns; ++tt) {
            const float vv = L[L_A3 + tt * 64 + v];
            const f32x4 f0 = *(const LAS f32x4*)(L + L_A1 + tt * 64 + g * 8), f1 = *(const LAS f32x4*)(L + L_A1 + tt * 64 + g * 8 + 4);
            const f32x4 k0 = *(const LAS f32x4*)(L + L_A2 + tt * 64 + g * 8), k1 = *(const LAS f32x4*)(L + L_A2 + tt * 64 + g * 8 + 4);
            const float lf[8] = {f0[0], f0[1], f0[2], f0[3], f1[0], f1[1], f1[2], f1[3]}; const float kk[8] = {k0[0], k0[1], k0[2], k0[3], k1[0], k1[1], k1[2], k1[3]};
#pragma unroll
            for (int j = 0; j < 8; ++j) { fs[j] += lf[j]; S[j] = __expf(lf[j]) * S[j] + kk[j] * vv; }
            if (OUT) {
                const f32x4 q0 = *(const LAS f32x4*)(L + L_A0 + tt * 64 + g * 8), q1 = *(const LAS f32x4*)(L + L_A0 + tt * 64 + g * 8 + 4);
                const float qq[8] = {q0[0], q0[1], q0[2], q0[3], q1[0], q1[1], q1[2], q1[3]};
                float o = 0.f;
#pragma unroll
                for (int j = 0; j < 8; ++j) o += qq[j] * S[j];
                o = sum8(o);
                if (g == 0) L[L_HB + tt * 64 + v] = o;
            }
        }
        if (OUT) {
            __syncthreads();
            const int tt = tid >> 3;
            if (tt < ns) {
                const f32x4 h0 = *(const LAS f32x4*)(L + L_HB + tt * 64 + g * 8), h1 = *(const LAS f32x4*)(L + L_HB + tt * 64 + g * 8 + 4);
                float hv[8] = {h0[0], h0[1], h0[2], h0[3], h1[0], h1[1], h1[2], h1[3]}; float ss = 0.f;
#pragma unroll
                for (int j = 0; j < 8; ++j) ss += hv[j] * hv[j];
                ss = sum8(ss);
                const float rs = rsqrtf(ss * (1.0f / 64.0f) + EPSN);
                const float* gm = c.in[I_GHG] + layer * 256 + hh * 64 + g * 8; float dg[8];
                unpack8(*(const u32x4*)(Z + (row0 + seg + tt) * NZ + ZC_DG + hh * 64 + g * 8), dg); float o[8];
#pragma unroll
                for (int j = 0; j < 8; ++j) o[j] = (hv[j] * rs * gm[j]) * (dg[j] * sigmoidf_(dg[j]));
                u32x4 w; w.x = pk2(o[0], o[1]); w.y = pk2(o[2], o[3]); w.z = pk2(o[4], o[5]); w.w = pk2(o[6], o[7]);
                *(u32x4*)(c.MIX() + (row0 + seg + tt) * DM + 768 + hh * 64 + g * 8) = w;
            }
        }
    }
    if (io.st_out) {
#pragma unroll
        for (int j = 0; j < 8; ++j) { if (io.native_out) io.st_out[tid * 8 + j] = S[j]; else io.st_out[(g * 8 + j) * 64 + v] = S[j]; }
        if (io.b_out && v == 0) {
#pragma unroll
            for (int j = 0; j < 8; ++j) io.b_out[g * 8 + j] = __expf(fs[j]); } }
    __syncthreads();
}

constexpr int RSTG = 128 * 144;
DEVI bf16x8_t pack8(const float* f) { union { u32x4 u; bf16x8_t v; } r; r.u.x = pk2(f[0], f[1]); r.u.y = pk2(f[2], f[3]); r.u.z = pk2(f[4], f[5]); r.u.w = pk2(f[6], f[7]); return r.v; }
DEVI bf16x8_t pack8v(const f32x4 a, const f32x4 b) { union { u32x4 u; bf16x8_t v; } r; r.u.x = pk2(a[0], a[1]); r.u.y = pk2(a[2], a[3]); r.u.z = pk2(b[0], b[1]); r.u.w = pk2(b[2], b[3]); return r.v; }
struct StageRegs { u32x4 v[2]; };
DEVI StageRegs stage_load(const bf16_t* src  , int tid) {
    StageRegs r; const int tt = tid >> 2, ch = tid & 3;
#pragma unroll
    for (int e = 0; e < 2; ++e) r.v[e] = *(const u32x4*)(src + (size_t)tt * NZ + 8 * (2 * ch + e));
    return r;
}
DEVI void stage_store(LAS unsigned char* stage, const StageRegs& r, int tid) {
    const int tt = tid >> 2, ch = tid & 3;
#pragma unroll
    for (int e = 0; e < 2; ++e) *(LAS u32x4*)(stage + tt * 144 + (2 * ch + e) * 16) = r.v[e];
}
struct GateRegs { unsigned short gi0, gi1, gf0, gf1; float bi, bfv; };
DEVI GateRegs gate_load(const Ctx& c, int layer, size_t row0, int hh) {
    GateRegs g; const bf16_t* Z = c.Z(); const size_t r0 = (row0 + 2 * c.lane) * NZ, r1 = r0 + NZ;
    g.gi0 = Z[r0 + ZC_GI + hh]; g.gi1 = Z[r1 + ZC_GI + hh]; g.gf0 = Z[r0 + ZC_GF + hh]; g.gf1 = Z[r1 + ZC_GF + hh]; g.bi = c.in[I_BI][layer * 4 + hh]; g.bfv = c.in[I_BF][layer * 4 + hh]; return g;
}
DEVI void mlstm_scalars(const Ctx& c, LAS float* F, const GateRegs& gr, float mprev) {
    if (c.wave == 0) {
        const int lane = c.lane;
        const float i0 = bf2f(gr.gi0) + gr.bi, i1 = bf2f(gr.gi1) + gr.bi, l0 = log_sigmoid(bf2f(gr.gf0) + gr.bfv), l1 = log_sigmoid(bf2f(gr.gf1) + gr.bfv);
        float inc = l0 + l1;
#pragma unroll
        for (int o = 1; o < 64; o <<= 1) { const float y = shfl_up_f(inc, o); if (lane >= o) inc += y; }
        const float b0 = inc - l1, b1 = inc, u0 = i0 - b0, u1 = i1 - b1;
        float mxs = fmaxf(u0, u1);
#pragma unroll
        for (int o = 1; o < 64; o <<= 1) { const float y = shfl_up_f(mxs, o); if (lane >= o) mxs = fmaxf(mxs, y); }
        float ex = shfl_up_f(mxs, 1); if (lane == 0) ex = NEGV;
        const float c0 = fmaxf(ex, u0), c1 = fmaxf(c0, u1);
        F[2 * lane] = b0; F[2 * lane + 1] = b1; F[128 + 2 * lane] = u0; F[128 + 2 * lane + 1] = u1; F[256 + 2 * lane] = fmaxf(b0 + mprev, b0 + c0); F[256 + 2 * lane + 1] = fmaxf(b1 + mprev, b1 + c1);
        if (lane == 63) { F[704] = b1; F[705] = mxs; }
    }
    __syncthreads();
}
constexpr int ML_V = 0, ML_K = RSTG, ML_F = 2 * RSTG, ML_P = ML_F + 4096;
DEVI void mlstm_chunk_state(const Ctx& c, int layer, int hh, size_t row0, float* Uout, float* nout, float* mout, float* bout) {
    LAS unsigned char* VS = c.lds + ML_V; LAS unsigned char* KS = c.lds + ML_K; LAS float* F = (LAS float*)(c.lds + ML_F); LAS float* NP_ = (LAS float*)(c.lds + ML_P);
    const bf16_t* Z = c.Z(); const int tid = c.tid, lane = c.lane, i = lane & 15, gq = lane >> 4;
    const StageRegs vreg = stage_load(Z + row0 * NZ + ZC_BV + hh * 64, tid), kreg = stage_load(Z + row0 * NZ + ZC_BK + hh * 64, tid);
    GateRegs gr{}; if (c.wave == 0) gr = gate_load(c, layer, row0, hh);
    __syncthreads();
    stage_store(VS, vreg, tid);
    mlstm_scalars(c, F, gr, 0.f);
    const float bL = F[704], umax = F[705];
    { const int tt = tid >> 2, ch = tid & 3; const float wsc = 0.125f * __expf(F[128 + tt] - umax);
#pragma unroll
      for (int e = 0; e < 2; ++e) { float f[8]; unpack8(kreg.v[e], f);
#pragma unroll
          for (int j = 0; j < 8; ++j) f[j] *= wsc;
          union { u32x4 u; bf16x8_t v; } pk; pk.v = pack8(f); *(LAS u32x4*)(KS + tt * 144 + (2 * ch + e) * 16) = pk.u; } }
    __syncthreads();
    { const int mt = c.wave >> 1, nt0 = 2 * (c.wave & 1);
      f32x4 acc0 = (f32x4){0.f, 0.f, 0.f, 0.f}, acc1 = acc0;
#pragma unroll
      for (int ks = 0; ks < 4; ++ks) { const bf16x8_t vf = lds_tfrag(VS, ks, 16 * mt + i, gq), k0 = lds_tfrag(KS, ks, 16 * nt0 + i, gq), k1 = lds_tfrag(KS, ks, 16 * (nt0 + 1) + i, gq);
          acc0 = __builtin_amdgcn_mfma_f32_16x16x32_bf16(vf, k0, acc0, 0, 0, 0); acc1 = __builtin_amdgcn_mfma_f32_16x16x32_bf16(vf, k1, acc1, 0, 0, 0); }
#pragma unroll
      for (int r = 0; r < 4; ++r) { Uout[(16 * mt + 4 * gq + r) * 64 + 16 * nt0 + i] = acc0[r]; Uout[(16 * mt + 4 * gq + r) * 64 + 16 * (nt0 + 1) + i] = acc1[r]; } }
    { const int k = tid & 63, part = tid >> 6; float sum = 0.f;
#pragma unroll
      for (int s = 0; s < 16; ++s) sum += bf2f(*(const LAS unsigned short*)(KS + (16 * part + s) * 144 + k * 2));
      NP_[part * 64 + k] = sum; }
    __syncthreads();
    if (tid < 64) { float sum = 0.f;
#pragma unroll
        for (int p8 = 0; p8 < 8; ++p8) sum += NP_[p8 * 64 + tid];
        nout[tid] = sum; }
    if (tid == 0) { mout[0] = bL + umax; bout[0] = bL; }
}
DEVI void mlstm_chunk_out(const Ctx& c, int layer, int hh, size_t row0, const float* Cp, const float* np, const float* mp_) {
    LAS unsigned char* VS = c.lds + ML_V; LAS float* F = (LAS float*)(c.lds + ML_F);
    const bf16_t* Z = c.Z(); const int tid = c.tid, lane = c.lane, i = lane & 15, gq = lane >> 4, w = c.wave;
    const int t = 16 * w + i;
    const StageRegs vreg = stage_load(Z + row0 * NZ + ZC_BV + hh * 64, tid);
    GateRegs gr{}; if (w == 0) gr = gate_load(c, layer, row0, hh);
    const float npv = (tid >= 128 && tid < 192) ? np[tid - 128] : 0.f;
    const float mprev = mp_[0];
    bf16x8_t qf[2], kfr[8][2];
    { const bf16_t* qp = Z + (row0 + t) * NZ + ZC_BQ + hh * 64 + 8 * gq; qf[0] = *(const bf16x8_t*)qp; qf[1] = *(const bf16x8_t*)(qp + 32); }
#pragma unroll
    for (int kt = 0; kt < 8; ++kt) if (kt <= w) { const bf16_t* kp = Z + (row0 + 16 * kt + i) * NZ + ZC_BK + hh * 64 + 8 * gq; kfr[kt][0] = *(const bf16x8_t*)kp; kfr[kt][1] = *(const bf16x8_t*)(kp + 32); }
    __syncthreads();
    stage_store(VS, vreg, tid);
    if (tid >= 128 && tid < 192) F[640 + tid - 128] = npv;
    mlstm_scalars(c, F, gr, mprev);
    u32x2 bog[4]; f32x4 gmv[4];
#pragma unroll
    for (int dt = 0; dt < 4; ++dt) { const int col = hh * 64 + 16 * dt + 4 * gq; gmv[dt] = *(const f32x4*)(c.in[I_GML] + layer * 256 + col); bog[dt] = *(const u32x2*)(Z + (row0 + t) * NZ + ZC_BO + col); }
    const float bt = F[t], mt_ = F[256 + t], wt = bt - mt_, gI = __expf(bt + mprev - mt_);
    f32x4 s[8]; float nqi = 0.f;
#pragma unroll
    for (int kt = 0; kt < 8; ++kt) {
        s[kt] = (f32x4){0.f, 0.f, 0.f, 0.f};
        if (kt <= w) {
            f32x4 a = (f32x4){0.f, 0.f, 0.f, 0.f};
            a = __builtin_amdgcn_mfma_f32_16x16x32_bf16(kfr[kt][0], qf[0], a, 0, 0, 0);
            a = __builtin_amdgcn_mfma_f32_16x16x32_bf16(kfr[kt][1], qf[1], a, 0, 0, 0);
            const f32x4 uu = *(const LAS f32x4*)(F + 128 + 16 * kt + 4 * gq);
#pragma unroll
            for (int r = 0; r < 4; ++r) { const bool valid = (16 * kt + 4 * gq + r) <= t; const float val = a[r] * 0.125f * __expf(valid ? uu[r] + wt : NEGV); a[r] = val; nqi += val; }
            s[kt] = a;
        }
    }
    nqi += shfl_xor_f(nqi, 16); nqi += shfl_xor_f(nqi, 32);
    f32x4 cpr[4][2][2];
#pragma unroll
    for (int dt = 0; dt < 4; ++dt)
#pragma unroll
        for (int ks = 0; ks < 2; ++ks) { const float* cp = Cp + (16 * dt + i) * 64 + 32 * ks + 8 * gq; cpr[dt][ks][0] = *(const f32x4*)cp; cpr[dt][ks][1] = *(const f32x4*)(cp + 4); }
    f32x4 o[4], oi[4];
#pragma unroll
    for (int dt = 0; dt < 4; ++dt) { o[dt] = (f32x4){0.f, 0.f, 0.f, 0.f}; oi[dt] = o[dt]; }
#pragma unroll
    for (int ks = 0; ks < 4; ++ks) {
        if (2 * ks <= w) {
            const bf16x8_t pf = pack8v(s[2 * ks], s[2 * ks + 1]);
#pragma unroll
            for (int dt = 0; dt < 4; ++dt) o[dt] = __builtin_amdgcn_mfma_f32_16x16x32_bf16(lds_tfrag(VS, ks, 16 * dt + i, gq), pf, o[dt], 0, 0, 0);
        }
    }
#pragma unroll
    for (int dt = 0; dt < 4; ++dt)
#pragma unroll
        for (int ks = 0; ks < 2; ++ks) oi[dt] = __builtin_amdgcn_mfma_f32_16x16x32_bf16(pack8v(cpr[dt][ks][0], cpr[dt][ks][1]), qf[ks], oi[dt], 0, 0, 0);
    float nqn = 0.f;
#pragma unroll
    for (int ks = 0; ks < 2; ++ks) { float qv[8]; union { u32x4 u; bf16x8_t v; } qq; qq.v = qf[ks]; unpack8(qq.u, qv);
#pragma unroll
        for (int j = 0; j < 8; ++j) nqn += qv[j] * F[640 + 32 * ks + 8 * gq + j]; }
    nqn += shfl_xor_f(nqn, 16); nqn += shfl_xor_f(nqn, 32);
    const float nq = nqi + gI * nqn, inv = frcp(fmaxf(fabsf(nq), __expf(-mt_)));
    float ss = 0.f;
#pragma unroll
    for (int dt = 0; dt < 4; ++dt) { o[dt] = (o[dt] + oi[dt] * gI) * inv; ss += (o[dt][0] * o[dt][0] + o[dt][1] * o[dt][1]) + (o[dt][2] * o[dt][2] + o[dt][3] * o[dt][3]); }
    ss += shfl_xor_f(ss, 16); ss += shfl_xor_f(ss, 32);
    const float rs = rsqrtf(ss * (1.0f / 64.0f) + EPSN);
#pragma unroll
    for (int dt = 0; dt < 4; ++dt) { const int col = hh * 64 + 16 * dt + 4 * gq; const f32x4 gm = gmv[dt]; const u32x2 bo = bog[dt];
        const float r0 = sigmoidf_(bflo(bo.x)) * (o[dt][0] * rs * gm[0]), r1 = sigmoidf_(bfhi(bo.x)) * (o[dt][1] * rs * gm[1]), r2 = sigmoidf_(bflo(bo.y)) * (o[dt][2] * rs * gm[2]), r3 = sigmoidf_(bfhi(bo.y)) * (o[dt][3] * rs * gm[3]);
        u32x2 wv; wv.x = pk2(r0, r1); wv.y = pk2(r2, r3); *(u32x2*)(c.MIX() + (row0 + t) * DM + 256 + col) = wv; }
}
constexpr int HG_V = 0, HG_K = RSTG, HG_BC = 2 * RSTG, HG_SEG = HG_BC + 32768;
DEVI void hgrn_logf_kd(float lbv, float llb, float l1m, float df, float& lfd, float& kd) {
    const float x2 = l1m + log_sigmoid(df), mx = fmaxf(llb, x2); lfd = mx + log1pexp_neg(fabsf(llb - x2)); kd = (1.0f - lbv) * sigmoidf_(-df);
}
struct DecayRegs { unsigned short df[16]; float lbv; };
DEVI DecayRegs decay_load(const Ctx& c, int layer, int hh, size_t row0) {
    DecayRegs r; const bf16_t* Z = c.Z(); const int d = c.tid & 63, seg = c.tid >> 6;
#pragma unroll
    for (int tt = 0; tt < 16; ++tt) r.df[tt] = Z[(row0 + 16 * seg + tt) * NZ + ZC_DF + hh * 64 + d];
    r.lbv = hgrn_lb(c, layer, hh * 64 + d); return r;
}
DEVI void hgrn_cumdecay(const Ctx& c, const DecayRegs& dr) {
    LAS float* BC = (LAS float*)(c.lds + HG_BC); LAS float* SEG = (LAS float*)(c.lds + HG_SEG);
    const int d = c.tid & 63, seg = c.tid >> 6; const float lbv = dr.lbv, llb = __logf(fmaxf(lbv, 1e-30f)), l1m = __logf(1.0f - lbv);
    float run = 0.f;
#pragma unroll
    for (int tt = 0; tt < 16; ++tt) { const int t = 16 * seg + tt; float lfd, kd; hgrn_logf_kd(lbv, llb, l1m, bf2f(dr.df[tt]), lfd, kd); run += lfd; BC[t * 64 + d] = run; }
    SEG[seg * 64 + d] = run;
    __syncthreads();
    float off = 0.f;
    for (int s2 = 0; s2 < seg; ++s2) off += SEG[s2 * 64 + d];
#pragma unroll 4
    for (int tt = 0; tt < 16; ++tt) BC[(16 * seg + tt) * 64 + d] += off;
    __syncthreads();
}
DEVI void hgrn_chunk_state(const Ctx& c, int layer, int hh, size_t row0, float* Uout  , float* dec_out) {
    LAS unsigned char* VS = c.lds + HG_V; LAS unsigned char* KS = c.lds + HG_K; LAS float* BC = (LAS float*)(c.lds + HG_BC);
    const bf16_t* Z = c.Z(); const int tid = c.tid, lane = c.lane, i = lane & 15, gq = lane >> 4;
    const StageRegs vreg = stage_load(Z + row0 * NZ + ZC_DI + hh * 64, tid), freg = stage_load(Z + row0 * NZ + ZC_DF + hh * 64, tid);
    const DecayRegs dr = decay_load(c, layer, hh, row0);
    float lb16[2][8];
#pragma unroll
    for (int e = 0; e < 2; ++e) hgrn_lb8(c, layer, hh * 64 + 8 * (2 * (tid & 3) + e), lb16[e]);
    __syncthreads();
    stage_store(VS, vreg, tid);
    hgrn_cumdecay(c, dr);
    { const int tt = tid >> 2, ch = tid & 3;
#pragma unroll
      for (int e = 0; e < 2; ++e) { const int d0 = 8 * (2 * ch + e); float f[8]; unpack8(freg.v[e], f);
#pragma unroll
          for (int j = 0; j < 8; ++j) { const float lbv = lb16[e][j]; float lfd, kd; hgrn_logf_kd(lbv, __logf(fmaxf(lbv, 1e-30f)), __logf(1.0f - lbv), f[j], lfd, kd);
              f[j] = kd * __expf(BC[127 * 64 + d0 + j] - BC[tt * 64 + d0 + j]); }
          union { u32x4 u; bf16x8_t v; } pk; pk.v = pack8(f); *(LAS u32x4*)(KS + tt * 144 + (2 * ch + e) * 16) = pk.u; } }
    __syncthreads();
    { const int mt = c.wave >> 1, nt0 = 2 * (c.wave & 1);
      f32x4 acc0 = (f32x4){0.f, 0.f, 0.f, 0.f}, acc1 = acc0;
#pragma unroll
      for (int ks = 0; ks < 4; ++ks) { const bf16x8_t vf = lds_tfrag(VS, ks, 16 * mt + i, gq), k0 = lds_tfrag(KS, ks, 16 * nt0 + i, gq), k1 = lds_tfrag(KS, ks, 16 * (nt0 + 1) + i, gq);
          acc0 = __builtin_amdgcn_mfma_f32_16x16x32_bf16(vf, k0, acc0, 0, 0, 0); acc1 = __builtin_amdgcn_mfma_f32_16x16x32_bf16(vf, k1, acc1, 0, 0, 0); }
#pragma unroll
      for (int r = 0; r < 4; ++r) { Uout[(16 * mt + 4 * gq + r) * 64 + 16 * nt0 + i] = acc0[r]; Uout[(16 * mt + 4 * gq + r) * 64 + 16 * (nt0 + 1) + i] = acc1[r]; } }
    if (tid < 64) dec_out[tid] = __expf(BC[127 * 64 + tid]);
}
DEVI void hgrn_chunk_out(const Ctx& c, int layer, int hh, size_t row0, const float* Sst  ) {
    LAS unsigned char* VS = c.lds + HG_V; LAS float* BC = (LAS float*)(c.lds + HG_BC);
    const bf16_t* Z = c.Z(); const int tid = c.tid, lane = c.lane, i = lane & 15, gq = lane >> 4, w = c.wave;
    const int t = 16 * w + i;
    const StageRegs vreg = stage_load(Z + row0 * NZ + ZC_DI + hh * 64, tid);
    const DecayRegs dr = decay_load(c, layer, hh, row0);
    u32x4 qraw[2], dfr[8][2]; f32x4 spr[4][2][2]; u32x2 dgg[4]; f32x4 gmv[4];
#pragma unroll
    for (int ks = 0; ks < 2; ++ks) qraw[ks] = *(const u32x4*)(Z + (row0 + t) * NZ + ZC_DQ + hh * 64 + 32 * ks + 8 * gq);
#pragma unroll
    for (int kt = 0; kt < 8; ++kt) if (kt <= w) {
#pragma unroll
        for (int ks = 0; ks < 2; ++ks) dfr[kt][ks] = *(const u32x4*)(Z + (row0 + 16 * kt + i) * NZ + ZC_DF + hh * 64 + 32 * ks + 8 * gq); }
    float oml[2][8]; bf16x8_t qf1[2], qf2[2];
#pragma unroll
    for (int ks = 0; ks < 2; ++ks) { hgrn_lb8(c, layer, hh * 64 + 32 * ks + 8 * gq, oml[ks]);
#pragma unroll
        for (int j = 0; j < 8; ++j) oml[ks][j] = 1.0f - oml[ks][j]; }
    __syncthreads();
    stage_store(VS, vreg, tid);
    hgrn_cumdecay(c, dr);
#pragma unroll
    for (int ks = 0; ks < 2; ++ks) { float qv[8]; unpack8(qraw[ks], qv); float q1[8], q2[8];
        const f32x4 b0 = *(const LAS f32x4*)(BC + t * 64 + 32 * ks + 8 * gq), b1 = *(const LAS f32x4*)(BC + t * 64 + 32 * ks + 8 * gq + 4);
        f32x4 r0 = (f32x4){0.f, 0.f, 0.f, 0.f}, r1 = r0;
        if (w > 0) { r0 = *(const LAS f32x4*)(BC + (16 * w - 1) * 64 + 32 * ks + 8 * gq); r1 = *(const LAS f32x4*)(BC + (16 * w - 1) * 64 + 32 * ks + 8 * gq + 4); }
#pragma unroll
        for (int j = 0; j < 8; ++j) { const float bj = j < 4 ? b0[j] : b1[j - 4], rj = j < 4 ? r0[j] : r1[j - 4];
            q1[j] = qv[j] * oml[ks][j] * __expf(bj - rj); q2[j] = qv[j] * __expf(bj); }
        qf1[ks] = pack8(q1); qf2[ks] = pack8(q2); }
    f32x4 s[8];
#pragma unroll
    for (int kt = 0; kt < 8; ++kt) {
        s[kt] = (f32x4){0.f, 0.f, 0.f, 0.f};
        if (kt <= w) {
            const int sk = 16 * kt + i; f32x4 a = (f32x4){0.f, 0.f, 0.f, 0.f};
#pragma unroll
            for (int ks = 0; ks < 2; ++ks) { float f[8]; unpack8(dfr[kt][ks], f);
                const f32x4 b0 = *(const LAS f32x4*)(BC + sk * 64 + 32 * ks + 8 * gq), b1 = *(const LAS f32x4*)(BC + sk * 64 + 32 * ks + 8 * gq + 4);
                f32x4 r0 = (f32x4){0.f, 0.f, 0.f, 0.f}, r1 = r0;
                if (w > 0) { r0 = *(const LAS f32x4*)(BC + (16 * w - 1) * 64 + 32 * ks + 8 * gq); r1 = *(const LAS f32x4*)(BC + (16 * w - 1) * 64 + 32 * ks + 8 * gq + 4); }
#pragma unroll
                for (int j = 0; j < 8; ++j) { const float bj = j < 4 ? b0[j] : b1[j - 4], rj = j < 4 ? r0[j] : r1[j - 4]; f[j] = sigmoidf_(-f[j]) * __expf(fminf(rj - bj, 80.f)); }
                a = __builtin_amdgcn_mfma_f32_16x16x32_bf16(pack8(f), qf1[ks], a, 0, 0, 0); }
#pragma unroll
            for (int r = 0; r < 4; ++r) a[r] = ((16 * kt + 4 * gq + r) <= t) ? a[r] : 0.f;
            s[kt] = a;
        }
    }
#pragma unroll
    for (int dt = 0; dt < 4; ++dt) {
#pragma unroll
        for (int ks = 0; ks < 2; ++ks) { const float* sp = Sst + (16 * dt + i) * 64 + 32 * ks + 8 * gq; spr[dt][ks][0] = *(const f32x4*)sp; spr[dt][ks][1] = *(const f32x4*)(sp + 4); }
        const int col = hh * 64 + 16 * dt + 4 * gq; gmv[dt] = *(const f32x4*)(c.in[I_GHG] + layer * 256 + col); dgg[dt] = *(const u32x2*)(Z + (row0 + t) * NZ + ZC_DG + col); }
    f32x4 o[4];
#pragma unroll
    for (int dt = 0; dt < 4; ++dt) o[dt] = (f32x4){0.f, 0.f, 0.f, 0.f};
#pragma unroll
    for (int ks = 0; ks < 4; ++ks) {
        if (2 * ks <= w) {
            const bf16x8_t pf = pack8v(s[2 * ks], s[2 * ks + 1]);
#pragma unroll
            for (int dt = 0; dt < 4; ++dt) o[dt] = __builtin_amdgcn_mfma_f32_16x16x32_bf16(lds_tfrag(VS, ks, 16 * dt + i, gq), pf, o[dt], 0, 0, 0);
        }
    }
#pragma unroll
    for (int dt = 0; dt < 4; ++dt)
#pragma unroll
        for (int ks = 0; ks < 2; ++ks) o[dt] = __builtin_amdgcn_mfma_f32_16x16x32_bf16(pack8v(spr[dt][ks][0], spr[dt][ks][1]), qf2[ks], o[dt], 0, 0, 0);
    float ss = 0.f;
#pragma unroll
    for (int dt = 0; dt < 4; ++dt) ss += (o[dt][0] * o[dt][0] + o[dt][1] * o[dt][1]) + (o[dt][2] * o[dt][2] + o[dt][3] * o[dt][3]);
    ss += shfl_xor_f(ss, 16); ss += shfl_xor_f(ss, 32);
    const float rs = rsqrtf(ss * (1.0f / 64.0f) + EPSN);
#pragma unroll
    for (int dt = 0; dt < 4; ++dt) { const int col = hh * 64 + 16 * dt + 4 * gq; const f32x4 gm = gmv[dt];
        const u32x2 dg = dgg[dt]; const float g0 = bflo(dg.x), g1 = bfhi(dg.x), g2 = bflo(dg.y), g3 = bfhi(dg.y);
        const float r0 = (o[dt][0] * rs * gm[0]) * (g0 * sigmoidf_(g0)), r1 = (o[dt][1] * rs * gm[1]) * (g1 * sigmoidf_(g1)), r2 = (o[dt][2] * rs * gm[2]) * (g2 * sigmoidf_(g2)), r3 = (o[dt][3] * rs * gm[3]) * (g3 * sigmoidf_(g3));
        u32x2 wv; wv.x = pk2(r0, r1); wv.y = pk2(r2, r3); *(u32x2*)(c.MIX() + (row0 + t) * DM + 768 + col) = wv; }
}

constexpr int GM_PITCH = 528;
DEVI void gmlp_chunk_item(const Ctx& c, int layer, size_t row0) {
    LAS unsigned char* VS = c.lds; const bf16_t* Z = c.Z(); const int lane = c.lane, i = lane & 15, gq = lane >> 4, w = c.wave, t = 16 * w + i;
    bf16x8_t wf[4][4];
    u32x2 cvr[16];
    {
        f32x4 wr[4][4][2];
#pragma unroll
        for (int hh = 0; hh < 4; ++hh)
#pragma unroll
            for (int ks = 0; ks < 4; ++ks) { const float* wp = c.in[I_WS] + ((size_t)(layer * NH + hh) * 128 + t) * 128 + 32 * ks + 4 * gq; wr[hh][ks][0] = *(const f32x4*)wp; wr[hh][ks][1] = *(const f32x4*)(wp + 16); }
#pragma unroll
        for (int rr = 0; rr < 16; ++rr) cvr[rr] = *(const u32x2*)(Z + (row0 + w * 16 + rr) * NZ + ZC_CV + 4 * lane);
#pragma unroll
        for (int hh = 0; hh < 4; ++hh)
#pragma unroll
            for (int ks = 0; ks < 4; ++ks) if (2 * ks <= w) { f32x4 w0 = wr[hh][ks][0], w1 = wr[hh][ks][1];
#pragma unroll
                for (int r = 0; r < 4; ++r) { if (32 * ks + 4 * gq + r > t) w0[r] = 0.f; if (32 * ks + 16 + 4 * gq + r > t) w1[r] = 0.f; }
                wf[hh][ks] = pack8v(w0, w1); }
    }
    __syncthreads();
    { const float* gcv = c.in[I_GCV] + layer * 256; const f32x4 gv = *(const f32x4*)(gcv + 4 * lane);
#pragma unroll
      for (int rr = 0; rr < 16; ++rr) { const u32x2 u = cvr[rr];
          const float e0 = gelu_tanh(bflo(u.x)), e1 = gelu_tanh(bfhi(u.x)), e2 = gelu_tanh(bflo(u.y)), e3 = gelu_tanh(bfhi(u.y));
          const float rs = rsqrtf(wave_sum((e0 * e0 + e1 * e1) + (e2 * e2 + e3 * e3)) * (1.0f / 256.0f) + EPSN);
          u32x2 o; o.x = pk2(e0 * rs * gv[0], e1 * rs * gv[1]); o.y = pk2(e2 * rs * gv[2], e3 * rs * gv[3]);
          *(LAS u32x2*)(VS + (w * 16 + rr) * GM_PITCH + 8 * lane) = o; } }
    __syncthreads();
    u32x2 cur4[4][4]; float bs4[4];
#pragma unroll
    for (int hh = 0; hh < 4; ++hh) {
#pragma unroll
        for (int ct = 0; ct < 4; ++ct) cur4[hh][ct] = *(const u32x2*)(Z + (row0 + t) * NZ + ZC_CU + hh * 64 + 16 * ct + 4 * gq);
        bs4[hh] = c.in[I_BS][(layer * NH + hh) * 128 + t]; }
    __builtin_amdgcn_sched_barrier(0);
#pragma unroll
    for (int hh = 0; hh < 4; ++hh) {
        const u32x2* cur = cur4[hh]; const float bsv = bs4[hh];
        f32x4 acc[4];
#pragma unroll
        for (int ct = 0; ct < 4; ++ct) acc[ct] = (f32x4){0.f, 0.f, 0.f, 0.f};
#pragma unroll
        for (int ks = 0; ks < 4; ++ks) if (2 * ks <= w) {
#pragma unroll
            for (int ct = 0; ct < 4; ++ct) acc[ct] = __builtin_amdgcn_mfma_f32_16x16x32_bf16(lds_tfrag<GM_PITCH>(VS, ks, hh * 64 + 16 * ct + i, gq), wf[hh][ks], acc[ct], 0, 0, 0);
        }
#pragma unroll
        for (int ct = 0; ct < 4; ++ct) { const u32x2 u = cur[ct];
            const float r0 = gelu_tanh(bflo(u.x)) * (acc[ct][0] + bsv), r1 = gelu_tanh(bfhi(u.x)) * (acc[ct][1] + bsv), r2 = gelu_tanh(bflo(u.y)) * (acc[ct][2] + bsv), r3 = gelu_tanh(bfhi(u.y)) * (acc[ct][3] + bsv);
            u32x2 wv; wv.x = pk2(r0, r1); wv.y = pk2(r2, r3); *(u32x2*)(c.MIX() + (row0 + t) * DM + 512 + hh * 64 + 16 * ct + 4 * gq) = wv; }
    }
}

DEVI void copy_item(const Ctx& c, int layer, int it) {
    constexpr int PER_T_P = 2 * WB * 256 / 16384  , PER_T_S = DECB * WB * 256 / 16384  ;
    const bf16_t* Z = c.Z();
    if (it < 2 * PER_T_P) {
        const int kv = it / PER_T_P, r = it % PER_T_P; float* o = c.out + (kv ? O_VWP : O_KWP) + (size_t)layer * 2 * WB * 256 + (size_t)r * 16384; const int zc = kv ? ZC_AV : ZC_AK;
        for (int i = c.tid; i < 4096; i += NTHREADS) { const size_t e = (size_t)r * 16384 + 4 * i; const int b = (int)(e / (WB * 256)), rr = (int)((e / 256) % WB), col = (int)(e % 256);
            const u32x2 u = *(const u32x2*)(Z + ((size_t)b * TSEQ + (TSEQ - WB) + rr) * NZ + zc + col); *(f32x4*)(o + 4 * i) = (f32x4){bflo(u.x), bfhi(u.x), bflo(u.y), bfhi(u.y)}; }
    } else {
        it -= 2 * PER_T_P; const int kv = it / PER_T_S, r = it % PER_T_S; float* o = c.out + (kv ? O_VWS : O_KWS) + (size_t)layer * DECB * WB * 256 + (size_t)r * 16384; const int zc = kv ? ZC_AV : ZC_AK;
        const float* src = c.in[kv ? I_CV : I_CK] + (size_t)layer * DECB * WB * 256;
        if ((r & 31) != 31) {
            const f32x4* s4 = (const f32x4*)(src + (size_t)r * 16384 + DECT * 256); f32x4* o4 = (f32x4*)o; f32x4 v[8];
#pragma unroll
            for (int k = 0; k < 8; ++k) v[k] = __builtin_nontemporal_load(s4 + c.tid + k * NTHREADS);
#pragma unroll
            for (int k = 0; k < 8; ++k) __builtin_nontemporal_store(v[k], o4 + c.tid + k * NTHREADS);
            return;
        }
        for (int i = c.tid; i < 4096; i += NTHREADS) { const size_t e = (size_t)r * 16384 + 4 * i; const int b = (int)(e / (WB * 256)), rr = (int)((e / 256) % WB), col = (int)(e % 256);
            f32x4 val;
            if (rr < WB - DECT) val = *(const f32x4*)(src + ((size_t)b * WB + rr + DECT) * 256 + col);
            else { const u32x2 u = *(const u32x2*)(Z + ((size_t)NPR + b * DECT + (rr - (WB - DECT))) * NZ + zc + col); val = (f32x4){bflo(u.x), bfhi(u.x), bflo(u.y), bfhi(u.y)}; }
            *(f32x4*)(o + 4 * i) = val; }
    }
}
constexpr int N_BIG = 2 * DECB * 8;
DEVI void big_copy_item(const Ctx& c, int layer, int it) {
    const int kv = it >> 8, b = (it >> 3) & 31, j = it & 7, n16 = (j == 7) ? 3 : 4;
    const size_t off = ((size_t)(layer * DECB + b) * WB) * 256 + (size_t)j * 4 * 16384;
    const f32x4* s4 = (const f32x4*)(c.in[kv ? I_CV : I_CK] + off + DECT * 256); f32x4* o4 = (f32x4*)(c.out + (kv ? O_VWS : O_KWS) + off);
    f32x4 v[32];
#pragma unroll
    for (int k = 0; k < 32; ++k) if (k < 8 * n16) v[k] = __builtin_nontemporal_load(s4 + c.tid + k * NTHREADS);
#pragma unroll
    for (int k = 0; k < 32; ++k) if (k < 8 * n16) __builtin_nontemporal_store(v[k], o4 + c.tid + k * NTHREADS);
}
DEVI void phase_mix_local(const Ctx& c0, int layer0, int qslot) {
    WorkQueue q; q.start(c0, (unsigned*)(c0.ws + WS_CTL) + CW_QUEUE + 64 * (2 * layer0) + 64 * 8 * qslot);
    for (;;) {
        const int pos = q.pop(c0);
        if (pos >= 2208) break;
        int it; bool big = false;
        if (pos < 64) it = 1440 + pos;
        else if (pos >= 64 + 102 * 21) { big = true; it = 510 + (pos - (64 + 102 * 21)); }
        else { const int p = pos - 64, g = p / 21, m = p % 21;
            if ((m & 3) == 3) { big = true; it = g * 5 + (m >> 2); }
            else { const int nb = g * 16 + m - ((m + 1) >> 2);
                if (nb < 416) it = nb;
                else { const int p2 = nb - 416, g2 = p2 / 19, m2 = p2 % 19; it = (m2 < 16) ? 416 + g2 * 16 + m2 : 1504 + g2 * 3 + (m2 - 16); } } }
        const Ctx c = relaunder(c0); int layer = layer0; asm volatile("" : "+s"(layer));
        float* MU = (float*)(c.ws + WS_MU); float* HU = (float*)(c.ws + WS_HU);
        if (big || it >= 256) q.prefetch(c);
        if (big) big_copy_item(c, layer, it);
        else if (it < 256) { const int itu = __builtin_amdgcn_readfirstlane(it); const int blk = itu & 31, hh = (itu >> 5) & 3, b = itu >> 7; for (int rp = 0; rp < REP_ATT; ++rp) attn_block_item(c, layer, b, hh, blk, q); }
        else if (it < 384) { for (int rp = 0; rp < REP_GMLP; ++rp) gmlp_chunk_item(c, layer, (size_t)(it - 256) * 128); }
        else if (it < 416) { const int b = it - 384; gmlp_item(c, layer, (size_t)NPR + b * DECT, DECT, c.out + O_CVS + ((size_t)layer * DECB + b) * DECT * 256); }
        else if (it < 928) { const int i2 = it - 416, b = i2 >> 8, hh = (i2 >> 6) & 3, ch = i2 & 63;
            for (int rp = 0; rp < REP_STATE; ++rp) mlstm_chunk_state(c, layer, hh, (size_t)b * TSEQ + ch * 128, MU + (size_t)i2 * 4096, (float*)((char*)MU + REC_N_OFF) + i2 * 64, (float*)((char*)MU + REC_M_OFF) + i2, (float*)((char*)MU + REC_B_OFF) + i2); }
        else if (it < 1440) { const int i2 = it - 928, b = i2 >> 8, hh = (i2 >> 6) & 3, ch = i2 & 63;
            for (int rp = 0; rp < REP_STATE; ++rp) hgrn_chunk_state(c, layer, hh, (size_t)b * TSEQ + ch * 128, HU + (size_t)i2 * 4096, (float*)((char*)HU + REC_N_OFF) + i2 * 64); }
        else if (it < 1504) { const int qh = __builtin_amdgcn_readfirstlane((it - 1440) * 8 + c.wave); const int t = qh & 3, hh = (qh >> 2) & 3, b = qh >> 4; for (int rp = 0; rp < REP_SATT; ++rp) attn_sample_qh(c, layer, b, hh, t); }
        else if (it < 1632) copy_item(c, layer, it - 1504);
        else { const int s = it - 1632; copy_item(c, layer, 128 + (s >> 5) * 1024 + (s & 31) * 32 + 31); }
    }
}

DEVI void phase_scan(const Ctx& c, int layer) {
    float* MU = (float*)(c.ws + WS_MU); float* MCS = (float*)(c.ws + WS_MCS); float* HU = (float*)(c.ws + WS_HU); float* HSS = (float*)(c.ws + WS_HSS);
    const int tid = c.tid; constexpr int GRP = 16;
    for (int it = c.bid; it < 128; it += c.G) {
        const int seq = it >> 3, e = (it & 7) * 512 + tid;
        if (seq < 8) {
            const float* un = (const float*)((const char*)MU + REC_N_OFF); const float* um = (const float*)((const char*)MU + REC_M_OFF); const float* ub = (const float*)((const char*)MU + REC_B_OFF);
            float* csn = (float*)((char*)MCS + REC_N_OFF); float* csm = (float*)((char*)MCS + REC_M_OFF);
            const bool lead = (it & 7) == 0; const bool do_n = lead && tid < 64;
            float C = 0.f, nn = 0.f, m = 0.f;
#pragma unroll 1
            for (int ch0 = 0; ch0 < NCHUNK; ch0 += GRP) {
                const float* up = MU + (size_t)(seq * NCHUNK + ch0) * 4096 + e; float* cp = MCS + (size_t)(seq * NCHUNK + ch0) * 4096 + e; const int item0 = seq * NCHUNK + ch0;
                float u[GRP], nu[GRP], Bv[GRP], mlv[GRP];
#pragma unroll
                for (int q = 0; q < GRP; ++q) { u[q] = up[(size_t)q * 4096]; Bv[q] = ub[item0 + q]; mlv[q] = um[item0 + q]; nu[q] = do_n ? un[(item0 + q) * 64 + tid] : 0.f; }
#pragma unroll
                for (int q = 0; q < GRP; ++q) {
                    cp[(size_t)q * 4096] = C; if (do_n) csn[(item0 + q) * 64 + tid] = nn; if (lead && tid == 0) csm[item0 + q] = m;
                    const float mn = fmaxf(Bv[q] + m, mlv[q]); const float a = __expf(Bv[q] + m - mn), bb = __expf(mlv[q] - mn);
                    C = a * C + bb * u[q]; nn = a * nn + bb * nu[q]; m = mn; }
            }
            c.out[O_CP + ((size_t)layer * 8 + seq) * 4096 + e] = C;
            if (lead && tid == 0) c.out[O_MP + layer * 8 + seq] = m;
            if (do_n) c.out[O_NP + ((size_t)layer * 8 + seq) * 64 + tid] = nn;
        } else {
            const int bh = seq - 8, d = e & 63, v = e >> 6; const float* dec = (const float*)((const char*)HU + REC_N_OFF);
            float S = 0.f;
#pragma unroll 1
            for (int ch0 = 0; ch0 < NCHUNK; ch0 += GRP) {
                const float* up = HU + (size_t)(bh * NCHUNK + ch0) * 4096 + e; float* sp = HSS + (size_t)(bh * NCHUNK + ch0) * 4096 + e; const float* dp = dec + (bh * NCHUNK + ch0) * 64 + d;
                float u[GRP], dd[GRP];
#pragma unroll
                for (int q = 0; q < GRP; ++q) { u[q] = up[(size_t)q * 4096]; dd[q] = dp[q * 64]; }
#pragma unroll
                for (int q = 0; q < GRP; ++q) { sp[(size_t)q * 4096] = S; S = dd[q] * S + u[q]; }
            }
            c.out[O_SP + ((size_t)layer * 8 + bh) * 4096 + d * 64 + v] = S;
        }
    }
}

DEVI void phase_mix_out(const Ctx& c0, int layer0, int qslot) {
    WorkQueue q; q.start(c0, (unsigned*)(c0.ws + WS_CTL) + CW_QUEUE + 64 * (2 * layer0 + 1) + 64 * 8 * qslot);
    for (;;) {
        const int it = q.pop(c0);
        if (it >= 1280) break;
        const Ctx c = relaunder(c0); int layer = layer0; asm volatile("" : "+s"(layer));
        float* MCS = (float*)(c.ws + WS_MCS); float* HSS = (float*)(c.ws + WS_HSS);
        q.prefetch(c);
        if (it < 512) { const int b = it >> 8, hh = (it >> 6) & 3, ch = it & 63; RecIO io{}; io.st_in = MCS + (size_t)it * 4096; io.n_in = (const float*)((const char*)MCS + REC_N_OFF) + it * 64; io.m_in = (const float*)((const char*)MCS + REC_M_OFF) + it;
            for (int rp = 0; rp < REP_OUT; ++rp) mlstm_chunk_out(c, layer, hh, (size_t)b * TSEQ + ch * 128, io.st_in, io.n_in, io.m_in); }
        else if (it < 1024) { const int i2 = it - 512, b = i2 >> 8, hh = (i2 >> 6) & 3, ch = i2 & 63; RecIO io{}; io.st_in = HSS + (size_t)i2 * 4096; io.native_in = true;
            for (int rp = 0; rp < REP_OUT; ++rp) hgrn_chunk_out(c, layer, hh, (size_t)b * TSEQ + ch * 128, io.st_in); }
        else if (it < 1152) { const int i2 = it - 1024, b = i2 >> 2, hh = i2 & 3; const size_t sidx = (size_t)(layer * DECB + b) * NH + hh; RecIO io{};
            io.st_in = c.in[I_MC] + sidx * 4096; io.n_in = c.in[I_MN] + sidx * 64; io.m_in = c.in[I_MM] + sidx;
            io.st_out = c.out + O_CS + sidx * 4096; io.n_out = c.out + O_NS + sidx * 64; io.m_out = c.out + O_MS + sidx;
            for (int rp = 0; rp < REP_SREC; ++rp) mlstm_item<true>(c, layer, hh, (size_t)NPR + b * DECT, DECT, io, 0.f); }
        else { const int i2 = it - 1152, b = i2 >> 2, hh = i2 & 3; const size_t sidx = (size_t)(layer * DECB + b) * NH + hh; RecIO io{};
            io.st_in = c.in[I_HS] + sidx * 4096; io.st_out = c.out + O_SS + sidx * 4096;
            for (int rp = 0; rp < REP_SREC; ++rp) hgrn_item<true>(c, layer, hh, (size_t)NPR + b * DECT, DECT, io); }
    }
}

DEVI void phase_final(const Ctx& c) {
    const int gw = c.bid * 8 + c.wave, NGW = c.G * 8; const bf16_t* x = c.X2(); const float* g = c.in[I_GFIN];
    f32x4 gv[4];
#pragma unroll
    for (int j = 0; j < 4; ++j) gv[j] = *(const f32x4*)(g + 256 * j + 4 * c.lane);
    for (int row0 = gw; row0 < NTOK; row0 += 3 * NGW) {
        u32x2 xb[3][4]; float rs[3];
#pragma unroll
        for (int r = 0; r < 3; ++r) { const int row = row0 + r * NGW < NTOK ? row0 + r * NGW : row0; const bf16_t* xr = x + (size_t)row * DM;
#pragma unroll
            for (int j = 0; j < 4; ++j) xb[r][j] = *(const u32x2*)(xr + 256 * j + 4 * c.lane);
            rs[r] = row_rs(c.SSQ(), row); }
        __builtin_amdgcn_sched_barrier(0);
#pragma unroll
        for (int r = 0; r < 3; ++r) { const int row = row0 + r * NGW; if (row < NTOK) {
            float* o = c.out + ((row < NPR) ? O_YP + (size_t)row * DM : O_YS + (size_t)(row - NPR) * DM);
#pragma unroll
            for (int j = 0; j < 4; ++j) { const f32x4 v = (f32x4){bflo(xb[r][j].x), bfhi(xb[r][j].x), bflo(xb[r][j].y), bfhi(xb[r][j].y)}; __builtin_nontemporal_store(v * rs[r] * gv[j], (f32x4*)(o + 256 * j + 4 * c.lane)); } } }
    }
}

#define XB_TMO      128
#define XB_XCNT(j)  (256  + 64 * (j))
#define XB_XSUB(j)  (1280 + 64 * (j))
#define XB_XGEN(j)  (2304 + 64 * (j))
#define XB_TOP      3328
#define XB_TOPGEN   3392
#define XCD_BAR_WORDS 3456
#define XB_SPIN_CAP (1u << 18)

__device__ __forceinline__ unsigned xb_ld(unsigned* p)              { return __hip_atomic_load(p, __ATOMIC_RELAXED, __HIP_MEMORY_SCOPE_AGENT); }
__device__ __forceinline__ unsigned xb_add(unsigned* p, unsigned v) { return __hip_atomic_fetch_add(p, v, __ATOMIC_RELAXED, __HIP_MEMORY_SCOPE_AGENT); }
__device__ __forceinline__ unsigned xb_xcc_id() { return (unsigned)__builtin_amdgcn_s_getreg((3 << 11) | 20) & 0xFu; }
#define XB_SPIN(cond, bar) do { unsigned _sp = 0; while (cond) { __builtin_amdgcn_s_sleep(1); \
    if ((++_sp & 255u) == 0u) { if (xb_ld(&(bar)[XB_TMO])) break; if (_sp > XB_SPIN_CAP) { atomicAdd(&(bar)[XB_TMO], 1u); break; } } } } while (0)

struct XcdBarrier {
    unsigned* bar; unsigned x;
    volatile LAS unsigned* st;
};

__device__ __forceinline__ XcdBarrier xcd_barrier_post(unsigned* bar, volatile LAS unsigned* st, bool leader) {
    XcdBarrier b; b.bar = bar; b.x = xb_xcc_id(); b.st = st;
    if (leader) (void)xb_add(&bar[XB_XCNT(b.x)], 1u);
    return b;
}
__device__ __forceinline__ void xcd_barrier_complete(unsigned* bar, unsigned x, unsigned& nloc, unsigned& nx) {
    const unsigned G = gridDim.x * gridDim.y * gridDim.z;
    unsigned sum, cnt, mine, sp = 0u;
    for (;;) {
        sum = 0u; cnt = 0u; mine = 0u;
#pragma unroll
        for (unsigned j = 0; j < 16; ++j) { const unsigned c = xb_ld(&bar[XB_XCNT(j)]); sum += c; cnt += (c > 0u) ? 1u : 0u; mine = (j == x) ? c : mine; }
        if (sum == G) break;
        __builtin_amdgcn_s_sleep(1);
        if ((++sp & 255u) == 0u) { if (xb_ld(&bar[XB_TMO])) break; if (sp > XB_SPIN_CAP) { atomicAdd(&bar[XB_TMO], 1u); break; } }
    }
    nloc = mine > 0u ? mine : 1u; nx = cnt > 0u ? cnt : 1u;
}

__device__ __forceinline__ void xcd_barrier(const XcdBarrier& b, bool leader) {
    asm volatile("s_waitcnt vmcnt(0)" ::: "memory");
    __syncthreads();
    if (leader) {
        unsigned* bar = b.bar;
        __builtin_amdgcn_s_waitcnt(0);
        unsigned nloc = b.st[0], nx = b.st[1];
        if (nloc == 0u) { xcd_barrier_complete(bar, b.x, nloc, nx); b.st[0] = nloc; b.st[1] = nx; }
        const unsigned old = xb_add(&bar[XB_XSUB(b.x)], 1u);
        const unsigned gen = old / nloc;
        if (old + 1u == (gen + 1u) * nloc) {
            __builtin_amdgcn_fence(__ATOMIC_RELEASE, "agent");
            asm volatile("s_waitcnt vmcnt(0)" ::: "memory");
            const unsigned og = xb_add(&bar[XB_TOP], 1u);
            const unsigned tg = og / nx;
            if (og + 1u == (tg + 1u) * nx) xb_add(&bar[XB_TOPGEN], 1u);
            else XB_SPIN(xb_ld(&bar[XB_TOPGEN]) == tg, bar);
            __builtin_amdgcn_fence(__ATOMIC_ACQUIRE, "agent");
            xb_add(&bar[XB_XGEN(b.x)], 1u);
            asm volatile("s_waitcnt vmcnt(0)" ::: "memory");
        } else {
            XB_SPIN(xb_ld(&bar[XB_XGEN(b.x)]) == gen, bar);
            __builtin_amdgcn_fence(__ATOMIC_ACQUIRE, "agent");
            asm volatile("s_waitcnt vmcnt(0)" ::: "memory");
        }
    }
    __syncthreads();
}

constexpr int PH_PER_LAYER = 9;
DEVI Ctx make_ctx(const Params& p, unsigned char* lds_raw, int wave0) {
    int tid_ = wave0 * 64 + lane_opaque(); asm volatile("" : "+v"(tid_));
    const __attribute__((address_space(4))) Params* kp = (const __attribute__((address_space(4))) Params*)__builtin_amdgcn_kernarg_segment_ptr(); asm volatile("" : "+s"(kp));
    const __attribute__((address_space(4))) ParamsDev* kd = (const __attribute__((address_space(4))) ParamsDev*)kp; Ctx c; c.in.p = kd->in; c.out = (float*)kd->out; c.ws = (unsigned char*)kd->ws; c.lds = (LAS unsigned char*)lds_raw; c.tid = tid_; c.lane = c.tid & 63; c.wave = __builtin_amdgcn_readfirstlane(c.tid >> 6); c.G = gridDim.x; c.bid = blockIdx.x;
    return c;
}
template <int SUB> DEVI void run_sub(const Ctx& c, const Params& p, int layer, int qslot = 0) {
    const bf16_t* xin_p = c.X2(); const bf16_t* xin_s = c.X2() + (size_t)NPR * DM;
    if constexpr (SUB == 1) { pg8::Gemm g{c.X2(), (const bf16_t*)(c.ws + WS_WIN) + (size_t)layer * NZ * DM, MPAD, NZ, DM}; pg8::StaticOrder S; S.init(MPAD, NZ, c.G, c.bid);
        EpiRowScaleBf16<0> E{c.Z(), NZ, c.SSQ(), c.lds + EPI_STG}; pg8::gemm_phase<EpiRowScaleBf16<0>, pg8::StaticOrder, true, true>(c.lds, g, S, E, c.tid);
        {
            const int nwg = (MPAD / 256) * (NZ / 256), full = nwg % c.G;
            const int i0 = layer == 0 ? CONV_ITEMS_WIN : CONV_ITEMS_PER_LAYER + CONV_ITEMS_WIN, i1 = layer == 0 ? CONV_ITEMS_PER_LAYER + CONV_ITEMS_WIN : 2 * CONV_ITEMS_PER_LAYER;
            if (full != 0 && c.bid >= full) convert_weights(c, i0, i1, (c.bid - full) * 8 + c.wave, (c.G - full) * 8);
            else if (full == 0) convert_weights(c, i0, i1, c.bid * 8 + c.wave, c.G * 8); } }
    else if constexpr (SUB == 2) phase_mix_local(c, layer, qslot);
    else if constexpr (SUB == 3) phase_scan(c, layer);
    else if constexpr (SUB == 4) phase_mix_out(c, layer, qslot);
    else if constexpr (SUB == 5) { const bf16_t* wt = (const bf16_t*)(c.ws + WS_WOUT) + (size_t)layer * DM * DM;
        { SkEpiResidualNorm se{xin_s, c.X1() + (size_t)NPR * DM, c.SSQ() + (size_t)NPR * 16}; skinny_gemm(c, c.MIX() + (size_t)NPR * DM, wt, DM, DM, se); }
        pg8::Gemm g{c.MIX(), wt, NPR, DM, DM}; pg8::StaticOrder S; S.init(NPR, DM, c.G, c.bid);
        EpiResidualNorm E{xin_p, c.X1(), c.SSQ(), c.lds + EPI_STG}; pg8::gemm_phase<EpiResidualNorm, pg8::StaticOrder, true, true>(c.lds, g, S, E, c.tid); }
    else if constexpr (SUB == 7) { const bf16_t* wt = (const bf16_t*)(c.ws + WS_WUP) + (size_t)layer * FF * DM;
        { SkEpiRelu2 se{c.Hb() + (size_t)NPR * FF, c.SSQ() + (size_t)NPR * 16}; skinny_gemm(c, c.X1() + (size_t)NPR * DM, wt, FF, DM, se); }
        pg8::Gemm g{c.X1(), wt, NPR, FF, DM}; pg8::StaticOrder S; S.init(NPR, FF, c.G, c.bid);
        EpiRowScaleBf16<1> E{c.Hb(), FF, c.SSQ(), c.lds + EPI_STG}; pg8::gemm_phase<EpiRowScaleBf16<1>, pg8::StaticOrder, true, true>(c.lds, g, S, E, c.tid); }
    else if constexpr (SUB == 8) { const bf16_t* wt = (const bf16_t*)(c.ws + WS_WDN) + (size_t)layer * DM * FF;
        { SkEpiResidualNorm se{c.X1() + (size_t)NPR * DM, c.X2() + (size_t)NPR * DM, c.SSQ() + (size_t)NPR * 16}; skinny_gemm(c, c.Hb() + (size_t)NPR * FF, wt, DM, FF, se); }
        pg8::Gemm g{c.Hb(), wt, NPR, DM, FF}; pg8::StaticOrder S; S.init(NPR, DM, c.G, c.bid);
        EpiResidualNorm E{c.X1(), c.X2(), c.SSQ(), c.lds + EPI_STG}; pg8::gemm_phase<EpiResidualNorm, pg8::StaticOrder, true, true>(c.lds, g, S, E, c.tid); }
    else if constexpr (SUB == 9) phase_prologue(c);
    else phase_final(c);
}
template <int SUB> __global__ void __launch_bounds__(NTHREADS, 2) k_sub(Params p, int layer) {
    extern __shared__ __attribute__((aligned(16))) unsigned char lds_raw[];
    const Ctx c = make_ctx(p, lds_raw, __builtin_amdgcn_readfirstlane((int)threadIdx.x >> 6));
    run_sub<SUB>(c, p, layer);
}
template <int SUB> static void launch_sub(const Params& p, int layer, int grid, hipStream_t stream) {
    static bool attr_set = false;
    if (!attr_set) { (void)hipFuncSetAttribute((const void*)k_sub<SUB>, hipFuncAttributeMaxDynamicSharedMemorySize, LDS_BYTES); attr_set = true; }
    hipLaunchKernelGGL(k_sub<SUB>, dim3(grid), dim3(NTHREADS), LDS_BYTES, stream, p, layer);
}

#ifndef REP_A
#define REP_A 1
#endif
#ifndef REP_B
#define REP_B 1
#endif
#ifndef REP_C
#define REP_C 1
#endif
#ifndef REP_D
#define REP_D 1
#endif
#ifndef REP_G1
#define REP_G1 1
#endif
#ifndef REP_G2
#define REP_G2 1
#endif
#ifndef REP_G3
#define REP_G3 1
#endif
#ifndef REP_G4
#define REP_G4 1
#endif
#ifndef REP_ML
#define REP_ML 1
#endif
#ifndef REP_MO
#define REP_MO 1
#endif
#ifndef REP_BAR
#define REP_BAR 1
#endif
#define GRID_BAR() do { for (int rb_ = 0; rb_ < REP_BAR; ++rb_) { XcdBarrier b_; b_.bar = (unsigned*)(c.ws + WS_CTL); b_.x = xb_xcc_id(); b_.st = (volatile LAS unsigned*)(c.lds + LDS_BYTES - 64); xcd_barrier(b_, wave0 == 0 && lane_opaque() == 0); c = make_ctx(p, lds_raw, wave0); } } while (0)
__global__ void __launch_bounds__(NTHREADS, 2) mk_fwd(Params p) {
    extern __shared__ __attribute__((aligned(16))) unsigned char lds_raw[];
    const int wave0 = __builtin_amdgcn_readfirstlane((int)threadIdx.x >> 6);
    Ctx c = make_ctx(p, lds_raw, wave0);
    volatile LAS unsigned* st = (volatile LAS unsigned*)(c.lds + LDS_BYTES - 64);
    if (c.tid < 16) st[c.tid] = 0u;
    __syncthreads();
    (void)xcd_barrier_post((unsigned*)(c.ws + WS_CTL), st, c.tid == 0);
    c = make_ctx(p, lds_raw, wave0);
    if (p.ph_lo < 0) cg::this_grid().sync();
    for (int rep = 0; rep < REP_D; ++rep) run_sub<9>(c, p, 0);
    GRID_BAR();
#pragma unroll 1
    for (int layer = 0; layer < NLAYER; ++layer) {
        for (int rep = 0; rep < REP_A * REP_G1; ++rep) run_sub<1>(c, p, layer);
        GRID_BAR();
        for (int rep = 0; rep < REP_ML; ++rep) run_sub<2>(c, p, layer, rep);
        GRID_BAR();
        for (int rep = 0; rep < REP_D; ++rep) run_sub<3>(c, p, layer);
        GRID_BAR();
        for (int rep = 0; rep < REP_MO; ++rep) run_sub<4>(c, p, layer, rep);
        GRID_BAR();
        for (int rep = 0; rep < REP_A * REP_G2; ++rep) run_sub<5>(c, p, layer);
        GRID_BAR();
        for (int rep = 0; rep < REP_A * REP_G3; ++rep) run_sub<7>(c, p, layer);
        GRID_BAR();
        for (int rep = 0; rep < REP_A * REP_G4; ++rep) run_sub<8>(c, p, layer);
        GRID_BAR();
    }
    for (int rep = 0; rep < REP_D; ++rep) run_sub<10>(c, p, 0);
}

extern "C" void kernel_launch(void* const* d_in, const int* in_sizes, int n_in, void* d_out, int out_size, void* d_ws, size_t ws_size, hipStream_t stream) {
    static int grid = 0;
    if (grid == 0) {
        if (n_in != N_IN || (size_t)out_size != O_END || ws_size < WS_END) { fprintf(stderr, "kernel_launch: unexpected shapes: n_in %d out %d (want %zu) ws %zu (want %zu)\n", n_in, out_size, (size_t)O_END, ws_size, (size_t)WS_END); grid = -1; return; }
        int dev = 0, cus = 0, per_cu = 0;
        (void)hipGetDevice(&dev); (void)hipDeviceGetAttribute(&cus, hipDeviceAttributeMultiprocessorCount, dev);
        if (hipFuncSetAttribute((const void*)mk_fwd, hipFuncAttributeMaxDynamicSharedMemorySize, LDS_BYTES) != hipSuccess) { fprintf(stderr, "kernel_launch: hipFuncSetAttribute failed\n"); grid = -1; return; }
        if (hipOccupancyMaxActiveBlocksPerMultiprocessor(&per_cu, (const void*)mk_fwd, NTHREADS, LDS_BYTES) != hipSuccess || per_cu < 1) { fprintf(stderr, "kernel_launch: occupancy query says %d blocks per CU\n", per_cu); (void)hipGetLastError(); grid = -1; return; }
        grid = (cus > 0 ? cus : 256);
    }
    if (grid < 0) return;
    (void)hipMemsetAsync((char*)d_ws + WS_CTL, 0, CTL_ZERO_BYTES, stream);
    Params p{};
    for (int i = 0; i < N_IN; ++i) p.in[i] = (const float*)d_in[i];
    p.out = (float*)d_out; p.ws = (unsigned char*)d_ws;
    void* args[] = {&p};
    const hipError_t e = hipLaunchCooperativeKernel((const void*)mk_fwd, dim3(grid), dim3(NTHREADS), args, LDS_BYTES, stream);
    if (e != hipSuccess) fprintf(stderr, "kernel_launch: cooperative launch failed: %s (grid %d)\n", hipGetErrorString(e), grid);
}
```

```cpp
#include <hip/hip_runtime.h>
#include <hip/hip_cooperative_groups.h>
#include <cstdio>
#include <cstdint>
namespace cg = cooperative_groups;

namespace pg8 {
#define PG8_LAS __attribute__((address_space(3)))
typedef unsigned short bf16_t;
typedef short bf16x8 __attribute__((ext_vector_type(8)));
typedef float f32x4 __attribute__((ext_vector_type(4)));
typedef unsigned u32x4 __attribute__((ext_vector_type(4)));
constexpr int BM = 256, BK = 64, HALF = 128, HTB = HALF * BK * 2  , STAGE_BYTES = 8 * HTB, NXCD = 8, WGM = 8;

__host__ __device__ __forceinline__ int lds_byte(int r, int c) { const int st = (r >> 4) * 2 + (c >> 5), rr = r & 15, cc = c & 31, ob = rr * 64 + cc * 2; return st * 1024 + (ob ^ (((ob >> 9) & 1) << 5)); }
__host__ __device__ __forceinline__ void stage_rc(int b, int& R, int& C) { const int st = b / 1024, sb = b % 1024, swz = sb ^ (((sb >> 9) & 1) << 5); R = (st >> 1) * 16 + swz / 64; C = (st & 1) * 32 + (swz % 64) / 2; }
__host__ __device__ __forceinline__ int perm32(int rho) { const int n = rho >> 4, i = rho & 15; return 8 * (i >> 2) + 4 * n + (i & 3); }

struct Unit { int pm, pn; };
struct Gemm { const bf16_t* A; const bf16_t* Bt; int M, N, K; };

struct StaticOrder {
    int nM, nN, nwg, G, c;
    __host__ __device__ void init(int M, int N, int G_, int c_) { nM = M / BM; nN = N / BM; nwg = nM * nN; G = G_; c = c_; }
    __host__ __device__ bool next(int i, Unit& u) const {
        const long L = (long)i * G + c; if (L >= nwg) return false;
        int wgid = (int)L; { const int q = nwg / NXCD, r = nwg % NXCD, xcd = wgid % NXCD, off = wgid / NXCD; wgid = (xcd < r ? xcd * (q + 1) : r * (q + 1) + (xcd - r) * q) + off; }
        const int nig = WGM * nN, gid = wgid / nig, fm = gid * WGM, gsz = (nM - fm) < WGM ? (nM - fm) : WGM;
        u.pm = fm + ((wgid % nig) % gsz); u.pn = (wgid % nig) / gsz; return true;
    }
    __device__ __forceinline__ void a_ready(const Unit&) const {}
    __device__ __forceinline__ void done(const Unit&) const {}
};

template <class Epi, class Sched, bool ALIGN_EPI = false, bool SP2 = false>
__device__ __forceinline__ void gemm_phase(PG8_LAS unsigned char* lds, const Gemm g, const Sched& S, const Epi& E, int tid_in) {
    int tid_ = tid_in; asm volatile("" : "+v"(tid_));
    const int tid = tid_, wid = __builtin_amdgcn_readfirstlane(tid >> 6), lane = tid & 63, wr = wid >> 2, wc = wid & 3, fr = lane & 15, fq = lane >> 4;
    const int K = g.K, nt = K / BK;
    unsigned voffA[2], voffB[2];
#pragma unroll
    for (int i = 0; i < 2; ++i) { int R, C; stage_rc(tid * 16 + i * 8192, R, C); const int Rb = Epi::WIDE ? ((R >> 5) * 64 + perm32(R & 31)) : (Epi::PERM ? ((R & ~31) + perm32(R & 31)) : R);
        voffA[i] = (unsigned)(R * K + C) * 2u; voffB[i] = (unsigned)(Rb * K + C) * 2u; }
    const size_t kstep = (size_t)(BK * 2);
    const size_t hstep = (size_t)HALF * K * 2;
    const size_t hstepB = Epi::WIDE ? (size_t)32 * K * 2 : hstep;
    const size_t tstep = 2 * hstep;
    const unsigned ldsw = (unsigned)wid * 1024u;
    const int aoff = lds_byte(wr * 64 + fr, fq * 8), boff = lds_byte(wc * 32 + fr, fq * 8);
#define PG8_SA(b, h) (((b) * 2 + (h)) * HTB)
#define PG8_SB(b, h) ((4 + (b) * 2 + (h)) * HTB)
#define PG8_STAGE(bufoff, gbase, voff) do { _Pragma("unroll") for (int _i = 0; _i < 2; ++_i) \
        __builtin_amdgcn_global_load_lds((const unsigned*)((const char*)(gbase) + (voff)[_i]), (PG8_LAS unsigned*)(lds + (bufoff) + ldsw + _i * 8192), 16, 0, 0); } while (0)
#define PG8_LDA(dst, b, h) do { _Pragma("unroll") for (int m = 0; m < 4; ++m) _Pragma("unroll") for (int k = 0; k < 2; ++k) dst[m][k] = *(const PG8_LAS bf16x8*)(lds + PG8_SA(b, h) + aoff + m * 2048 + k * 1024); } while (0)
#define PG8_LDB(dst, b, h) do { _Pragma("unroll") for (int n = 0; n < 2; ++n) _Pragma("unroll") for (int k = 0; k < 2; ++k) dst[n][k] = *(const PG8_LAS bf16x8*)(lds + PG8_SB(b, h) + boff + n * 2048 + k * 1024); } while (0)
#define PG8_MMA(ai, bj, At, Bt) do { __builtin_amdgcn_s_setprio(1); _Pragma("unroll") for (int m = 0; m < 4; ++m) _Pragma("unroll") for (int n = 0; n < 2; ++n) _Pragma("unroll") for (int k = 0; k < 2; ++k) \
        acc[ai][bj][m][n] = __builtin_amdgcn_mfma_f32_16x16x32_bf16(Bt[n][k], At[m][k], acc[ai][bj][m][n], 0, 0, 0); __builtin_amdgcn_s_setprio(0); } while (0)
#define PG8_WAIT_V(n) asm volatile("s_waitcnt vmcnt(" #n ")" ::: "memory")
#define PG8_WAIT_L(n) asm volatile("s_waitcnt lgkmcnt(" #n ")" ::: "memory")
#define PG8_BAR __builtin_amdgcn_s_barrier()
#define PG8_SCHED __builtin_amdgcn_sched_barrier(0)
    Unit cur, nxt; int ui = 0;
    if (!S.next(0, cur)) return;
    f32x4 acc[2][2][4][2];
#pragma unroll
    for (int a = 0; a < 2; ++a)
#pragma unroll
        for (int b = 0; b < 2; ++b)
#pragma unroll
            for (int m = 0; m < 4; ++m)
#pragma unroll
                for (int n = 0; n < 2; ++n) acc[a][b][m][n] = (f32x4){0.f, 0.f, 0.f, 0.f};
    bf16x8 At[4][2], B0[2][2], B1[2][2];
    const char* cA = (const char*)g.A + (size_t)cur.pm * tstep; const char* cB = (const char*)g.Bt + (size_t)cur.pn * tstep;
    S.a_ready(cur);
    if constexpr (SP2) {
        PG8_STAGE(PG8_SB(0, 0), cB, voffB); PG8_STAGE(PG8_SB(0, 1), cB + hstepB, voffB); PG8_STAGE(PG8_SA(0, 0), cA, voffA); PG8_STAGE(PG8_SA(0, 1), cA + hstep, voffA);
        if (wr == 1) PG8_BAR;
        PG8_WAIT_V(2); PG8_BAR;
        PG8_STAGE(PG8_SB(1, 0), cB + kstep, voffB); PG8_STAGE(PG8_SA(1, 0), cA + kstep, voffA); PG8_STAGE(PG8_SB(1, 1), cB + hstepB + kstep, voffB);
        PG8_WAIT_V(6); PG8_BAR;
    } else {
        PG8_STAGE(PG8_SB(0, 0), cB, voffB); PG8_STAGE(PG8_SA(0, 0), cA, voffA); PG8_STAGE(PG8_SB(0, 1), cB + hstepB, voffB); PG8_STAGE(PG8_SA(0, 1), cA + hstep, voffA);
        if (wr == 1) PG8_BAR;
        PG8_WAIT_V(4); PG8_BAR;
        PG8_STAGE(PG8_SB(1, 0), cB + kstep, voffB); PG8_STAGE(PG8_SA(1, 0), cA + kstep, voffA); PG8_STAGE(PG8_SB(1, 1), cB + hstepB + kstep, voffB);
        PG8_WAIT_V(6); PG8_BAR;
    }
    for (;;) {
        const bool has_next = S.next(ui + 1, nxt);
        const char* nA = has_next ? (const char*)g.A + (size_t)nxt.pm * tstep : cA; const char* nB = has_next ? (const char*)g.Bt + (size_t)nxt.pn * tstep : cB;
        for (int t = 0; t < nt; t += 2) {
            const bool last = (t == nt - 2);
            const char* a1 = cA + (size_t)(t + 1) * kstep;
            const char* a2 = last ? nA : cA + (size_t)(t + 2) * kstep; const char* b2 = last ? nB : cB + (size_t)(t + 2) * kstep;
            const char* a3 = a2 + kstep; const char* b3 = b2 + kstep;
            if (last && has_next) S.a_ready(nxt);
            if constexpr (SP2) {
            PG8_LDB(B0, 0, 0); PG8_LDB(B1, 0, 1); PG8_SCHED; PG8_LDA(At, 0, 0); PG8_STAGE(PG8_SA(1, 1), a1 + hstep, voffA);
            PG8_WAIT_V(8); PG8_WAIT_L(0); PG8_BAR; PG8_MMA(0, 0, At, B0); PG8_MMA(0, 1, At, B1); PG8_BAR; PG8_SCHED;
            PG8_LDA(At, 0, 1); PG8_STAGE(PG8_SB(0, 0), b2, voffB); PG8_STAGE(PG8_SB(0, 1), b2 + hstepB, voffB); PG8_STAGE(PG8_SA(0, 0), a2, voffA);
            PG8_WAIT_V(8); PG8_WAIT_L(0); PG8_BAR; PG8_MMA(1, 0, At, B0); PG8_MMA(1, 1, At, B1); PG8_BAR; PG8_SCHED;
            PG8_LDB(B0, 1, 0); PG8_LDB(B1, 1, 1); PG8_SCHED; PG8_LDA(At, 1, 0); PG8_STAGE(PG8_SA(0, 1), a2 + hstep, voffA);
            PG8_WAIT_V(8); PG8_WAIT_L(0); PG8_BAR; PG8_MMA(0, 0, At, B0); PG8_MMA(0, 1, At, B1); PG8_BAR; PG8_SCHED;
            PG8_LDA(At, 1, 1); PG8_STAGE(PG8_SB(1, 0), b3, voffB); PG8_STAGE(PG8_SB(1, 1), b3 + hstepB, voffB); PG8_STAGE(PG8_SA(1, 0), a3, voffA);
            PG8_WAIT_V(8); PG8_WAIT_L(0); PG8_BAR; PG8_MMA(1, 0, At, B0); PG8_MMA(1, 1, At, B1); PG8_BAR; PG8_SCHED;
            } else {
            PG8_LDB(B0, 0, 0); PG8_SCHED; PG8_LDA(At, 0, 0); PG8_STAGE(PG8_SA(1, 1), a1 + hstep, voffA);
            PG8_WAIT_L(8); PG8_BAR; PG8_WAIT_L(0); PG8_MMA(0, 0, At, B0); PG8_BAR; PG8_SCHED;
            PG8_LDB(B1, 0, 1); PG8_STAGE(PG8_SB(0, 0), b2, voffB);
            PG8_BAR; PG8_WAIT_L(0); PG8_MMA(0, 1, At, B1); PG8_BAR;
            PG8_LDA(At, 0, 1); PG8_STAGE(PG8_SA(0, 0), a2, voffA);
            PG8_BAR; PG8_WAIT_L(0); PG8_MMA(1, 0, At, B0); PG8_BAR; PG8_SCHED;
            PG8_STAGE(PG8_SB(0, 1), b2 + hstepB, voffB);
            PG8_WAIT_V(6); PG8_BAR; PG8_MMA(1, 1, At, B1); PG8_BAR;
            PG8_LDB(B0, 1, 0); PG8_SCHED; PG8_LDA(At, 1, 0); PG8_STAGE(PG8_SA(0, 1), a2 + hstep, voffA);
            PG8_WAIT_L(8); PG8_BAR; PG8_WAIT_L(0); PG8_MMA(0, 0, At, B0); PG8_BAR; PG8_SCHED;
            PG8_LDB(B1, 1, 1); PG8_STAGE(PG8_SB(1, 0), b3, voffB);
            PG8_BAR; PG8_WAIT_L(0); PG8_MMA(0, 1, At, B1); PG8_BAR;
            PG8_LDA(At, 1, 1); PG8_STAGE(PG8_SA(1, 0), a3, voffA);
            PG8_BAR; PG8_WAIT_L(0); PG8_MMA(1, 0, At, B0); PG8_BAR; PG8_SCHED;
            PG8_STAGE(PG8_SB(1, 1), b3 + hstepB, voffB);
            PG8_WAIT_V(6); PG8_BAR; PG8_MMA(1, 1, At, B1); PG8_BAR;
            }
        }
        if constexpr (ALIGN_EPI) { if (wr == 0) PG8_BAR; }
        if constexpr (!Epi::AFTER_DRAIN) { E(acc, cur, wr, wc, fr, fq); S.done(cur); }
        if (!has_next) break;
#pragma unroll
        for (int a = 0; a < 2; ++a)
#pragma unroll
            for (int b = 0; b < 2; ++b)
#pragma unroll
                for (int m = 0; m < 4; ++m)
#pragma unroll
                    for (int n = 0; n < 2; ++n) acc[a][b][m][n] = (f32x4){0.f, 0.f, 0.f, 0.f};
        cur = nxt; cA = nA; cB = nB; ++ui;
        if constexpr (ALIGN_EPI) { if (wr == 1) PG8_BAR; }
    }
    PG8_WAIT_V(0);
    if constexpr (!ALIGN_EPI) { if (wr == 0) PG8_BAR; }
    PG8_BAR;
    if constexpr (Epi::AFTER_DRAIN) { E.fused(acc, cur, wr, wc, fr, fq, lds, wid, lane); S.done(cur); }
#undef PG8_SA
#undef PG8_SB
#undef PG8_STAGE
#undef PG8_LDA
#undef PG8_LDB
#undef PG8_MMA
#undef PG8_WAIT_V
#undef PG8_WAIT_L
#undef PG8_BAR
#undef PG8_SCHED
}
}

#define LAS __attribute__((address_space(3)))
#define DEVI __device__ __forceinline__
typedef unsigned short bf16_t;
typedef float f32x4 __attribute__((ext_vector_type(4)));
typedef unsigned u32x4 __attribute__((ext_vector_type(4)));
typedef unsigned u32x2 __attribute__((ext_vector_type(2)));
typedef short bf16x8_t __attribute__((ext_vector_type(8)));

constexpr int DM = 1024, TSEQ = 8192, NPR = 16384  , NSR = 128  , NTOK = NPR + NSR, MPAD = 16640  ;
constexpr int DIN = 3336, NZ = 3584, FF = 4096, NH = 4, DH = 64, NLAYER = 2, WB = 2048, DECB = 32, DECT = 4;
constexpr float EPSN = 1e-6f, NEGV = -1e30f;
constexpr int ZC_AQ = 0, ZC_AK = 256, ZC_AV = 512, ZC_BQ = 768, ZC_BK = 1024, ZC_BV = 1280, ZC_BO = 1536, ZC_CU = 1792, ZC_CV = 2048, ZC_DQ = 2304, ZC_DF = 2560, ZC_DI = 2816, ZC_DG = 3072;
constexpr int SRC_GATE = 1792, ZC_GI = 3328, ZC_GF = 3332;
enum { I_XP = 0, I_XS, I_CK, I_CV, I_MC, I_MN, I_MM, I_HS, I_RB, I_WIN, I_WOUT, I_GATTN, I_GMLP, I_WUP, I_WDN, I_BI, I_BF, I_GML, I_GCV, I_WS, I_BS, I_LB, I_GHG, I_GFIN, N_IN };
constexpr size_t O_YP = 0, O_YS = O_YP + (size_t)NPR * DM, O_KWP = O_YS + (size_t)NSR * DM, O_VWP = O_KWP + (size_t)NLAYER * 2 * WB * 256, O_KWS = O_VWP + (size_t)NLAYER * 2 * WB * 256,
                 O_VWS = O_KWS + (size_t)NLAYER * DECB * WB * 256, O_CP = O_VWS + (size_t)NLAYER * DECB * WB * 256, O_NP = O_CP + (size_t)NLAYER * 2 * NH * 4096, O_MP = O_NP + (size_t)NLAYER * 2 * NH * 64,
                 O_CS = O_MP + (size_t)NLAYER * 2 * NH, O_NS = O_CS + (size_t)NLAYER * DECB * NH * 4096, O_MS = O_NS + (size_t)NLAYER * DECB * NH * 64, O_SP = O_MS + (size_t)NLAYER * DECB * NH,
                 O_SS = O_SP + (size_t)NLAYER * 2 * NH * 4096, O_CVS = O_SS + (size_t)NLAYER * DECB * NH * 4096, O_END = O_CVS + (size_t)NLAYER * DECB * DECT * 256;
constexpr size_t MiB = 1u << 20;
constexpr size_t WS_CTL = 0, CTL_ZERO_BYTES = 64 * 1024;
constexpr size_t WS_WIN = 1 * MiB, WS_WOUT = 15 * MiB, WS_WUP = 19 * MiB, WS_WDN = 35 * MiB;
constexpr size_t WS_XN = 51 * MiB;
constexpr size_t WS_SMALL = 84 * MiB;
constexpr size_t WS_Z = 86 * MiB, WS_MIX = 200 * MiB, WS_H = WS_Z;
constexpr size_t WS_X1 = 233 * MiB, WS_X2 = 298 * MiB;
constexpr size_t WS_MU = 363 * MiB, WS_MCS = 372 * MiB, WS_HU = 381 * MiB, WS_HSS = 390 * MiB, WS_END = 399 * MiB;
static_assert(WS_Z + (size_t)MPAD * NZ * 2 <= WS_MIX && WS_MIX + (size_t)MPAD * DM * 2 <= WS_X1 && WS_H + (size_t)MPAD * FF * 2 <= WS_X1, "ws map");
static_assert(WS_WIN + 2 * (size_t)NZ * DM * 2 <= WS_WOUT && WS_XN + (size_t)MPAD * DM * 2 <= WS_SMALL, "ws map 2");
constexpr int CONV_ITEMS_WIN = 16 * ((3328 + 32) / 32);
constexpr int CONV_ITEMS_PER_LAYER = 16 * ((3328 + 32) / 32) + 16 * 32 + 16 * (4096 / 32) + 64 * 32;
constexpr size_t SM_SSQ = 0, SM_BT = 1280 * 1024;
constexpr int NCHUNK = 64, NITEM_REC = 2 * NH * NCHUNK;
constexpr size_t REC_N_OFF = (size_t)NITEM_REC * 4096 * 4, REC_M_OFF = REC_N_OFF + (size_t)NITEM_REC * 64 * 4, REC_B_OFF = REC_M_OFF + (size_t)NITEM_REC * 4;
static_assert(REC_B_OFF + NITEM_REC * 4 <= 9 * MiB, "rec scratch");

constexpr int LDS_BYTES = 148480, NTHREADS = 512, EPI_STG = 131072;
#ifndef REP_ATT
#define REP_ATT 1
#endif
#ifndef REP_GMLP
#define REP_GMLP 1
#endif
#ifndef REP_STATE
#define REP_STATE 1
#endif
#ifndef REP_OUT
#define REP_OUT 1
#endif
#ifndef REP_COPY
#define REP_COPY 1
#endif
#ifndef REP_SATT
#define REP_SATT 1
#endif
#ifndef REP_SREC
#define REP_SREC 1
#endif


struct Params { const float* in[N_IN]; float* out; unsigned char* ws; int ph_lo, ph_hi; };

DEVI float bf2f(unsigned v) { return __uint_as_float(v << 16); }
DEVI unsigned pk2(float lo, float hi) { unsigned r; asm("v_cvt_pk_bf16_f32 %0, %1, %2" : "=v"(r) : "v"(lo), "v"(hi)); return r; }
DEVI unsigned f2bf(float f) { return pk2(f, 0.f) & 0xffffu; }
DEVI float bflo(unsigned u) { return __uint_as_float(u << 16); }
DEVI float bfhi(unsigned u) { return __uint_as_float(u & 0xffff0000u); }
DEVI void unpack8(const u32x4 u, float* f) { f[0] = bflo(u.x); f[1] = bfhi(u.x); f[2] = bflo(u.y); f[3] = bfhi(u.y); f[4] = bflo(u.z); f[5] = bfhi(u.z); f[6] = bflo(u.w); f[7] = bfhi(u.w); }
DEVI int lane_opaque() { unsigned z = 0u; asm volatile("" : "+s"(z)); return (int)__builtin_amdgcn_mbcnt_hi(~0u, __builtin_amdgcn_mbcnt_lo(~0u, z)); }
DEVI float shfl_xor_f(float v, int m) {
    const unsigned b = __builtin_bit_cast(unsigned, v);
    if (m == 32) { const auto r = __builtin_amdgcn_permlane32_swap(b, b, false, false); return __builtin_bit_cast(float, (lane_opaque() & 32) ? r[0] : r[1]); }
    if (m == 16) { const auto r = __builtin_amdgcn_permlane16_swap(b, b, false, false); return __builtin_bit_cast(float, (lane_opaque() & 16) ? r[0] : r[1]); }
    return __builtin_bit_cast(float, __builtin_amdgcn_ds_bpermute((lane_opaque() ^ m) << 2, __builtin_bit_cast(int, v)));
}
DEVI float shfl_up_f(float v, int o) { const int l = lane_opaque(); const int s = l - o; return __builtin_bit_cast(float, __builtin_amdgcn_ds_bpermute((s < 0 ? l : s) << 2, __builtin_bit_cast(int, v))); }
typedef short v4i16_t __attribute__((ext_vector_type(4)));
template <int PITCH = 144> DEVI bf16x8_t lds_tfrag(const LAS unsigned char* stage, int ks, int col, int gq) {
    const int i = col & 15, q = i >> 2, p = i & 3;
    const LAS unsigned char* a0 = stage + (32 * ks + 4 * gq + q) * PITCH + ((col - i) + 4 * p) * 2;
    const v4i16_t lo = __builtin_amdgcn_ds_read_tr16_b64_v4i16((LAS v4i16_t*)a0), hi = __builtin_amdgcn_ds_read_tr16_b64_v4i16((LAS v4i16_t*)(a0 + 16 * PITCH));
    return (bf16x8_t){lo[0], lo[1], lo[2], lo[3], hi[0], hi[1], hi[2], hi[3]};
}
DEVI float wave_sum(float v) {
#pragma unroll
    for (int o = 1; o < 64; o <<= 1) v += shfl_xor_f(v, o);
    return v;
}
DEVI float wave_max(float v) {
#pragma unroll
    for (int o = 1; o < 64; o <<= 1) v = fmaxf(v, shfl_xor_f(v, o));
    return v;
}
DEVI float sum8(float v) {
    v += __builtin_bit_cast(float, __builtin_amdgcn_update_dpp(0, __builtin_bit_cast(int, v), 0xB1, 0xF, 0xF, true));
    v += __builtin_bit_cast(float, __builtin_amdgcn_update_dpp(0, __builtin_bit_cast(int, v), 0x4E, 0xF, 0xF, true));
    v += __builtin_bit_cast(float, __builtin_amdgcn_update_dpp(0, __builtin_bit_cast(int, v), 0x141, 0xF, 0xF, true));
    return v;
}
DEVI float sum16(float v) {
    v = sum8(v);
    v += __builtin_bit_cast(float, __builtin_amdgcn_update_dpp(0, __builtin_bit_cast(int, v), 0x140, 0xF, 0xF, true));
    return v;
}
DEVI float frcp(float x) { return __builtin_amdgcn_rcpf(x); }
DEVI float sigmoidf_(float x) { return frcp(1.0f + __expf(-x)); }
DEVI float log1pexp_neg(float a) { return __logf(1.0f + __expf(-a)); }
DEVI float log_sigmoid(float x) { return fminf(x, 0.f) - log1pexp_neg(fabsf(x)); }
DEVI float gelu_tanh(float x) { const float u = 0.7978845608028654f * (x + 0.044715f * x * x * x); return x * frcp(1.0f + __expf(-2.0f * u)); }

#define GAS __attribute__((address_space(1)))
struct InPtrs { GAS const float* const __attribute__((address_space(4)))* p; DEVI const float* operator[](int i) const { return (const float*)p[i]; } };
struct ParamsDev { GAS const float* in[N_IN]; GAS float* out; GAS unsigned char* ws; int ph_lo, ph_hi; };
struct Ctx {
    InPtrs in; float* out; unsigned char* ws;
    LAS unsigned char* lds; int tid, lane, wave, G, bid;
    DEVI bf16_t* Z() const { return (bf16_t*)(ws + WS_Z); }
    DEVI bf16_t* MIX() const { return (bf16_t*)(ws + WS_MIX); }
    DEVI bf16_t* Hb() const { return (bf16_t*)(ws + WS_H); }
    DEVI bf16_t* X1() const { return (bf16_t*)(ws + WS_X1); }
    DEVI bf16_t* X2() const { return (bf16_t*)(ws + WS_X2); }
    DEVI float* SSQ() const { return (float*)(ws + WS_SMALL + SM_SSQ); }
    DEVI float* BT() const { return (float*)(ws + WS_SMALL + SM_BT); }
};

DEVI Ctx relaunder(const Ctx& c0) {
    Ctx c = c0; int t = c0.wave * 64 + lane_opaque(); asm volatile("" : "+v"(t)); c.tid = t; c.lane = t & 63; c.wave = c0.wave;
    auto inp = c0.in.p; asm volatile("" : "+s"(inp)); c.in.p = inp; GAS unsigned char* w = (GAS unsigned char*)c0.ws; asm volatile("" : "+s"(w)); c.ws = (unsigned char*)w; GAS float* o = (GAS float*)c0.out; asm volatile("" : "+s"(o)); c.out = (float*)o; return c;
}
constexpr int CW_QUEUE = 4096;
struct WorkQueue {
    unsigned* ctr; int nxt;
    DEVI void prefetch(const Ctx& c) { int t = 0; if (c.wave == 0 && lane_opaque() == 0) t = (int)__hip_atomic_fetch_add(ctr, 1u, __ATOMIC_RELAXED, __HIP_MEMORY_SCOPE_AGENT); nxt = t; }
    DEVI void start(const Ctx& c, unsigned* counter) { ctr = counter; nxt = 0; prefetch(c); }
    DEVI int pop(const Ctx& c) {
        LAS int* slot = (LAS int*)(c.lds + LDS_BYTES - 32);
        __syncthreads();
        if (c.wave == 0 && lane_opaque() == 0) *slot = nxt;
        __syncthreads();
        return *slot;
    }
};

DEVI float row_rs(const float* ssq, int row) {
    const f32x4* p = (const f32x4*)(ssq + (size_t)row * 16); const f32x4 a = p[0], b = p[1], c2 = p[2], d = p[3];
    const float s = ((a[0] + a[1]) + (a[2] + a[3])) + ((b[0] + b[1]) + (b[2] + b[3])) + ((c2[0] + c2[1]) + (c2[2] + c2[3])) + ((d[0] + d[1]) + (d[2] + d[3]));
    return rsqrtf(s * (1.0f / DM) + EPSN);
}
template <int ACT  > struct EpiRowScaleBf16 {
    static constexpr bool PERM = true, WIDE = true, AFTER_DRAIN = false;
    bf16_t* O; int ldc; const float* ssq; LAS unsigned char* stg;
    __device__ __forceinline__ void operator()(const pg8::f32x4 (&acc)[2][2][4][2], const pg8::Unit& u, int wr, int wc, int fr, int fq) const {
        const int row0 = u.pm * 256 + wr * 64 + fr;
        const int lane = fr + 16 * fq, rr = lane >> 3, sg = lane & 7;
        LAS unsigned char* my = stg + (wr * 4 + wc) * 2048;
        float rsv[2];
#pragma unroll
        for (int j = 0; j < 2; ++j) { const int row = row0 + (fq >> 1) * 128 + (2 * (fq & 1) + j) * 16; rsv[j] = row_rs(ssq, row < NTOK ? row : NTOK - 1); }
        bf16_t* obase = O + (size_t)(u.pm * 256 + wr * 64 + rr) * ldc + u.pn * 256 + wc * 64 + sg * 8;
#pragma unroll
        for (int ai = 0; ai < 2; ++ai)
#pragma unroll
            for (int m = 0; m < 4; ++m) {
                const float s = __builtin_bit_cast(float, __builtin_amdgcn_ds_bpermute((fr + 16 * (2 * ai + (m >> 1))) << 2, __builtin_bit_cast(int, rsv[m & 1])));
#pragma unroll
                for (int bj = 0; bj < 2; ++bj) {
                    pg8::f32x4 v0 = acc[ai][bj][m][0] * s, v1 = acc[ai][bj][m][1] * s;
                    if (ACT == 1) {
#pragma unroll
                        for (int e = 0; e < 4; ++e) { const float a = fmaxf(v0[e], 0.f), b = fmaxf(v1[e], 0.f); v0[e] = a * a; v1[e] = b * b; }
                    }
                    u32x4 w; w.x = pk2(v0[0], v0[1]); w.y = pk2(v0[2], v0[3]); w.z = pk2(v1[0], v1[1]); w.w = pk2(v1[2], v1[3]);
                    *(LAS u32x4*)(my + fr * 128 + (((bj * 4 + fq) ^ (fr & 7)) * 16)) = w;
                }
#pragma unroll
                for (int k = 0; k < 2; ++k) { const int r = rr + 8 * k; const u32x4 w = *(const LAS u32x4*)(my + r * 128 + ((sg ^ (r & 7)) * 16));
                    *(u32x4*)(obase + (size_t)(ai * 128 + m * 16 + 8 * k) * ldc) = w; }
            }
    }
};
struct EpiResidualNorm {
    static constexpr bool PERM = false, WIDE = false, AFTER_DRAIN = false;
    const bf16_t* base; bf16_t* out; float* ssq; LAS unsigned char* stg;
    __device__ __forceinline__ void operator()(const pg8::f32x4 (&acc)[2][2][4][2], const pg8::Unit& u, int wr, int wc, int fr, int fq) const {
        const int lane = fr + 16 * fq, rr = lane >> 3, sg = lane & 7;
        LAS unsigned char* my = stg + (wr * 4 + wc) * 2048;
        const int rbase = u.pm * 256 + wr * 64, cb = u.pn * 256 + wc * 32 + 4 * sg;
        u32x2 pre[4][2][2];
#define RN_LOAD(G) do { _Pragma("unroll") for (int k = 0; k < 2; ++k) _Pragma("unroll") for (int bj = 0; bj < 2; ++bj) \
            pre[(G) & 3][k][bj] = *(const u32x2*)(base + (size_t)(rbase + ((G) >> 2) * 128 + ((G) & 3) * 16 + rr + 8 * k) * DM + cb + bj * 128); } while (0)
        RN_LOAD(0); RN_LOAD(1); RN_LOAD(2); RN_LOAD(3);
        __builtin_amdgcn_sched_barrier(0);
#pragma unroll
        for (int G = 0; G < 8; ++G) {
            const int ai = G >> 2, m = G & 3; float ss[2] = {0.f, 0.f};
#pragma unroll
            for (int bj = 0; bj < 2; ++bj) {
#pragma unroll
                for (int n = 0; n < 2; ++n) *(LAS pg8::f32x4*)(my + fr * 128 + (((n * 4 + fq) ^ (fr & 7)) * 16)) = acc[ai][bj][m][n];
#pragma unroll
                for (int k = 0; k < 2; ++k) { const int r = rr + 8 * k; const pg8::f32x4 v = *(const LAS pg8::f32x4*)(my + r * 128 + ((sg ^ (r & 7)) * 16));
                    const u32x2 pb = pre[G & 3][k][bj]; const pg8::f32x4 x = (pg8::f32x4){bflo(pb.x), bfhi(pb.x), bflo(pb.y), bfhi(pb.y)} + v; const size_t o = (size_t)(rbase + ai * 128 + m * 16 + r) * DM + cb + bj * 128;
                    { u32x2 xb; xb.x = pk2(x[0], x[1]); xb.y = pk2(x[2], x[3]); *(u32x2*)(out + o) = xb; } ss[k] += (x[0] * x[0] + x[1] * x[1]) + (x[2] * x[2] + x[3] * x[3]); }
            }
            if (G + 4 < 8) RN_LOAD(G + 4);
#pragma unroll
            for (int k = 0; k < 2; ++k) { const float s = sum8(ss[k]); if (sg == 0) ssq[(size_t)(rbase + ai * 128 + m * 16 + rr + 8 * k) * 16 + u.pn * 4 + wc] = s; }
        }
#undef RN_LOAD
    }
};

template <class E> DEVI void skinny_gemm(const Ctx& c, const bf16_t* A, const bf16_t* Bt, int N, int K, const E& epi) {
    const int lane = c.lane, fr = lane & 15, gq = lane >> 4, ngrp = N >> 6, total = ngrp * 8, kw = K >> 3;
    LAS float* red = (LAS float*)c.lds;
    bf16x8_t a0[4], b0[4][4], a1[4], b1[4][4];
    const bf16_t* ap = A; const bf16_t* bp = Bt;
#define SK_PTRS(T) { const int ng_ = (T) % ngrp, mg_ = (T) / ngrp; ap = A + (size_t)(mg_ * 16 + fr) * K + c.wave * kw + 8 * gq; bp = Bt + (size_t)(ng_ * 64 + fr) * K + c.wave * kw + 8 * gq; }
#define SK_LOAD(AF, BF, KC) { _Pragma("unroll") for (int s4 = 0; s4 < 4; ++s4) { AF[s4] = *(const bf16x8_t*)(ap + (KC) + 32 * s4); _Pragma("unroll") for (int e = 0; e < 4; ++e) BF[s4][e] = *(const bf16x8_t*)(bp + (size_t)(16 * e) * K + (KC) + 32 * s4); } }
#define SK_MMA(AF, BF) { _Pragma("unroll") for (int s4 = 0; s4 < 4; ++s4) { _Pragma("unroll") for (int e = 0; e < 4; ++e) acc[e] = __builtin_amdgcn_mfma_f32_16x16x32_bf16(BF[s4][e], AF[s4], acc[e], 0, 0, 0); } }
    if (c.bid < total) { SK_PTRS(c.bid); SK_LOAD(a0, b0, 0); }
    for (int task = c.bid; task < total; task += c.G) {
        const int ng = task % ngrp, mg = task / ngrp;
        f32x4 acc[4];
#pragma unroll
        for (int e = 0; e < 4; ++e) acc[e] = (f32x4){0.f, 0.f, 0.f, 0.f};
#pragma unroll 1
        for (int kc = 0; kc < kw; kc += 256) {
            const bool h1 = kc + 128 < kw;
            if (h1) SK_LOAD(a1, b1, kc + 128);
            __builtin_amdgcn_sched_barrier(0);
            SK_MMA(a0, b0);
            __builtin_amdgcn_sched_barrier(0);
            if (h1) {
                if (kc + 256 < kw) SK_LOAD(a0, b0, kc + 256);
                __builtin_amdgcn_sched_barrier(0);
                SK_MMA(a1, b1);
                __builtin_amdgcn_sched_barrier(0);
            }
        }
        if (task + c.G < total) { SK_PTRS(task + c.G); SK_LOAD(a0, b0, 0); }
        __builtin_amdgcn_sched_barrier(0);
        __syncthreads();
#pragma unroll
        for (int e = 0; e < 4; ++e) *(LAS f32x4*)(red + ((c.wave * 4 + e) * 64 + lane) * 4) = acc[e];
        __syncthreads();
        { const int row = c.tid >> 5, cp = c.tid & 31, col = 2 * cp, e = col >> 4, g2 = (col >> 2) & 3, r = col & 3; float s0 = 0.f, s1 = 0.f;
#pragma unroll
          for (int w = 0; w < 8; ++w) { const LAS float* p = red + ((w * 4 + e) * 64 + (g2 * 16 + row)) * 4 + r; s0 += p[0]; s1 += p[1]; }
          float ss = epi.pair(mg * 16 + row, ng * 64 + col, s0, s1);
          ss += shfl_xor_f(ss, 1); ss += shfl_xor_f(ss, 2); ss += shfl_xor_f(ss, 4); ss += shfl_xor_f(ss, 8); ss += shfl_xor_f(ss, 16);
          if (cp == 0) epi.rowsum(mg * 16 + row, ng, ss); }
    }
#undef SK_PTRS
#undef SK_LOAD
#undef SK_MMA
    __syncthreads();
}
struct SkEpiResidualNorm {
    const bf16_t* base; bf16_t* out; float* ssq;
    DEVI float pair(int row, int col, float v0, float v1) const { const size_t o = (size_t)row * DM + col; const unsigned bb = *(const unsigned*)(base + o); const float x0 = bflo(bb) + v0, x1 = bfhi(bb) + v1; *(unsigned*)(out + o) = pk2(x0, x1); return x0 * x0 + x1 * x1; }
    DEVI void rowsum(int row, int slot, float s) const { ssq[(size_t)row * 16 + slot] = s; }
};
struct SkEpiRelu2 { bf16_t* H; const float* ssq;
    DEVI float pair(int row, int col, float v0, float v1) const { const float rs = row_rs(ssq, row); const float a = fmaxf(v0 * rs, 0.f), b = fmaxf(v1 * rs, 0.f); *(unsigned*)(H + (size_t)row * FF + col) = pk2(a * a, b * b); return 0.f; }
    DEVI void rowsum(int, int, float) const {}
};

DEVI void transpose_item(const float* W, int ldw, int src_col0, int K, bf16_t* WT, int dst_row0, LAS float* scr, int k0, int lane, const float* gk) {
    float wv[32];
#pragma unroll
    for (int i = 0; i < 32; ++i) wv[i] = __builtin_nontemporal_load(W + (size_t)(k0 + 2 * i + (lane >> 5)) * ldw + src_col0 + (lane & 31));
#pragma unroll
    for (int i = 0; i < 32; ++i) scr[(2 * i + (lane >> 5)) * 33 + (lane & 31)] = gk ? wv[i] * gk[k0 + 2 * i + (lane >> 5)] : wv[i];
    asm volatile("s_waitcnt lgkmcnt(0)" ::: "memory");
    const int c = lane & 7;
#pragma unroll
    for (int j = 0; j < 4; ++j) { const int n = (lane >> 3) + 8 * j; const LAS float* s = scr + (8 * c) * 33 + n;
        u32x4 o; o.x = pk2(s[0 * 33], s[1 * 33]); o.y = pk2(s[2 * 33], s[3 * 33]); o.z = pk2(s[4 * 33], s[5 * 33]); o.w = pk2(s[6 * 33], s[7 * 33]);
        *(u32x4*)(WT + (size_t)(dst_row0 + n) * K + k0 + 8 * c) = o; }
    asm volatile("s_waitcnt lgkmcnt(0)" ::: "memory");
}
DEVI int rel_bucket(int dist) {
    if (dist < 16) return dist;
    int large = 16 + (int)(log((double)dist / 16.0) / log(128.0) * 16.0);
    large = large < 16 ? 16 : (large > 31 ? 31 : large);
    return large;
}
DEVI void convert_weights(const Ctx& c, int it0, int it1, int wi, int nw) {
    LAS float* scr = (LAS float*)(c.lds + c.wave * 16384);
    constexpr int NZS = 3328 + 32;
    constexpr int I_IN = 16 * (NZS / 32), I_OUT = 16 * 32, I_UP = 16 * (FF / 32), I_DN = 64 * 32, I_L = I_IN + I_OUT + I_UP + I_DN;
    static_assert(I_L == CONV_ITEMS_PER_LAYER, "conversion item count");
    for (int it = it0 + wi; it < it1; it += nw) {
        const int l = it / I_L; int r = it % I_L;
        if (r < I_IN) { const int kb = r / (NZS / 32), nb = r % (NZS / 32), n0 = nb * 32;
            transpose_item(c.in[I_WIN] + (size_t)l * DM * DIN, DIN, n0 == 3328 ? SRC_GATE : n0 + (n0 >= SRC_GATE ? 8 : 0), DM, (bf16_t*)(c.ws + WS_WIN) + (size_t)l * NZ * DM, n0, scr, kb * 64, c.lane, c.in[I_GATTN] + l * DM); continue; }
        r -= I_IN;
        if (r < I_OUT) { const int kb = r / 32, nb = r % 32; transpose_item(c.in[I_WOUT] + (size_t)l * DM * DM, DM, nb * 32, DM, (bf16_t*)(c.ws + WS_WOUT) + (size_t)l * DM * DM, nb * 32, scr, kb * 64, c.lane, nullptr); continue; }
        r -= I_OUT;
        if (r < I_UP) { const int kb = r / (FF / 32), nb = r % (FF / 32); transpose_item(c.in[I_WUP] + (size_t)l * DM * FF, FF, nb * 32, DM, (bf16_t*)(c.ws + WS_WUP) + (size_t)l * FF * DM, nb * 32, scr, kb * 64, c.lane, c.in[I_GMLP] + l * DM); continue; }
        r -= I_UP;
        { const int kb = r / 32, nb = r % 32; transpose_item(c.in[I_WDN] + (size_t)l * FF * DM, DM, nb * 32, FF, (bf16_t*)(c.ws + WS_WDN) + (size_t)l * DM * FF, nb * 32, scr, kb * 64, c.lane, nullptr); }
    }
}
DEVI void phase_prologue(const Ctx& c) {
    const int gw = c.bid * 8 + c.wave, NGW = c.G * 8;
    convert_weights(c, 0, CONV_ITEMS_WIN, gw, NGW);
    for (int idx = c.bid * NTHREADS + c.tid; idx < NLAYER * 224 * (DM / 8); idx += c.G * NTHREADS) { const int l = idx / (224 * (DM / 8)), r = idx % (224 * (DM / 8));
        *(u32x4*)((bf16_t*)(c.ws + WS_WIN) + (size_t)l * NZ * DM + (size_t)3360 * DM + (size_t)r * 8) = (u32x4){0u, 0u, 0u, 0u}; }
    for (int row0 = gw; row0 < NTOK; row0 += 3 * NGW) {
        f32x4 v[3][4];
#pragma unroll
        for (int r = 0; r < 3; ++r) { const int row = row0 + r * NGW < NTOK ? row0 + r * NGW : row0;
            const float* xr = (row < NPR) ? c.in[I_XP] + (size_t)row * DM : c.in[I_XS] + (size_t)(row - NPR) * DM;
#pragma unroll
            for (int j = 0; j < 4; ++j) v[r][j] = __builtin_nontemporal_load((const f32x4*)(xr + 256 * j + 4 * c.lane)); }
        __builtin_amdgcn_sched_barrier(0);
#pragma unroll
        for (int r = 0; r < 3; ++r) { const int row = row0 + r * NGW; if (row < NTOK) {
            float ss = 0.f; u32x2* xb = (u32x2*)(c.X2() + (size_t)row * DM);
#pragma unroll
            for (int j = 0; j < 4; ++j) { ss += (v[r][j][0] * v[r][j][0] + v[r][j][1] * v[r][j][1]) + (v[r][j][2] * v[r][j][2] + v[r][j][3] * v[r][j][3]);
                u32x2 w2; w2.x = pk2(v[r][j][0], v[r][j][1]); w2.y = pk2(v[r][j][2], v[r][j][3]); xb[64 * j + c.lane] = w2; }
            ss = wave_sum(ss);
            if (c.lane < 16) c.SSQ()[(size_t)row * 16 + c.lane] = c.lane == 0 ? ss : 0.f; } }
    }
    {
        for (int i = c.bid * NTHREADS + c.tid; i < 3 * 129 * 4; i += c.G * NTHREADS) { const int h = i & 3, j = (i >> 2) % 129, pat = (i >> 2) / 129; const int d = pat == 0 ? 1 : (pat == 1 ? 4 : 16);
            c.BT()[i] = c.in[I_RB][rel_bucket(j * d) * 4 + h]; }
    }
}

DEVI void attn_sample_qh(const Ctx& c, int layer, int b, int h, int t) {
    const bf16_t* Z = c.Z(); const int lane = c.lane, kg = lane >> 4, c4 = lane & 15;
    const size_t rbase = (size_t)(NPR + b * DECT);
    const size_t qrow = rbase + t;
    LAS float* pl = (LAS float*)(c.lds + c.wave * 1024);
    const u32x2 qu = *(const u32x2*)(Z + qrow * NZ + ZC_AQ + h * 64 + 4 * c4);
    const f32x4 q4 = (f32x4){bflo(qu.x), bfhi(qu.x), bflo(qu.y), bfhi(qu.y)};
    const float* bt = c.BT() + h;
    const float* ck = c.in[I_CK] + ((size_t)(layer * DECB + b) * WB) * 256 + h * 64;
    const float* cv = c.in[I_CV] + ((size_t)(layer * DECB + b) * WB) * 256 + h * 64;
    float Mx = NEGV, wsum = 0.f; f32x4 accv = (f32x4){0.f, 0.f, 0.f, 0.f};
#pragma unroll 1
    for (int pat = 0; pat < 3; ++pat) {
        const int d = 1 << (2 * pat);
        const float* btp = bt + pat * 129 * 4;
        const int pos0 = t - kg * d; const bool isz = pos0 >= 0; const int zp = isz ? pos0 : 0, cp = isz ? -1 : pos0;
        const unsigned loff = (unsigned)((3 - kg) * d * 256 + 4 * c4), loff0 = (unsigned)((WB + cp) * 256 + 4 * c4), loff32 = (unsigned)(4 * c4);
        float lg[33]; f32x4 kv[33];
        const u32x2 uk = *(const u32x2*)(Z + (rbase + zp) * NZ + ZC_AK + h * 64 + 4 * c4);
        kv[0] = *(const f32x4*)(ck + loff0);
#pragma unroll
        for (int it = 1; it < 32; ++it) kv[it] = *(const f32x4*)(ck + (size_t)(WB + t - (4 * it + 3) * d) * 256 + loff);
        kv[32] = *(const f32x4*)(ck + (size_t)(WB + t - 128 * d) * 256 + loff32);
        { const float b0 = btp[lane * 4], b1 = btp[(64 + lane) * 4], b2 = btp[128 * 4]; pl[lane] = b0; pl[64 + lane] = b1; pl[128 + lane] = b2; }
        __builtin_amdgcn_sched_barrier(0);
        kv[0] = (f32x4){isz ? bflo(uk.x) : kv[0][0], isz ? bfhi(uk.x) : kv[0][1], isz ? bflo(uk.y) : kv[0][2], isz ? bfhi(uk.y) : kv[0][3]};
#pragma unroll
        for (int it = 0; it < 33; ++it) {
            const float dot = sum16((q4[0] * kv[it][0] + q4[1] * kv[it][1]) + (q4[2] * kv[it][2] + q4[3] * kv[it][3]));
            lg[it] = (it < 32 || kg == 0) ? dot * 0.125f + pl[4 * it + kg] : NEGV;
        }
        __builtin_amdgcn_sched_barrier(0);
        const u32x2 uv = *(const u32x2*)(Z + (rbase + zp) * NZ + ZC_AV + h * 64 + 4 * c4);
        kv[0] = *(const f32x4*)(cv + loff0);
#pragma unroll
        for (int it = 1; it < 32; ++it) kv[it] = *(const f32x4*)(cv + (size_t)(WB + t - (4 * it + 3) * d) * 256 + loff);
        kv[32] = *(const f32x4*)(cv + (size_t)(WB + t - 128 * d) * 256 + loff32);
        __builtin_amdgcn_sched_barrier(0);
        float m = lg[0];
#pragma unroll
        for (int it = 1; it < 33; ++it) m = fmaxf(m, lg[it]);
        m = fmaxf(m, shfl_xor_f(m, 16)); m = fmaxf(m, shfl_xor_f(m, 32));
        float den = 0.f;
#pragma unroll
        for (int it = 0; it < 33; ++it) { lg[it] = __expf(lg[it] - m); den += lg[it]; }
        den += shfl_xor_f(den, 16); den += shfl_xor_f(den, 32);
        __builtin_amdgcn_sched_barrier(0);
        f32x4 o4 = (f32x4){isz ? bflo(uv.x) : kv[0][0], isz ? bfhi(uv.x) : kv[0][1], isz ? bflo(uv.y) : kv[0][2], isz ? bfhi(uv.y) : kv[0][3]} * lg[0];
#pragma unroll
        for (int it = 1; it < 33; ++it) o4 += kv[it] * lg[it];
#pragma unroll
        for (int e = 0; e < 4; ++e) { o4[e] += shfl_xor_f(o4[e], 16); o4[e] += shfl_xor_f(o4[e], 32); }
        const float lse = m + __logf(den), Mn = fmaxf(Mx, lse), sc = __expf(Mx - Mn), wp = __expf(lse - Mn);
        accv = accv * sc + o4 * (wp / den); wsum = wsum * sc + wp; Mx = Mn;
    }
    if (kg == 0) { const f32x4 r = accv * (1.0f / wsum); u32x2 w; w.x = pk2(r[0], r[1]); w.y = pk2(r[2], r[3]); *(u32x2*)(c.MIX() + qrow * DM + h * 64 + 4 * c4) = w; }
}

constexpr int AT_LBW = 192;
constexpr int AT_OA = 0, AT_LM = 65536, AT_LW = AT_LM + 1024, AT_LB = AT_LW + 1024, AT_VS = AT_LB + 3 * AT_LBW * 4, AT_VS_WAVE = 32 * 144;
static_assert(AT_VS % 16 == 0 && AT_VS + 8 * AT_VS_WAVE <= LDS_BYTES - 64, "attention LDS map");
DEVI void attn_block_item(const Ctx& c, int layer, int b, int h, int blk, WorkQueue& q) {
    const int lane = c.lane, i = lane & 15, gq = lane >> 4;
    LAS float* OA = (LAS float*)(c.lds + AT_OA); LAS float* LM = (LAS float*)(c.lds + AT_LM); LAS float* LW = (LAS float*)(c.lds + AT_LW); LAS float* LB = (LAS float*)(c.lds + AT_LB);
    LAS unsigned char* VS = c.lds + AT_VS + c.wave * AT_VS_WAVE;
    __syncthreads();
    for (int idx = c.tid; idx < 3 * AT_LBW; idx += NTHREADS) { const int pat = idx / AT_LBW, x = idx % AT_LBW - 16, j = 128 - x; LB[idx] = (j >= 0 && j <= 128) ? 1.4426950408889634f * c.BT()[(pat * 129 + j) * 4 + h] : 0.f; }
    __syncthreads();
    const int base = blk * 256;
    const char* zb = (const char*)(c.Z() + (size_t)b * TSEQ * NZ + h * 64);
#define AT_T0(PAT, TK) (base + ((PAT) == 0 ? 16 * (TK) : ((PAT) == 1 ? 64 * ((TK) >> 2) + ((TK) & 3) : (TK))))
    bf16x8_t qf[2], kfr[9][2];
#define AT_KQLOAD(PAT, TK) do { const int d_ = 1 << (2 * (PAT)), t0_ = AT_T0(PAT, TK); const unsigned lk_ = (unsigned)((d_ * i * NZ + 8 * gq) * 2); \
        { const char* qb = zb + ((size_t)(unsigned)t0_ * NZ + ZC_AQ) * 2; qf[0] = *(const bf16x8_t*)(qb + lk_); qf[1] = *(const bf16x8_t*)(qb + lk_ + 64); } \
        _Pragma("unroll") for (int kt = 0; kt < 9; ++kt) { int u_ = t0_ + d_ * (16 * kt - 128); u_ = u_ < 0 ? 0 : u_;     \
            const char* kb = zb + ((size_t)(unsigned)u_ * NZ + ZC_AK) * 2; kfr[kt][0] = *(const bf16x8_t*)(kb + lk_); kfr[kt][1] = *(const bf16x8_t*)(kb + lk_ + 64); } } while (0)
    AT_KQLOAD(0, c.wave);
#pragma unroll 1
    for (int ti = 0; ti < 6; ++ti) {
        {
            const int pat = ti >> 1, tk = c.wave + 8 * (ti & 1), d = 1 << (2 * pat);
            const int t0 = AT_T0(pat, tk);
            const int tq = t0 + d * i;
            const int kmin = 128 - (t0 >> (2 * pat));
            const int vrow0 = lane >> 3;
            u32x4 vr[5][4];
            const unsigned lv = (unsigned)((d * vrow0 * NZ + 8 * (lane & 7)) * 2);
#define AT_VLOAD(S5) do { _Pragma("unroll") for (int n = 0; n < ((S5) == 4 ? 2 : 4); ++n) { int uv = t0 + d * (32 * (S5) + 8 * n - 128); uv = uv < 0 ? 0 : uv;     \
                vr[(S5)][n] = *(const u32x4*)(zb + ((size_t)(unsigned)uv * NZ + ZC_AV) * 2 + lv); } } while (0)
            AT_VLOAD(0); AT_VLOAD(1); AT_VLOAD(2); AT_VLOAD(3); AT_VLOAD(4);
            __builtin_amdgcn_sched_barrier(0);
            f32x4 s[10];
#pragma unroll
            for (int kt = 0; kt < 9; ++kt) {
                f32x4 a = (f32x4){0.f, 0.f, 0.f, 0.f};
                a = __builtin_amdgcn_mfma_f32_16x16x32_bf16(kfr[kt][0], qf[0], a, 0, 0, 0);
                a = __builtin_amdgcn_mfma_f32_16x16x32_bf16(kfr[kt][1], qf[1], a, 0, 0, 0);
                s[kt] = a;
            }
            s[9] = (f32x4){0.f, 0.f, 0.f, 0.f};
            const LAS float* lb = LB + pat * AT_LBW + 16 + 4 * gq - i;
            float mx = NEGV;
#pragma unroll
            for (int half = 0; half < 2; ++half) {
                float bz[5][4];
#pragma unroll
                for (int k5 = 0; k5 < 5; ++k5) { const int kt = 5 * half + k5; if (kt < 9) {
#pragma unroll
                    for (int r = 0; r < 4; ++r) bz[k5][r] = lb[16 * kt + r]; } }
                __builtin_amdgcn_sched_barrier(0);
#pragma unroll
                for (int k5 = 0; k5 < 5; ++k5) { const int kt = 5 * half + k5; if (kt < 9) {
#pragma unroll
                    for (int r = 0; r < 4; ++r) {
                        const bool valid = kt == 0 ? (kmin <= 0 && 4 * gq + r >= i) : (kt == 8 ? (4 * gq + r <= i) : (16 * kt >= kmin));
                        const float lg = valid ? s[kt][r] * (0.125f * 1.4426950408889634f) + bz[k5][r] : NEGV;
                        s[kt][r] = lg; mx = fmaxf(mx, lg);
                    } } }
                __builtin_amdgcn_sched_barrier(0);
            }
            mx = fmaxf(mx, shfl_xor_f(mx, 16)); mx = fmaxf(mx, shfl_xor_f(mx, 32));
            float den = 0.f;
#pragma unroll
            for (int kt = 0; kt < 9; ++kt)
#pragma unroll
                for (int r = 0; r < 4; ++r) { const float pv = __builtin_amdgcn_exp2f(s[kt][r] - mx); s[kt][r] = pv; den += pv; }
            den += shfl_xor_f(den, 16); den += shfl_xor_f(den, 32);
            u32x4 pf[5];
#pragma unroll
            for (int s5 = 0; s5 < 5; ++s5) { pf[s5].x = pk2(s[2 * s5][0], s[2 * s5][1]); pf[s5].y = pk2(s[2 * s5][2], s[2 * s5][3]); pf[s5].z = pk2(s[2 * s5 + 1][0], s[2 * s5 + 1][1]); pf[s5].w = pk2(s[2 * s5 + 1][2], s[2 * s5 + 1][3]); }
            f32x4 o[4];
#pragma unroll
            for (int dt = 0; dt < 4; ++dt) o[dt] = (f32x4){0.f, 0.f, 0.f, 0.f};
#pragma unroll
            for (int s5 = 0; s5 < 5; ++s5) {
                __builtin_amdgcn_sched_barrier(0);
                if (s5 == 2 && ti == 5) q.prefetch(c);
                if (s5 == 2 && ti + 1 < 6) { const int np_ = (ti + 1) >> 1, ntk_ = c.wave + 8 * ((ti + 1) & 1); AT_KQLOAD(np_, ntk_); }
#pragma unroll
                for (int n = 0; n < 4; ++n) *(LAS u32x4*)(VS + (vrow0 + 8 * n) * 144 + (lane & 7) * 16) = (s5 == 4 && n >= 2) ? vr[4][n - 2] : vr[s5][n];
#pragma unroll
                for (int dt = 0; dt < 4; ++dt) {
                    union { u32x4 u; bf16x8_t v; } pp; pp.u = pf[s5];
                    o[dt] = __builtin_amdgcn_mfma_f32_16x16x32_bf16(lds_tfrag<144>(VS, 0, 16 * dt + i, gq), pp.v, o[dt], 0, 0, 0);
                }
            }
#undef AT_VLOAD
            const float inv = frcp(den), lse = mx + __builtin_amdgcn_logf(den); const int tok = tq - base;
            if (pat == 0) {
#pragma unroll
                for (int dt = 0; dt < 4; ++dt) *(LAS f32x4*)(OA + tok * 64 + 16 * dt + 4 * gq) = o[dt] * inv;
                if (gq == 0) { LM[tok] = lse; LW[tok] = 1.0f; }
            } else {
                const float Mo = LM[tok], Wo = LW[tok]; const float Mn = fmaxf(Mo, lse), sc = __builtin_amdgcn_exp2f(Mo - Mn), wl = __builtin_amdgcn_exp2f(lse - Mn), wp = wl * inv; const float wn = Wo * sc + wl;
                if (pat == 1) {
#pragma unroll
                    for (int dt = 0; dt < 4; ++dt) o[dt] = (*(const LAS f32x4*)(OA + tok * 64 + 16 * dt + 4 * gq)) * sc + o[dt] * wp;
#pragma unroll
                    for (int dt = 0; dt < 4; ++dt) *(LAS f32x4*)(OA + tok * 64 + 16 * dt + 4 * gq) = o[dt];
                    asm volatile("s_waitcnt lgkmcnt(0)" ::: "memory");
                    if (gq == 0) { LM[tok] = Mn; LW[tok] = wn; }
                } else {
                    const float rw = frcp(wn);
#pragma unroll
                    for (int dt = 0; dt < 4; ++dt) o[dt] = ((*(const LAS f32x4*)(OA + tok * 64 + 16 * dt + 4 * gq)) * sc + o[dt] * wp) * rw;
#pragma unroll
                    for (int dt = 0; dt < 4; ++dt) { const f32x4 r = o[dt];
                        u32x2 w; w.x = pk2(r[0], r[1]); w.y = pk2(r[2], r[3]); *(u32x2*)(c.MIX() + ((size_t)b * TSEQ + tq) * DM + h * 64 + 16 * dt + 4 * gq) = w; }
                }
            }
        }
        if (ti & 1) __syncthreads();
    }
#undef AT_KQLOAD
#undef AT_T0
}

DEVI void gmlp_item(const Ctx& c, int layer, size_t row0, int nrows, float* chunk_v_out) {
    LAS float* vr = (LAS float*)c.lds;
    const bf16_t* Z = c.Z(); const int lane = c.lane;
    const float* gcv = c.in[I_GCV] + layer * 256;
    __syncthreads();
    for (int r = c.wave; r < nrows; r += 8) {
        const u32x2 u = *(const u32x2*)(Z + (row0 + r) * NZ + ZC_CV + 4 * lane);
        float e0 = gelu_tanh(bflo(u.x)), e1 = gelu_tanh(bfhi(u.x)), e2 = gelu_tanh(bflo(u.y)), e3 = gelu_tanh(bfhi(u.y));
        const float ss = wave_sum((e0 * e0 + e1 * e1) + (e2 * e2 + e3 * e3));
        const float rs = rsqrtf(ss * (1.0f / 256.0f) + EPSN);
        const f32x4 gv = *(const f32x4*)(gcv + 4 * lane);
        f32x4 o; o[0] = e0 * rs * gv[0]; o[1] = e1 * rs * gv[1]; o[2] = e2 * rs * gv[2]; o[3] = e3 * rs * gv[3];
        *(LAS f32x4*)(vr + r * 260 + 4 * lane) = o;
        if (chunk_v_out) *(f32x4*)(chunk_v_out + (size_t)r * 256 + 4 * lane) = o;
    }
    __syncthreads();
    const int t = c.tid >> 2, hh = c.tid & 3;
    const float* wrow = c.in[I_WS] + ((size_t)(layer * NH + hh) * 128 + t) * 128;
    int smax = c.wave * 16 + 15; if (smax > nrows - 1) smax = nrows - 1;
    const float bsv = (t < nrows) ? c.in[I_BS][(layer * NH + hh) * 128 + t] : 0.f;
#pragma unroll 1
    for (int half = 0; half < 2; ++half) {
        float acc[32];
#pragma unroll
        for (int i = 0; i < 32; ++i) acc[i] = 0.f;
#pragma unroll 1
        for (int s = 0; s <= smax; ++s) {
            const float w = (s <= t && t < nrows) ? wrow[s] : 0.f;
            const LAS f32x4* vp = (const LAS f32x4*)(vr + s * 260 + hh * 64 + half * 32);
#pragma unroll
            for (int i = 0; i < 8; ++i) { const f32x4 v = vp[i]; acc[4 * i] += w * v[0]; acc[4 * i + 1] += w * v[1]; acc[4 * i + 2] += w * v[2]; acc[4 * i + 3] += w * v[3]; }
        }
        if (t < nrows) {
            const u32x4* up = (const u32x4*)(Z + (row0 + t) * NZ + ZC_CU + hh * 64 + half * 32);
            u32x4* mp = (u32x4*)(c.MIX() + (row0 + t) * DM + 512 + hh * 64 + half * 32);
#pragma unroll
            for (int i = 0; i < 4; ++i) { float uf[8]; unpack8(up[i], uf); float o[8];
#pragma unroll
                for (int e = 0; e < 8; ++e) o[e] = gelu_tanh(uf[e]) * (acc[8 * i + e] + bsv);
                u32x4 w; w.x = pk2(o[0], o[1]); w.y = pk2(o[2], o[3]); w.z = pk2(o[4], o[5]); w.w = pk2(o[6], o[7]); mp[i] = w; }
        }
    }
    __syncthreads();
}

constexpr int L_A0 = 0, L_A1 = 4096, L_A2 = 8192, L_A3 = 12288, L_HB = 16384, L_SC = 20480;
struct RecIO {
    const float* st_in;
    const float* n_in; const float* m_in;
    float* st_out; float* n_out; float* m_out; float* b_out;
    bool native_in, native_out;
};
template <bool OUT> DEVI void mlstm_item(const Ctx& c, int layer, int hh, size_t row0, int nt, const RecIO& io, float m_init) {
    LAS float* L = (LAS float*)c.lds; const bf16_t* Z = c.Z(); const int tid = c.tid, v = tid >> 3, g = tid & 7;
    float C[8], n[8], m;
    if (io.st_in) { const f32x4 a = *(const f32x4*)(io.st_in + tid * 8), b = *(const f32x4*)(io.st_in + tid * 8 + 4); C[0] = a[0]; C[1] = a[1]; C[2] = a[2]; C[3] = a[3]; C[4] = b[0]; C[5] = b[1]; C[6] = b[2]; C[7] = b[3];
        const f32x4 na = *(const f32x4*)(io.n_in + g * 8), nb = *(const f32x4*)(io.n_in + g * 8 + 4); n[0] = na[0]; n[1] = na[1]; n[2] = na[2]; n[3] = na[3]; n[4] = nb[0]; n[5] = nb[1]; n[6] = nb[2]; n[7] = nb[3]; m = io.m_in[0]; }
    else {
#pragma unroll
        for (int j = 0; j < 8; ++j) { C[j] = 0.f; n[j] = 0.f; } m = m_init; }
    float bsum = 0.f;
    const float gbi = c.in[I_BI][layer * 4 + hh], gbf = c.in[I_BF][layer * 4 + hh];
    for (int seg = 0; seg < nt; seg += 64) {
        const int ns = (nt - seg) < 64 ? (nt - seg) : 64;
        __syncthreads();
        { const int tt = tid >> 3;
          if (tt < ns) { const size_t zr = (row0 + seg + tt) * NZ + hh * 64 + g * 8; float f[8];
            if (OUT) { unpack8(*(const u32x4*)(Z + zr + ZC_BQ), f); *(LAS f32x4*)(L + L_A0 + tt * 64 + g * 8) = (f32x4){f[0], f[1], f[2], f[3]}; *(LAS f32x4*)(L + L_A0 + tt * 64 + g * 8 + 4) = (f32x4){f[4], f[5], f[6], f[7]}; }
            unpack8(*(const u32x4*)(Z + zr + ZC_BK), f); *(LAS f32x4*)(L + L_A1 + tt * 64 + g * 8) = (f32x4){f[0], f[1], f[2], f[3]} * 0.125f; *(LAS f32x4*)(L + L_A1 + tt * 64 + g * 8 + 4) = (f32x4){f[4], f[5], f[6], f[7]} * 0.125f;
            unpack8(*(const u32x4*)(Z + zr + ZC_BV), f); *(LAS f32x4*)(L + L_A2 + tt * 64 + g * 8) = (f32x4){f[0], f[1], f[2], f[3]}; *(LAS f32x4*)(L + L_A2 + tt * 64 + g * 8 + 4) = (f32x4){f[4], f[5], f[6], f[7]}; }
          if (tid < ns) { L[L_SC + tid] = bf2f(Z[(row0 + seg + tid) * NZ + ZC_GI + hh]) + gbi; L[L_SC + 64 + tid] = log_sigmoid(bf2f(Z[(row0 + seg + tid) * NZ + ZC_GF + hh]) + gbf); } }
        __syncthreads();
#pragma unroll 2
        for (int tt = 0; tt < ns; ++tt) {
            const float ii = L[L_SC + tt], lf = L[L_SC + 64 + tt];
            const float mn = fmaxf(lf + m, ii);
            const float a = __expf(lf + m - mn), bb = __expf(ii - mn);
            bsum += lf; m = mn;
            const float bv = bb * L[L_A2 + tt * 64 + v];
            const f32x4 k0 = *(const LAS f32x4*)(L + L_A1 + tt * 64 + g * 8), k1 = *(const LAS f32x4*)(L + L_A1 + tt * 64 + g * 8 + 4);
            const float kk[8] = {k0[0], k0[1], k0[2], k0[3], k1[0], k1[1], k1[2], k1[3]};
#pragma unroll
            for (int j = 0; j < 8; ++j) { C[j] = a * C[j] + bv * kk[j]; n[j] = a * n[j] + bb * kk[j]; }
            if (OUT) {
                const f32x4 q0 = *(const LAS f32x4*)(L + L_A0 + tt * 64 + g * 8), q1 = *(const LAS f32x4*)(L + L_A0 + tt * 64 + g * 8 + 4);
                const float qq[8] = {q0[0], q0[1], q0[2], q0[3], q1[0], q1[1], q1[2], q1[3]};
                float num = 0.f, nq = 0.f;
#pragma unroll
                for (int j = 0; j < 8; ++j) { num += C[j] * qq[j]; nq += n[j] * qq[j]; }
                num = sum8(num); nq = sum8(nq);
                const float den = fmaxf(fabsf(nq), __expf(-mn));
                if (g == 0) L[L_HB + tt * 64 + v] = num / den;
            }
        }
        if (OUT) {
            __syncthreads();
            const int tt = tid >> 3;
            if (tt < ns) {
                const f32x4 h0 = *(const LAS f32x4*)(L + L_HB + tt * 64 + g * 8), h1 = *(const LAS f32x4*)(L + L_HB + tt * 64 + g * 8 + 4);
                float hv[8] = {h0[0], h0[1], h0[2], h0[3], h1[0], h1[1], h1[2], h1[3]}; float ss = 0.f;
#pragma unroll
                for (int j = 0; j < 8; ++j) ss += hv[j] * hv[j];
                ss = sum8(ss);
                const float rs = rsqrtf(ss * (1.0f / 64.0f) + EPSN);
                const float* gm = c.in[I_GML] + layer * 256 + hh * 64 + g * 8; float bo[8];
                unpack8(*(const u32x4*)(Z + (row0 + seg + tt) * NZ + ZC_BO + hh * 64 + g * 8), bo); float o[8];
#pragma unroll
                for (int j = 0; j < 8; ++j) o[j] = sigmoidf_(bo[j]) * (hv[j] * rs * gm[j]);
                u32x4 w; w.x = pk2(o[0], o[1]); w.y = pk2(o[2], o[3]); w.z = pk2(o[4], o[5]); w.w = pk2(o[6], o[7]);
                *(u32x4*)(c.MIX() + (row0 + seg + tt) * DM + 256 + hh * 64 + g * 8) = w;
            }
        }
    }
    if (io.st_out) { *(f32x4*)(io.st_out + tid * 8) = (f32x4){C[0], C[1], C[2], C[3]}; *(f32x4*)(io.st_out + tid * 8 + 4) = (f32x4){C[4], C[5], C[6], C[7]};
        if (v == 0) { *(f32x4*)(io.n_out + g * 8) = (f32x4){n[0], n[1], n[2], n[3]}; *(f32x4*)(io.n_out + g * 8 + 4) = (f32x4){n[4], n[5], n[6], n[7]}; }
        if (tid == 0) { io.m_out[0] = m; if (io.b_out) io.b_out[0] = bsum; } }
    __syncthreads();
}
DEVI float hgrn_lb(const Ctx& c, int layer, int col) {
    if (layer == 0) return 0.f;
    const float a = c.in[I_LB][col], b = c.in[I_LB][256 + col]; const float mx = fmaxf(a, b); const float ea = __expf(a - mx), eb = __expf(b - mx);
    return eb * frcp(ea + eb);
}
DEVI void hgrn_lb8(const Ctx& c, int layer, int col0, float* out) {
    if (layer == 0) {
#pragma unroll
        for (int j = 0; j < 8; ++j) out[j] = 0.f;
        return; }
    const float* lb = c.in[I_LB];
    const f32x4 a0 = *(const f32x4*)(lb + col0), a1 = *(const f32x4*)(lb + col0 + 4), b0 = *(const f32x4*)(lb + 256 + col0), b1 = *(const f32x4*)(lb + 256 + col0 + 4);
#pragma unroll
    for (int j = 0; j < 8; ++j) { const float a = j < 4 ? a0[j & 3] : a1[j & 3], b = j < 4 ? b0[j & 3] : b1[j & 3]; const float mx = fmaxf(a, b); const float ea = __expf(a - mx), eb = __expf(b - mx); out[j] = eb * frcp(ea + eb); }
}
template <bool OUT> DEVI void hgrn_item(const Ctx& c, int layer, int hh, size_t row0, int nt, const RecIO& io) {
    LAS float* L = (LAS float*)c.lds; const bf16_t* Z = c.Z(); const int tid = c.tid, v = tid >> 3, g = tid & 7;
    float S[8], fs[8];
#pragma unroll
    for (int j = 0; j < 8; ++j) { fs[j] = 0.f;
        S[j] = io.st_in ? (io.native_in ? io.st_in[tid * 8 + j] : io.st_in[(g * 8 + j) * 64 + v]) : 0.f; }
    float lbv[8], llb[8], l1m[8];
    {
        hgrn_lb8(c, layer, hh * 64 + g * 8, lbv);
#pragma unroll
        for (int j = 0; j < 8; ++j) { llb[j] = __logf(fmaxf(lbv[j], 1e-30f)); l1m[j] = __logf(1.0f - lbv[j]); }
    }
    for (int seg = 0; seg < nt; seg += 64) {
        const int ns = (nt - seg) < 64 ? (nt - seg) : 64;
        __syncthreads();
        { const int tt = tid >> 3;
          if (tt < ns) { const size_t zr = (row0 + seg + tt) * NZ + hh * 64 + g * 8; float f[8];
            if (OUT) { unpack8(*(const u32x4*)(Z + zr + ZC_DQ), f); *(LAS f32x4*)(L + L_A0 + tt * 64 + g * 8) = (f32x4){f[0], f[1], f[2], f[3]}; *(LAS f32x4*)(L + L_A0 + tt * 64 + g * 8 + 4) = (f32x4){f[4], f[5], f[6], f[7]}; }
            unpack8(*(const u32x4*)(Z + zr + ZC_DF), f); float ff[8], kd[8];
#pragma unroll
            for (int j = 0; j < 8; ++j) { const float x1 = llb[j], x2 = l1m[j] + log_sigmoid(f[j]); const float mx = fmaxf(x1, x2); const float lfd = mx + log1pexp_neg(fabsf(x1 - x2));
                ff[j] = lfd; kd[j] = (1.0f - lbv[j]) * sigmoidf_(-f[j]); }
            *(LAS f32x4*)(L + L_A1 + tt * 64 + g * 8) = (f32x4){ff[0], ff[1], ff[2], ff[3]}; *(LAS f32x4*)(L + L_A1 + tt * 64 + g * 8 + 4) = (f32x4){ff[4], ff[5], ff[6], ff[7]};
            *(LAS f32x4*)(L + L_A2 + tt * 64 + g * 8) = (f32x4){kd[0], kd[1], kd[2], kd[3]}; *(LAS f32x4*)(L + L_A2 + tt * 64 + g * 8 + 4) = (f32x4){kd[4], kd[5], kd[6], kd[7]};
            unpack8(*(const u32x4*)(Z + zr + ZC_DI), f); *(LAS f32x4*)(L + L_A3 + tt * 64 + g * 8) = (f32x4){f[0], f[1], f[2], f[3]}; *(LAS f32x4*)(L + L_A3 + tt * 64 + g * 8 + 4) = (f32x4){f[4], f[5], f[6], f[7]}; } }
        __syncthreads();
#pragma unroll 2
        for (int tt = 0; tt < ns; ++tt) {
            const float vv = L[L_A3 + tt * 64 + v];
            const f32x4 f0 = *(const LAS f32x4*)(L + L_A1 + tt * 64 + g * 8), f1 = *(const LAS f32x4*)(L + L_A1 + tt * 64 + g * 8 + 4);
            const f32x4 k0 = *(const LAS f32x4*)(L + L_A2 + tt * 64 + g * 8), k1 = *(const LAS f32x4*)(L + L_A2 + tt * 64 + g * 8 + 4);
            const float lf[8] = {f0[0], f0[1], f0[2], f0[3], f1[0], f1[1], f1[2], f1[3]}; const float kk[8] = {k0[0], k0[1], k0[2], k0[3], k1[0], k1[1], k1[2], k1[3]};
#pragma unroll
            for (int j = 0; j < 8; ++j) { fs[j] += lf[j]; S[j] = __expf(lf[j]) * S[j] + kk[j] * vv; }
            if (OUT) {
                const f32x4 q0 = *(const LAS f32x4*)(L + L_A0 + tt * 64 + g * 8), q1 = *(const LAS f32x4*)(L + L_A0 + tt * 64 + g * 8 + 4);
                const float qq[8] = {q0[0], q0[1], q0[2], q0[3], q1[0], q1[1], q1[2], q1[3]};
                float o = 0.f;
#pragma unroll
                for (int j = 0; j < 8; ++j) o += qq[j] * S[j];
                o = sum8(o);
                if (g == 0) L[L_HB + tt * 64 + v] = o;
            }
        }
        if (OUT) {
            __syncthreads();
            const int tt = tid >> 3;
            if (tt < ns) {
                const f32x4 h0 = *(const LAS f32x4*)(L + L_HB + tt * 64 + g * 8), h1 = *(const LAS f32x4*)(L + L_HB + tt * 64 + g * 8 + 4);
                float hv[8] = {h0[0], h0[1], h0[2], h0[3], h1[0], h1[1], h1[2], h1[3]}; float ss = 0.f;
#pragma unroll
                for (int j = 0; j < 8; ++j) ss += hv[j] * hv[j];
                ss = sum8(ss);
                const float rs = rsqrtf(ss * (1.0f / 64.0f) + EPSN);
                const float* gm = c.in[I_GHG] + layer * 256 + hh * 64 + g * 8; float dg[8];
                unpack8(*(const u32x4*)(Z + (row0 + seg + tt) * NZ + ZC_DG + hh * 64 + g * 8), dg); float o[8];
#pragma unroll
                for (int j = 0; j < 8; ++j) o[j] = (hv[j] * rs * gm[j]) * (dg[j] * sigmoidf_(dg[j]));
                u32x4 w; w.x = pk2(o[0], o[1]); w.y = pk2(o[2], o[3]); w.z = pk2(o[4], o[5]); w.w = pk2(o[6], o[7]);
                *(u32x4*)(c.MIX() + (row0 + seg + tt) * DM + 768 + hh * 64 + g * 8) = w;
            }
        }
    }
    if (io.st_out) {
#pragma unroll
        for (int j = 0; j < 8; ++j) { if (io.native_out) io.st_out[tid * 8 + j] = S[j]; else io.st_out[(g * 8 + j) * 64 + v] = S[j]; }
        if (io.b_out && v == 0) {
#pragma unroll
            for (int j = 0; j < 8; ++j) io.b_out[g * 8 + j] = __expf(fs[j]); } }
    __syncthreads();
}

constexpr int RSTG = 128 * 144;
DEVI bf16x8_t pack8(const float* f) { union { u32x4 u; bf16x8_t v; } r; r.u.x = pk2(f[0], f[1]); r.u.y = pk2(f[2], f[3]); r.u.z = pk2(f[4], f[5]); r.u.w = pk2(f[6], f[7]); return r.v; }
DEVI bf16x8_t pack8v(const f32x4 a, const f32x4 b) { union { u32x4 u; bf16x8_t v; } r; r.u.x = pk2(a[0], a[1]); r.u.y = pk2(a[2], a[3]); r.u.z = pk2(b[0], b[1]); r.u.w = pk2(b[2], b[3]); return r.v; }
struct StageRegs { u32x4 v[2]; };
DEVI StageRegs stage_load(const bf16_t* src  , int tid) {
    StageRegs r; const int tt = tid >> 2, ch = tid & 3;
#pragma unroll
    for (int e = 0; e < 2; ++e) r.v[e] = *(const u32x4*)(src + (size_t)tt * NZ + 8 * (2 * ch + e));
    return r;
}
DEVI void stage_store(LAS unsigned char* stage, const StageRegs& r, int tid) {
    const int tt = tid >> 2, ch = tid & 3;
#pragma unroll
    for (int e = 0; e < 2; ++e) *(LAS u32x4*)(stage + tt * 144 + (2 * ch + e) * 16) = r.v[e];
}
struct GateRegs { unsigned short gi0, gi1, gf0, gf1; float bi, bfv; };
DEVI GateRegs gate_load(const Ctx& c, int layer, size_t row0, int hh) {
    GateRegs g; const bf16_t* Z = c.Z(); const size_t r0 = (row0 + 2 * c.lane) * NZ, r1 = r0 + NZ;
    g.gi0 = Z[r0 + ZC_GI + hh]; g.gi1 = Z[r1 + ZC_GI + hh]; g.gf0 = Z[r0 + ZC_GF + hh]; g.gf1 = Z[r1 + ZC_GF + hh]; g.bi = c.in[I_BI][layer * 4 + hh]; g.bfv = c.in[I_BF][layer * 4 + hh]; return g;
}
DEVI void mlstm_scalars(const Ctx& c, LAS float* F, const GateRegs& gr, float mprev) {
    if (c.wave == 0) {
        const int lane = c.lane;
        const float i0 = bf2f(gr.gi0) + gr.bi, i1 = bf2f(gr.gi1) + gr.bi, l0 = log_sigmoid(bf2f(gr.gf0) + gr.bfv), l1 = log_sigmoid(bf2f(gr.gf1) + gr.bfv);
        float inc = l0 + l1;
#pragma unroll
        for (int o = 1; o < 64; o <<= 1) { const float y = shfl_up_f(inc, o); if (lane >= o) inc += y; }
        const float b0 = inc - l1, b1 = inc, u0 = i0 - b0, u1 = i1 - b1;
        float mxs = fmaxf(u0, u1);
#pragma unroll
        for (int o = 1; o < 64; o <<= 1) { const float y = shfl_up_f(mxs, o); if (lane >= o) mxs = fmaxf(mxs, y); }
        float ex = shfl_up_f(mxs, 1); if (lane == 0) ex = NEGV;
        const float c0 = fmaxf(ex, u0), c1 = fmaxf(c0, u1);
        F[2 * lane] = b0; F[2 * lane + 1] = b1; F[128 + 2 * lane] = u0; F[128 + 2 * lane + 1] = u1; F[256 + 2 * lane] = fmaxf(b0 + mprev, b0 + c0); F[256 + 2 * lane + 1] = fmaxf(b1 + mprev, b1 + c1);
        if (lane == 63) { F[704] = b1; F[705] = mxs; }
    }
    __syncthreads();
}
constexpr int ML_V = 0, ML_K = RSTG, ML_F = 2 * RSTG, ML_P = ML_F + 4096;
DEVI void mlstm_chunk_state(const Ctx& c, int layer, int hh, size_t row0, float* Uout, float* nout, float* mout, float* bout) {
    LAS unsigned char* VS = c.lds + ML_V; LAS unsigned char* KS = c.lds + ML_K; LAS float* F = (LAS float*)(c.lds + ML_F); LAS float* NP_ = (LAS float*)(c.lds + ML_P);
    const bf16_t* Z = c.Z(); const int tid = c.tid, lane = c.lane, i = lane & 15, gq = lane >> 4;
    const StageRegs vreg = stage_load(Z + row0 * NZ + ZC_BV + hh * 64, tid), kreg = stage_load(Z + row0 * NZ + ZC_BK + hh * 64, tid);
    GateRegs gr{}; if (c.wave == 0) gr = gate_load(c, layer, row0, hh);
    __syncthreads();
    stage_store(VS, vreg, tid);
    mlstm_scalars(c, F, gr, 0.f);
    const float bL = F[704], umax = F[705];
    { const int tt = tid >> 2, ch = tid & 3; const float wsc = 0.125f * __expf(F[128 + tt] - umax);
#pragma unroll
      for (int e = 0; e < 2; ++e) { float f[8]; unpack8(kreg.v[e], f);
#pragma unroll
          for (int j = 0; j < 8; ++j) f[j] *= wsc;
          union { u32x4 u; bf16x8_t v; } pk; pk.v = pack8(f); *(LAS u32x4*)(KS + tt * 144 + (2 * ch + e) * 16) = pk.u; } }
    __syncthreads();
    { const int mt = c.wave >> 1, nt0 = 2 * (c.wave & 1);
      f32x4 acc0 = (f32x4){0.f, 0.f, 0.f, 0.f}, acc1 = acc0;
#pragma unroll
      for (int ks = 0; ks < 4; ++ks) { const bf16x8_t vf = lds_tfrag(VS, ks, 16 * mt + i, gq), k0 = lds_tfrag(KS, ks, 16 * nt0 + i, gq), k1 = lds_tfrag(KS, ks, 16 * (nt0 + 1) + i, gq);
          acc0 = __builtin_amdgcn_mfma_f32_16x16x32_bf16(vf, k0, acc0, 0, 0, 0); acc1 = __builtin_amdgcn_mfma_f32_16x16x32_bf16(vf, k1, acc1, 0, 0, 0); }
#pragma unroll
      for (int r = 0; r < 4; ++r) { Uout[(16 * mt + 4 * gq + r) * 64 + 16 * nt0 + i] = acc0[r]; Uout[(16 * mt + 4 * gq + r) * 64 + 16 * (nt0 + 1) + i] = acc1[r]; } }
    { const int k = tid & 63, part = tid >> 6; float sum = 0.f;
#pragma unroll
      for (int s = 0; s < 16; ++s) sum += bf2f(*(const LAS unsigned short*)(KS + (16 * part + s) * 144 + k * 2));
      NP_[part * 64 + k] = sum; }
    __syncthreads();
    if (tid < 64) { float sum = 0.f;
#pragma unroll
        for (int p8 = 0; p8 < 8; ++p8) sum += NP_[p8 * 64 + tid];
        nout[tid] = sum; }
    if (tid == 0) { mout[0] = bL + umax; bout[0] = bL; }
}
DEVI void mlstm_chunk_out(const Ctx& c, int layer, int hh, size_t row0, const float* Cp, const float* np, const float* mp_) {
    LAS unsigned char* VS = c.lds + ML_V; LAS float* F = (LAS float*)(c.lds + ML_F);
    const bf16_t* Z = c.Z(); const int tid = c.tid, lane = c.lane, i = lane & 15, gq = lane >> 4, w = c.wave;
    const int t = 16 * w + i;
    const StageRegs vreg = stage_load(Z + row0 * NZ + ZC_BV + hh * 64, tid);
    GateRegs gr{}; if (w == 0) gr = gate_load(c, layer, row0, hh);
    const float npv = (tid >= 128 && tid < 192) ? np[tid - 128] : 0.f;
    const float mprev = mp_[0];
    bf16x8_t qf[2], kfr[8][2];
    { const bf16_t* qp = Z + (row0 + t) * NZ + ZC_BQ + hh * 64 + 8 * gq; qf[0] = *(const bf16x8_t*)qp; qf[1] = *(const bf16x8_t*)(qp + 32); }
#pragma unroll
    for (int kt = 0; kt < 8; ++kt) if (kt <= w) { const bf16_t* kp = Z + (row0 + 16 * kt + i) * NZ + ZC_BK + hh * 64 + 8 * gq; kfr[kt][0] = *(const bf16x8_t*)kp; kfr[kt][1] = *(const bf16x8_t*)(kp + 32); }
    __syncthreads();
    stage_store(VS, vreg, tid);
    if (tid >= 128 && tid < 192) F[640 + tid - 128] = npv;
    mlstm_scalars(c, F, gr, mprev);
    u32x2 bog[4]; f32x4 gmv[4];
#pragma unroll
    for (int dt = 0; dt < 4; ++dt) { const int col = hh * 64 + 16 * dt + 4 * gq; gmv[dt] = *(const f32x4*)(c.in[I_GML] + layer * 256 + col); bog[dt] = *(const u32x2*)(Z + (row0 + t) * NZ + ZC_BO + col); }
    const float bt = F[t], mt_ = F[256 + t], wt = bt - mt_, gI = __expf(bt + mprev - mt_);
    f32x4 s[8]; float nqi = 0.f;
#pragma unroll
    for (int kt = 0; kt < 8; ++kt) {
        s[kt] = (f32x4){0.f, 0.f, 0.f, 0.f};
        if (kt <= w) {
            f32x4 a = (f32x4){0.f, 0.f, 0.f, 0.f};
            a = __builtin_amdgcn_mfma_f32_16x16x32_bf16(kfr[kt][0], qf[0], a, 0, 0, 0);
            a = __builtin_amdgcn_mfma_f32_16x16x32_bf16(kfr[kt][1], qf[1], a, 0, 0, 0);
            const f32x4 uu = *(const LAS f32x4*)(F + 128 + 16 * kt + 4 * gq);
#pragma unroll
            for (int r = 0; r < 4; ++r) { const bool valid = (16 * kt + 4 * gq + r) <= t; const float val = a[r] * 0.125f * __expf(valid ? uu[r] + wt : NEGV); a[r] = val; nqi += val; }
            s[kt] = a;
        }
    }
    nqi += shfl_xor_f(nqi, 16); nqi += shfl_xor_f(nqi, 32);
    f32x4 cpr[4][2][2];
#pragma unroll
    for (int dt = 0; dt < 4; ++dt)
#pragma unroll
        for (int ks = 0; ks < 2; ++ks) { const float* cp = Cp + (16 * dt + i) * 64 + 32 * ks + 8 * gq; cpr[dt][ks][0] = *(const f32x4*)cp; cpr[dt][ks][1] = *(const f32x4*)(cp + 4); }
    f32x4 o[4], oi[4];
#pragma unroll
    for (int dt = 0; dt < 4; ++dt) { o[dt] = (f32x4){0.f, 0.f, 0.f, 0.f}; oi[dt] = o[dt]; }
#pragma unroll
    for (int ks = 0; ks < 4; ++ks) {
        if (2 * ks <= w) {
            const bf16x8_t pf = pack8v(s[2 * ks], s[2 * ks + 1]);
#pragma unroll
            for (int dt = 0; dt < 4; ++dt) o[dt] = __builtin_amdgcn_mfma_f32_16x16x32_bf16(lds_tfrag(VS, ks, 16 * dt + i, gq), pf, o[dt], 0, 0, 0);
        }
    }
#pragma unroll
    for (int dt = 0; dt < 4; ++dt)
#pragma unroll
        for (int ks = 0; ks < 2; ++ks) oi[dt] = __builtin_amdgcn_mfma_f32_16x16x32_bf16(pack8v(cpr[dt][ks][0], cpr[dt][ks][1]), qf[ks], oi[dt], 0, 0, 0);
    float nqn = 0.f;
#pragma unroll
    for (int ks = 0; ks < 2; ++ks) { float qv[8]; union { u32x4 u; bf16x8_t v; } qq; qq.v = qf[ks]; unpack8(qq.u, qv);
#pragma unroll
        for (int j = 0; j < 8; ++j) nqn += qv[j] * F[640 + 32 * ks + 8 * gq + j]; }
    nqn += shfl_xor_f(nqn, 16); nqn += shfl_xor_f(nqn, 32);
    const float nq = nqi + gI * nqn, inv = frcp(fmaxf(fabsf(nq), __expf(-mt_)));
    float ss = 0.f;
#pragma unroll
    for (int dt = 0; dt < 4; ++dt) { o[dt] = (o[dt] + oi[dt] * gI) * inv; ss += (o[dt][0] * o[dt][0] + o[dt][1] * o[dt][1]) + (o[dt][2] * o[dt][2] + o[dt][3] * o[dt][3]); }
    ss += shfl_xor_f(ss, 16); ss += shfl_xor_f(ss, 32);
    const float rs = rsqrtf(ss * (1.0f / 64.0f) + EPSN);
#pragma unroll
    for (int dt = 0; dt < 4; ++dt) { const int col = hh * 64 + 16 * dt + 4 * gq; const f32x4 gm = gmv[dt]; const u32x2 bo = bog[dt];
        const float r0 = sigmoidf_(bflo(bo.x)) * (o[dt][0] * rs * gm[0]), r1 = sigmoidf_(bfhi(bo.x)) * (o[dt][1] * rs * gm[1]), r2 = sigmoidf_(bflo(bo.y)) * (o[dt][2] * rs * gm[2]), r3 = sigmoidf_(bfhi(bo.y)) * (o[dt][3] * rs * gm[3]);
        u32x2 wv; wv.x = pk2(r0, r1); wv.y = pk2(r2, r3); *(u32x2*)(c.MIX() + (row0 + t) * DM + 256 + col) = wv; }
}
constexpr int HG_V = 0, HG_K = RSTG, HG_BC = 2 * RSTG, HG_SEG = HG_BC + 32768;
DEVI void hgrn_logf_kd(float lbv, float llb, float l1m, float df, float& lfd, float& kd) {
    const float x2 = l1m + log_sigmoid(df), mx = fmaxf(llb, x2); lfd = mx + log1pexp_neg(fabsf(llb - x2)); kd = (1.0f - lbv) * sigmoidf_(-df);
}
struct DecayRegs { unsigned short df[16]; float lbv; };
DEVI DecayRegs decay_load(const Ctx& c, int layer, int hh, size_t row0) {
    DecayRegs r; const bf16_t* Z = c.Z(); const int d = c.tid & 63, seg = c.tid >> 6;
#pragma unroll
    for (int tt = 0; tt < 16; ++tt) r.df[tt] = Z[(row0 + 16 * seg + tt) * NZ + ZC_DF + hh * 64 + d];
    r.lbv = hgrn_lb(c, layer, hh * 64 + d); return r;
}
DEVI void hgrn_cumdecay(const Ctx& c, const DecayRegs& dr) {
    LAS float* BC = (LAS float*)(c.lds + HG_BC); LAS float* SEG = (LAS float*)(c.lds + HG_SEG);
    const int d = c.tid & 63, seg = c.tid >> 6; const float lbv = dr.lbv, llb = __logf(fmaxf(lbv, 1e-30f)), l1m = __logf(1.0f - lbv);
    float run = 0.f;
#pragma unroll
    for (int tt = 0; tt < 16; ++tt) { const int t = 16 * seg + tt; float lfd, kd; hgrn_logf_kd(lbv, llb, l1m, bf2f(dr.df[tt]), lfd, kd); run += lfd; BC[t * 64 + d] = run; }
    SEG[seg * 64 + d] = run;
    __syncthreads();
    float off = 0.f;
    for (int s2 = 0; s2 < seg; ++s2) off += SEG[s2 * 64 + d];
#pragma unroll 4
    for (int tt = 0; tt < 16; ++tt) BC[(16 * seg + tt) * 64 + d] += off;
    __syncthreads();
}
DEVI void hgrn_chunk_state(const Ctx& c, int layer, int hh, size_t row0, float* Uout  , float* dec_out) {
    LAS unsigned char* VS = c.lds + HG_V; LAS unsigned char* KS = c.lds + HG_K; LAS float* BC = (LAS float*)(c.lds + HG_BC);
    const bf16_t* Z = c.Z(); const int tid = c.tid, lane = c.lane, i = lane & 15, gq = lane >> 4;
    const StageRegs vreg = stage_load(Z + row0 * NZ + ZC_DI + hh * 64, tid), freg = stage_load(Z + row0 * NZ + ZC_DF + hh * 64, tid);
    const DecayRegs dr = decay_load(c, layer, hh, row0);
    float lb16[2][8];
#pragma unroll
    for (int e = 0; e < 2; ++e) hgrn_lb8(c, layer, hh * 64 + 8 * (2 * (tid & 3) + e), lb16[e]);
    __syncthreads();
    stage_store(VS, vreg, tid);
    hgrn_cumdecay(c, dr);
    { const int tt = tid >> 2, ch = tid & 3;
#pragma unroll
      for (int e = 0; e < 2; ++e) { const int d0 = 8 * (2 * ch + e); float f[8]; unpack8(freg.v[e], f);
#pragma unroll
          for (int j = 0; j < 8; ++j) { const float lbv = lb16[e][j]; float lfd, kd; hgrn_logf_kd(lbv, __logf(fmaxf(lbv, 1e-30f)), __logf(1.0f - lbv), f[j], lfd, kd);
              f[j] = kd * __expf(BC[127 * 64 + d0 + j] - BC[tt * 64 + d0 + j]); }
          union { u32x4 u; bf16x8_t v; } pk; pk.v = pack8(f); *(LAS u32x4*)(KS + tt * 144 + (2 * ch + e) * 16) = pk.u; } }
    __syncthreads();
    { const int mt = c.wave >> 1, nt0 = 2 * (c.wave & 1);
      f32x4 acc0 = (f32x4){0.f, 0.f, 0.f, 0.f}, acc1 = acc0;
#pragma unroll
      for (int ks = 0; ks < 4; ++ks) { const bf16x8_t vf = lds_tfrag(VS, ks, 16 * mt + i, gq), k0 = lds_tfrag(KS, ks, 16 * nt0 + i, gq), k1 = lds_tfrag(KS, ks, 16 * (nt0 + 1) + i, gq);
          acc0 = __builtin_amdgcn_mfma_f32_16x16x32_bf16(vf, k0, acc0, 0, 0, 0); acc1 = __builtin_amdgcn_mfma_f32_16x16x32_bf16(vf, k1, acc1, 0, 0, 0); }
#pragma unroll
      for (int r = 0; r < 4; ++r) { Uout[(16 * mt + 4 * gq + r) * 64 + 16 * nt0 + i] = acc0[r]; Uout[(16 * mt + 4 * gq + r) * 64 + 16 * (nt0 + 1) + i] = acc1[r]; } }
    if (tid < 64) dec_out[tid] = __expf(BC[127 * 64 + tid]);
}
DEVI void hgrn_chunk_out(const Ctx& c, int layer, int hh, size_t row0, const float* Sst  ) {
    LAS unsigned char* VS = c.lds + HG_V; LAS float* BC = (LAS float*)(c.lds + HG_BC);
    const bf16_t* Z = c.Z(); const int tid = c.tid, lane = c.lane, i = lane & 15, gq = lane >> 4, w = c.wave;
    const int t = 16 * w + i;
    const StageRegs vreg = stage_load(Z + row0 * NZ + ZC_DI + hh * 64, tid);
    const DecayRegs dr = decay_load(c, layer, hh, row0);
    u32x4 qraw[2], dfr[8][2]; f32x4 spr[4][2][2]; u32x2 dgg[4]; f32x4 gmv[4];
#pragma unroll
    for (int ks = 0; ks < 2; ++ks) qraw[ks] = *(const u32x4*)(Z + (row0 + t) * NZ + ZC_DQ + hh * 64 + 32 * ks + 8 * gq);
#pragma unroll
    for (int kt = 0; kt < 8; ++kt) if (kt <= w) {
#pragma unroll
        for (int ks = 0; ks < 2; ++ks) dfr[kt][ks] = *(const u32x4*)(Z + (row0 + 16 * kt + i) * NZ + ZC_DF + hh * 64 + 32 * ks + 8 * gq); }
    float oml[2][8]; bf16x8_t qf1[2], qf2[2];
#pragma unroll
    for (int ks = 0; ks < 2; ++ks) { hgrn_lb8(c, layer, hh * 64 + 32 * ks + 8 * gq, oml[ks]);
#pragma unroll
        for (int j = 0; j < 8; ++j) oml[ks][j] = 1.0f - oml[ks][j]; }
    __syncthreads();
    stage_store(VS, vreg, tid);
    hgrn_cumdecay(c, dr);
#pragma unroll
    for (int ks = 0; ks < 2; ++ks) { float qv[8]; unpack8(qraw[ks], qv); float q1[8], q2[8];
        const f32x4 b0 = *(const LAS f32x4*)(BC + t * 64 + 32 * ks + 8 * gq), b1 = *(const LAS f32x4*)(BC + t * 64 + 32 * ks + 8 * gq + 4);
        f32x4 r0 = (f32x4){0.f, 0.f, 0.f, 0.f}, r1 = r0;
        if (w > 0) { r0 = *(const LAS f32x4*)(BC + (16 * w - 1) * 64 + 32 * ks + 8 * gq); r1 = *(const LAS f32x4*)(BC + (16 * w - 1) * 64 + 32 * ks + 8 * gq + 4); }
#pragma unroll
        for (int j = 0; j < 8; ++j) { const float bj = j < 4 ? b0[j] : b1[j - 4], rj = j < 4 ? r0[j] : r1[j - 4];
            q1[j] = qv[j] * oml[ks][j] * __expf(bj - rj); q2[j] = qv[j] * __expf(bj); }
        qf1[ks] = pack8(q1); qf2[ks] = pack8(q2); }
    f32x4 s[8];
#pragma unroll
    for (int kt = 0; kt < 8; ++kt) {
        s[kt] = (f32x4){0.f, 0.f, 0.f, 0.f};
        if (kt <= w) {
            const int sk = 16 * kt + i; f32x4 a = (f32x4){0.f, 0.f, 0.f, 0.f};
#pragma unroll
            for (int ks = 0; ks < 2; ++ks) { float f[8]; unpack8(dfr[kt][ks], f);
                const f32x4 b0 = *(const LAS f32x4*)(BC + sk * 64 + 32 * ks + 8 * gq), b1 = *(const LAS f32x4*)(BC + sk * 64 + 32 * ks + 8 * gq + 4);
                f32x4 r0 = (f32x4){0.f, 0.f, 0.f, 0.f}, r1 = r0;
                if (w > 0) { r0 = *(const LAS f32x4*)(BC + (16 * w - 1) * 64 + 32 * ks + 8 * gq); r1 = *(const LAS f32x4*)(BC + (16 * w - 1) * 64 + 32 * ks + 8 * gq + 4); }
#pragma unroll
                for (int j = 0; j < 8; ++j) { const float bj = j < 4 ? b0[j] : b1[j - 4], rj = j < 4 ? r0[j] : r1[j - 4]; f[j] = sigmoidf_(-f[j]) * __expf(fminf(rj - bj, 80.f)); }
                a = __builtin_amdgcn_mfma_f32_16x16x32_bf16(pack8(f), qf1[ks], a, 0, 0, 0); }
#pragma unroll
            for (int r = 0; r < 4; ++r) a[r] = ((16 * kt + 4 * gq + r) <= t) ? a[r] : 0.f;
            s[kt] = a;
        }
    }
#pragma unroll
    for (int dt = 0; dt < 4; ++dt) {
#pragma unroll
        for (int ks = 0; ks < 2; ++ks) { const float* sp = Sst + (16 * dt + i) * 64 + 32 * ks + 8 * gq; spr[dt][ks][0] = *(const f32x4*)sp; spr[dt][ks][1] = *(const f32x4*)(sp + 4); }
        const int col = hh * 64 + 16 * dt + 4 * gq; gmv[dt] = *(const f32x4*)(c.in[I_GHG] + layer * 256 + col); dgg[dt] = *(const u32x2*)(Z + (row0 + t) * NZ + ZC_DG + col); }
    f32x4 o[4];
#pragma unroll
    for (int dt = 0; dt < 4; ++dt) o[dt] = (f32x4){0.f, 0.f, 0.f, 0.f};
#pragma unroll
    for (int ks = 0; ks < 4; ++ks) {
        if (2 * ks <= w) {
            const bf16x8_t pf = pack8v(s[2 * ks], s[2 * ks + 1]);
#pragma unroll
            for (int dt = 0; dt < 4; ++dt) o[dt] = __builtin_amdgcn_mfma_f32_16x16x32_bf16(lds_tfrag(VS, ks, 16 * dt + i, gq), pf, o[dt], 0, 0, 0);
        }
    }
#pragma unroll
    for (int dt = 0; dt < 4; ++dt)
#pragma unroll
        for (int ks = 0; ks < 2; ++ks) o[dt] = __builtin_amdgcn_mfma_f32_16x16x32_bf16(pack8v(spr[dt][ks][0], spr[dt][ks][1]), qf2[ks], o[dt], 0, 0, 0);
    float ss = 0.f;
#pragma unroll
    for (int dt = 0; dt < 4; ++dt) ss += (o[dt][0] * o[dt][0] + o[dt][1] * o[dt][1]) + (o[dt][2] * o[dt][2] + o[dt][3] * o[dt][3]);
    ss += shfl_xor_f(ss, 16); ss += shfl_xor_f(ss, 32);
    const float rs = rsqrtf(ss * (1.0f / 64.0f) + EPSN);
#pragma unroll
    for (int dt = 0; dt < 4; ++dt) { const int col = hh * 64 + 16 * dt + 4 * gq; const f32x4 gm = gmv[dt];
        const u32x2 dg = dgg[dt]; const float g0 = bflo(dg.x), g1 = bfhi(dg.x), g2 = bflo(dg.y), g3 = bfhi(dg.y);
        const float r0 = (o[dt][0] * rs * gm[0]) * (g0 * sigmoidf_(g0)), r1 = (o[dt][1] * rs * gm[1]) * (g1 * sigmoidf_(g1)), r2 = (o[dt][2] * rs * gm[2]) * (g2 * sigmoidf_(g2)), r3 = (o[dt][3] * rs * gm[3]) * (g3 * sigmoidf_(g3));
        u32x2 wv; wv.x = pk2(r0, r1); wv.y = pk2(r2, r3); *(u32x2*)(c.MIX() + (row0 + t) * DM + 768 + col) = wv; }
}

constexpr int GM_PITCH = 528;
DEVI void gmlp_chunk_item(const Ctx& c, int layer, size_t row0) {
    LAS unsigned char* VS = c.lds; const bf16_t* Z = c.Z(); const int lane = c.lane, i = lane & 15, gq = lane >> 4, w = c.wave, t = 16 * w + i;
    bf16x8_t wf[4][4];
    u32x2 cvr[16];
    {
        f32x4 wr[4][4][2];
#pragma unroll
        for (int hh = 0; hh < 4; ++hh)
#pragma unroll
            for (int ks = 0; ks < 4; ++ks) { const float* wp = c.in[I_WS] + ((size_t)(layer * NH + hh) * 128 + t) * 128 + 32 * ks + 4 * gq; wr[hh][ks][0] = *(const f32x4*)wp; wr[hh][ks][1] = *(const f32x4*)(wp + 16); }
#pragma unroll
        for (int rr = 0; rr < 16; ++rr) cvr[rr] = *(const u32x2*)(Z + (row0 + w * 16 + rr) * NZ + ZC_CV + 4 * lane);
#pragma unroll
        for (int hh = 0; hh < 4; ++hh)
#pragma unroll
            for (int ks = 0; ks < 4; ++ks) if (2 * ks <= w) { f32x4 w0 = wr[hh][ks][0], w1 = wr[hh][ks][1];
#pragma unroll
                for (int r = 0; r < 4; ++r) { if (32 * ks + 4 * gq + r > t) w0[r] = 0.f; if (32 * ks + 16 + 4 * gq + r > t) w1[r] = 0.f; }
                wf[hh][ks] = pack8v(w0, w1); }
    }
    __syncthreads();
    { const float* gcv = c.in[I_GCV] + layer * 256; const f32x4 gv = *(const f32x4*)(gcv + 4 * lane);
#pragma unroll
      for (int rr = 0; rr < 16; ++rr) { const u32x2 u = cvr[rr];
          const float e0 = gelu_tanh(bflo(u.x)), e1 = gelu_tanh(bfhi(u.x)), e2 = gelu_tanh(bflo(u.y)), e3 = gelu_tanh(bfhi(u.y));
          const float rs = rsqrtf(wave_sum((e0 * e0 + e1 * e1) + (e2 * e2 + e3 * e3)) * (1.0f / 256.0f) + EPSN);
          u32x2 o; o.x = pk2(e0 * rs * gv[0], e1 * rs * gv[1]); o.y = pk2(e2 * rs * gv[2], e3 * rs * gv[3]);
          *(LAS u32x2*)(VS + (w * 16 + rr) * GM_PITCH + 8 * lane) = o; } }
    __syncthreads();
    u32x2 cur4[4][4]; float bs4[4];
#pragma unroll
    for (int hh = 0; hh < 4; ++hh) {
#pragma unroll
        for (int ct = 0; ct < 4; ++ct) cur4[hh][ct] = *(const u32x2*)(Z + (row0 + t) * NZ + ZC_CU + hh * 64 + 16 * ct + 4 * gq);
        bs4[hh] = c.in[I_BS][(layer * NH + hh) * 128 + t]; }
    __builtin_amdgcn_sched_barrier(0);
#pragma unroll
    for (int hh = 0; hh < 4; ++hh) {
        const u32x2* cur = cur4[hh]; const float bsv = bs4[hh];
        f32x4 acc[4];
#pragma unroll
        for (int ct = 0; ct < 4; ++ct) acc[ct] = (f32x4){0.f, 0.f, 0.f, 0.f};
#pragma unroll
        for (int ks = 0; ks < 4; ++ks) if (2 * ks <= w) {
#pragma unroll
            for (int ct = 0; ct < 4; ++ct) acc[ct] = __builtin_amdgcn_mfma_f32_16x16x32_bf16(lds_tfrag<GM_PITCH>(VS, ks, hh * 64 + 16 * ct + i, gq), wf[hh][ks], acc[ct], 0, 0, 0);
        }
#pragma unroll
        for (int ct = 0; ct < 4; ++ct) { const u32x2 u = cur[ct];
            const float r0 = gelu_tanh(bflo(u.x)) * (acc[ct][0] + bsv), r1 = gelu_tanh(bfhi(u.x)) * (acc[ct][1] + bsv), r2 = gelu_tanh(bflo(u.y)) * (acc[ct][2] + bsv), r3 = gelu_tanh(bfhi(u.y)) * (acc[ct][3] + bsv);
            u32x2 wv; wv.x = pk2(r0, r1); wv.y = pk2(r2, r3); *(u32x2*)(c.MIX() + (row0 + t) * DM + 512 + hh * 64 + 16 * ct + 4 * gq) = wv; }
    }
}

DEVI void copy_item(const Ctx& c, int layer, int it) {
    constexpr int PER_T_P = 2 * WB * 256 / 16384  , PER_T_S = DECB * WB * 256 / 16384  ;
    const bf16_t* Z = c.Z();
    if (it < 2 * PER_T_P) {
        const int kv = it / PER_T_P, r = it % PER_T_P; float* o = c.out + (kv ? O_VWP : O_KWP) + (size_t)layer * 2 * WB * 256 + (size_t)r * 16384; const int zc = kv ? ZC_AV : ZC_AK;
        for (int i = c.tid; i < 4096; i += NTHREADS) { const size_t e = (size_t)r * 16384 + 4 * i; const int b = (int)(e / (WB * 256)), rr = (int)((e / 256) % WB), col = (int)(e % 256);
            const u32x2 u = *(const u32x2*)(Z + ((size_t)b * TSEQ + (TSEQ - WB) + rr) * NZ + zc + col); *(f32x4*)(o + 4 * i) = (f32x4){bflo(u.x), bfhi(u.x), bflo(u.y), bfhi(u.y)}; }
    } else {
        it -= 2 * PER_T_P; const int kv = it / PER_T_S, r = it % PER_T_S; float* o = c.out + (kv ? O_VWS : O_KWS) + (size_t)layer * DECB * WB * 256 + (size_t)r * 16384; const int zc = kv ? ZC_AV : ZC_AK;
        const float* src = c.in[kv ? I_CV : I_CK] + (size_t)layer * DECB * WB * 256;
        if ((r & 31) != 31) {
            const f32x4* s4 = (const f32x4*)(src + (size_t)r * 16384 + DECT * 256); f32x4* o4 = (f32x4*)o; f32x4 v[8];
#pragma unroll
            for (int k = 0; k < 8; ++k) v[k] = __builtin_nontemporal_load(s4 + c.tid + k * NTHREADS);
#pragma unroll
            for (int k = 0; k < 8; ++k) __builtin_nontemporal_store(v[k], o4 + c.tid + k * NTHREADS);
            return;
        }
        for (int i = c.tid; i < 4096; i += NTHREADS) { const size_t e = (size_t)r * 16384 + 4 * i; const int b = (int)(e / (WB * 256)), rr = (int)((e / 256) % WB), col = (int)(e % 256);
            f32x4 val;
            if (rr < WB - DECT) val = *(const f32x4*)(src + ((size_t)b * WB + rr + DECT) * 256 + col);
            else { const u32x2 u = *(const u32x2*)(Z + ((size_t)NPR + b * DECT + (rr - (WB - DECT))) * NZ + zc + col); val = (f32x4){bflo(u.x), bfhi(u.x), bflo(u.y), bfhi(u.y)}; }
            *(f32x4*)(o + 4 * i) = val; }
    }
}
constexpr int N_BIG = 2 * DECB * 8;
DEVI void big_copy_item(const Ctx& c, int layer, int it) {
    const int kv = it >> 8, b = (it >> 3) & 31, j = it & 7, n16 = (j == 7) ? 3 : 4;
    const size_t off = ((size_t)(layer * DECB + b) * WB) * 256 + (size_t)j * 4 * 16384;
    const f32x4* s4 = (const f32x4*)(c.in[kv ? I_CV : I_CK] + off + DECT * 256); f32x4* o4 = (f32x4*)(c.out + (kv ? O_VWS : O_KWS) + off);
    f32x4 v[32];
#pragma unroll
    for (int k = 0; k < 32; ++k) if (k < 8 * n16) v[k] = __builtin_nontemporal_load(s4 + c.tid + k * NTHREADS);
#pragma unroll
    for (int k = 0; k < 32; ++k) if (k < 8 * n16) __builtin_nontemporal_store(v[k], o4 + c.tid + k * NTHREADS);
}
DEVI void phase_mix_local(const Ctx& c0, int layer0, int qslot) {
    WorkQueue q; q.start(c0, (unsigned*)(c0.ws + WS_CTL) + CW_QUEUE + 64 * (2 * layer0) + 64 * 8 * qslot);
    for (;;) {
        const int pos = q.pop(c0);
        if (pos >= 2208) break;
        int it; bool big = false;
        if (pos < 64) it = 1440 + pos;
        else if (pos >= 64 + 102 * 21) { big = true; it = 510 + (pos - (64 + 102 * 21)); }
        else { const int p = pos - 64, g = p / 21, m = p % 21;
            if ((m & 3) == 3) { big = true; it = g * 5 + (m >> 2); }
            else { const int nb = g * 16 + m - ((m + 1) >> 2);
                if (nb < 416) it = nb;
                else { const int p2 = nb - 416, g2 = p2 / 19, m2 = p2 % 19; it = (m2 < 16) ? 416 + g2 * 16 + m2 : 1504 + g2 * 3 + (m2 - 16); } } }
        const Ctx c = relaunder(c0); int layer = layer0; asm volatile("" : "+s"(layer));
        float* MU = (float*)(c.ws + WS_MU); float* HU = (float*)(c.ws + WS_HU);
        if (big || it >= 256) q.prefetch(c);
        if (big) big_copy_item(c, layer, it);
        else if (it < 256) { const int itu = __builtin_amdgcn_readfirstlane(it); const int blk = itu & 31, hh = (itu >> 5) & 3, b = itu >> 7; for (int rp = 0; rp < REP_ATT; ++rp) attn_block_item(c, layer, b, hh, blk, q); }
        else if (it < 384) { for (int rp = 0; rp < REP_GMLP; ++rp) gmlp_chunk_item(c, layer, (size_t)(it - 256) * 128); }
        else if (it < 416) { const int b = it - 384; gmlp_item(c, layer, (size_t)NPR + b * DECT, DECT, c.out + O_CVS + ((size_t)layer * DECB + b) * DECT * 256); }
        else if (it < 928) { const int i2 = it - 416, b = i2 >> 8, hh = (i2 >> 6) & 3, ch = i2 & 63;
            for (int rp = 0; rp < REP_STATE; ++rp) mlstm_chunk_state(c, layer, hh, (size_t)b * TSEQ + ch * 128, MU + (size_t)i2 * 4096, (float*)((char*)MU + REC_N_OFF) + i2 * 64, (float*)((char*)MU + REC_M_OFF) + i2, (float*)((char*)MU + REC_B_OFF) + i2); }
        else if (it < 1440) { const int i2 = it - 928, b = i2 >> 8, hh = (i2 >> 6) & 3, ch = i2 & 63;
            for (int rp = 0; rp < REP_STATE; ++rp) hgrn_chunk_state(c, layer, hh, (size_t)b * TSEQ + ch * 128, HU + (size_t)i2 * 4096, (float*)((char*)HU + REC_N_OFF) + i2 * 64); }
        else if (it < 1504) { const int qh = __builtin_amdgcn_readfirstlane((it - 1440) * 8 + c.wave); const int t = qh & 3, hh = (qh >> 2) & 3, b = qh >> 4; for (int rp = 0; rp < REP_SATT; ++rp) attn_sample_qh(c, layer, b, hh, t); }
        else if (it < 1632) copy_item(c, layer, it - 1504);
        else { const int s = it - 1632; copy_item(c, layer, 128 + (s >> 5) * 1024 + (s & 31) * 32 + 31); }
    }
}

DEVI void phase_scan(const Ctx& c, int layer) {
    float* MU = (float*)(c.ws + WS_MU); float* MCS = (float*)(c.ws + WS_MCS); float* HU = (float*)(c.ws + WS_HU); float* HSS = (float*)(c.ws + WS_HSS);
    const int tid = c.tid; constexpr int GRP = 16;
    for (int it = c.bid; it < 128; it += c.G) {
        const int seq = it >> 3, e = (it & 7) * 512 + tid;
        if (seq < 8) {
            const float* un = (const float*)((const char*)MU + REC_N_OFF); const float* um = (const float*)((const char*)MU + REC_M_OFF); const float* ub = (const float*)((const char*)MU + REC_B_OFF);
            float* csn = (float*)((char*)MCS + REC_N_OFF); float* csm = (float*)((char*)MCS + REC_M_OFF);
            const bool lead = (it & 7) == 0; const bool do_n = lead && tid < 64;
            float C = 0.f, nn = 0.f, m = 0.f;
#pragma unroll 1
            for (int ch0 = 0; ch0 < NCHUNK; ch0 += GRP) {
                const float* up = MU + (size_t)(seq * NCHUNK + ch0) * 4096 + e; float* cp = MCS + (size_t)(seq * NCHUNK + ch0) * 4096 + e; const int item0 = seq * NCHUNK + ch0;
                float u[GRP], nu[GRP], Bv[GRP], mlv[GRP];
#pragma unroll
                for (int q = 0; q < GRP; ++q) { u[q] = up[(size_t)q * 4096]; Bv[q] = ub[item0 + q]; mlv[q] = um[item0 + q]; nu[q] = do_n ? un[(item0 + q) * 64 + tid] : 0.f; }
#pragma unroll
                for (int q = 0; q < GRP; ++q) {
                    cp[(size_t)q * 4096] = C; if (do_n) csn[(item0 + q) * 64 + tid] = nn; if (lead && tid == 0) csm[item0 + q] = m;
                    const float mn = fmaxf(Bv[q] + m, mlv[q]); const float a = __expf(Bv[q] + m - mn), bb = __expf(mlv[q] - mn);
                    C = a * C + bb * u[q]; nn = a * nn + bb * nu[q]; m = mn; }
            }
            c.out[O_CP + ((size_t)layer * 8 + seq) * 4096 + e] = C;
            if (lead && tid == 0) c.out[O_MP + layer * 8 + seq] = m;
            if (do_n) c.out[O_NP + ((size_t)layer * 8 + seq) * 64 + tid] = nn;
        } else {
            const int bh = seq - 8, d = e & 63, v = e >> 6; const float* dec = (const float*)((const char*)HU + REC_N_OFF);
            float S = 0.f;
#pragma unroll 1
            for (int ch0 = 0; ch0 < NCHUNK; ch0 += GRP) {
                const float* up = HU + (size_t)(bh * NCHUNK + ch0) * 4096 + e; float* sp = HSS + (size_t)(bh * NCHUNK + ch0) * 4096 + e; const float* dp = dec + (bh * NCHUNK + ch0) * 64 + d;
                float u[GRP], dd[GRP];
#pragma unroll
                for (int q = 0; q < GRP; ++q) { u[q] = up[(size_t)q * 4096]; dd[q] = dp[q * 64]; }
#pragma unroll
                for (int q = 0; q < GRP; ++q) { sp[(size_t)q * 4096] = S; S = dd[q] * S + u[q]; }
            }
            c.out[O_SP + ((size_t)layer * 8 + bh) * 4096 + d * 64 + v] = S;
        }
    }
}

DEVI void phase_mix_out(const Ctx& c0, int layer0, int qslot) {
    WorkQueue q; q.start(c0, (unsigned*)(c0.ws + WS_CTL) + CW_QUEUE + 64 * (2 * layer0 + 1) + 64 * 8 * qslot);
    for (;;) {
        const int it = q.pop(c0);
        if (it >= 1280) break;
        const Ctx c = relaunder(c0); int layer = layer0; asm volatile("" : "+s"(layer));
        float* MCS = (float*)(c.ws + WS_MCS); float* HSS = (float*)(c.ws + WS_HSS);
        q.prefetch(c);
        if (it < 512) { const int b = it >> 8, hh = (it >> 6) & 3, ch = it & 63; RecIO io{}; io.st_in = MCS + (size_t)it * 4096; io.n_in = (const float*)((const char*)MCS + REC_N_OFF) + it * 64; io.m_in = (const float*)((const char*)MCS + REC_M_OFF) + it;
            for (int rp = 0; rp < REP_OUT; ++rp) mlstm_chunk_out(c, layer, hh, (size_t)b * TSEQ + ch * 128, io.st_in, io.n_in, io.m_in); }
        else if (it < 1024) { const int i2 = it - 512, b = i2 >> 8, hh = (i2 >> 6) & 3, ch = i2 & 63; RecIO io{}; io.st_in = HSS + (size_t)i2 * 4096; io.native_in = true;
            for (int rp = 0; rp < REP_OUT; ++rp) hgrn_chunk_out(c, layer, hh, (size_t)b * TSEQ + ch * 128, io.st_in); }
        else if (it < 1152) { const int i2 = it - 1024, b = i2 >> 2, hh = i2 & 3; const size_t sidx = (size_t)(layer * DECB + b) * NH + hh; RecIO io{};
            io.st_in = c.in[I_MC] + sidx * 4096; io.n_in = c.in[I_MN] + sidx * 64; io.m_in = c.in[I_MM] + sidx;
            io.st_out = c.out + O_CS + sidx * 4096; io.n_out = c.out + O_NS + sidx * 64; io.m_out = c.out + O_MS + sidx;
            for (int rp = 0; rp < REP_SREC; ++rp) mlstm_item<true>(c, layer, hh, (size_t)NPR + b * DECT, DECT, io, 0.f); }
        else { const int i2 = it - 1152, b = i2 >> 2, hh = i2 & 3; const size_t sidx = (size_t)(layer * DECB + b) * NH + hh; RecIO io{};
            io.st_in = c.in[I_HS] + sidx * 4096; io.st_out = c.out + O_SS + sidx * 4096;
            for (int rp = 0; rp < REP_SREC; ++rp) hgrn_item<true>(c, layer, hh, (size_t)NPR + b * DECT, DECT, io); }
    }
}

DEVI void phase_final(const Ctx& c) {
    const int gw = c.bid * 8 + c.wave, NGW = c.G * 8; const bf16_t* x = c.X2(); const float* g = c.in[I_GFIN];
    f32x4 gv[4];
#pragma unroll
    for (int j = 0; j < 4; ++j) gv[j] = *(const f32x4*)(g + 256 * j + 4 * c.lane);
    for (int row0 = gw; row0 < NTOK; row0 += 3 * NGW) {
        u32x2 xb[3][4]; float rs[3];
#pragma unroll
        for (int r = 0; r < 3; ++r) { const int row = row0 + r * NGW < NTOK ? row0 + r * NGW : row0; const bf16_t* xr = x + (size_t)row * DM;
#pragma unroll
            for (int j = 0; j < 4; ++j) xb[r][j] = *(const u32x2*)(xr + 256 * j + 4 * c.lane);
            rs[r] = row_rs(c.SSQ(), row); }
        __builtin_amdgcn_sched_barrier(0);
#pragma unroll
        for (int r = 0; r < 3; ++r) { const int row = row0 + r * NGW; if (row < NTOK) {
            float* o = c.out + ((row < NPR) ? O_YP + (size_t)row * DM : O_YS + (size_t)(row - NPR) * DM);
#pragma unroll
            for (int j = 0; j < 4; ++j) { const f32x4 v = (f32x4){bflo(xb[r][j].x), bfhi(xb[r][j].x), bflo(xb[r][j].y), bfhi(xb[r][j].y)}; __builtin_nontemporal_store(v * rs[r] * gv[j], (f32x4*)(o + 256 * j + 4 * c.lane)); } } }
    }
}

#define XB_TMO      128
#define XB_XCNT(j)  (256  + 64 * (j))
#define XB_XSUB(j)  (1280 + 64 * (j))
#define XB_XGEN(j)  (2304 + 64 * (j))
#define XB_TOP      3328
#define XB_TOPGEN   3392
#define XCD_BAR_WORDS 3456
#define XB_SPIN_CAP (1u << 18)

__device__ __forceinline__ unsigned xb_ld(unsigned* p)              { return __hip_atomic_load(p, __ATOMIC_RELAXED, __HIP_MEMORY_SCOPE_AGENT); }
__device__ __forceinline__ unsigned xb_add(unsigned* p, unsigned v) { return __hip_atomic_fetch_add(p, v, __ATOMIC_RELAXED, __HIP_MEMORY_SCOPE_AGENT); }
__device__ __forceinline__ unsigned xb_xcc_id() { return (unsigned)__builtin_amdgcn_s_getreg((3 << 11) | 20) & 0xFu; }
#define XB_SPIN(cond, bar) do { unsigned _sp = 0; while (cond) { __builtin_amdgcn_s_sleep(1); \
    if ((++_sp & 255u) == 0u) { if (xb_ld(&(bar)[XB_TMO])) break; if (_sp > XB_SPIN_CAP) { atomicAdd(&(bar)[XB_TMO], 1u); break; } } } } while (0)

struct XcdBarrier {
    unsigned* bar; unsigned x;
    volatile LAS unsigned* st;
};

__device__ __forceinline__ XcdBarrier xcd_barrier_post(unsigned* bar, volatile LAS unsigned* st, bool leader) {
    XcdBarrier b; b.bar = bar; b.x = xb_xcc_id(); b.st = st;
    if (leader) (void)xb_add(&bar[XB_XCNT(b.x)], 1u);
    return b;
}
__device__ __forceinline__ void xcd_barrier_complete(unsigned* bar, unsigned x, unsigned& nloc, unsigned& nx) {
    const unsigned G = gridDim.x * gridDim.y * gridDim.z;
    unsigned sum, cnt, mine, sp = 0u;
    for (;;) {
        sum = 0u; cnt = 0u; mine = 0u;
#pragma unroll
        for (unsigned j = 0; j < 16; ++j) { const unsigned c = xb_ld(&bar[XB_XCNT(j)]); sum += c; cnt += (c > 0u) ? 1u : 0u; mine = (j == x) ? c : mine; }
        if (sum == G) break;
        __builtin_amdgcn_s_sleep(1);
        if ((++sp & 255u) == 0u) { if (xb_ld(&bar[XB_TMO])) break; if (sp > XB_SPIN_CAP) { atomicAdd(&bar[XB_TMO], 1u); break; } }
    }
    nloc = mine > 0u ? mine : 1u; nx = cnt > 0u ? cnt : 1u;
}

__device__ __forceinline__ void xcd_barrier(const XcdBarrier& b, bool leader) {
    asm volatile("s_waitcnt vmcnt(0)" ::: "memory");
    __syncthreads();
    if (leader) {
        unsigned* bar = b.bar;
        __builtin_amdgcn_s_waitcnt(0);
        unsigned nloc = b.st[0], nx = b.st[1];
        if (nloc == 0u) { xcd_barrier_complete(bar, b.x, nloc, nx); b.st[0] = nloc; b.st[1] = nx; }
        const unsigned old = xb_add(&bar[XB_XSUB(b.x)], 1u);
        const unsigned gen = old / nloc;
        if (old + 1u == (gen + 1u) * nloc) {
            __builtin_amdgcn_fence(__ATOMIC_RELEASE, "agent");
            asm volatile("s_waitcnt vmcnt(0)" ::: "memory");
            const unsigned og = xb_add(&bar[XB_TOP], 1u);
            const unsigned tg = og / nx;
            if (og + 1u == (tg + 1u) * nx) xb_add(&bar[XB_TOPGEN], 1u);
            else XB_SPIN(xb_ld(&bar[XB_TOPGEN]) == tg, bar);
            __builtin_amdgcn_fence(__ATOMIC_ACQUIRE, "agent");
            xb_add(&bar[XB_XGEN(b.x)], 1u);
            asm volatile("s_waitcnt vmcnt(0)" ::: "memory");
        } else {
            XB_SPIN(xb_ld(&bar[XB_XGEN(b.x)]) == gen, bar);
            __builtin_amdgcn_fence(__ATOMIC_ACQUIRE, "agent");
            asm volatile("s_waitcnt vmcnt(0)" ::: "memory");
        }
    }
    __syncthreads();
}

constexpr int PH_PER_LAYER = 9;
DEVI Ctx make_ctx(const Params& p, unsigned char* lds_raw, int wave0) {
    int tid_ = wave0 * 64 + lane_opaque(); asm volatile("" : "+v"(tid_));
    const __attribute__((address_space(4))) Params* kp = (const __attribute__((address_space(4))) Params*)__builtin_amdgcn_kernarg_segment_ptr(); asm volatile("" : "+s"(kp));
    const __attribute__((address_space(4))) ParamsDev* kd = (const __attribute__((address_space(4))) ParamsDev*)kp; Ctx c; c.in.p = kd->in; c.out = (float*)kd->out; c.ws = (unsigned char*)kd->ws; c.lds = (LAS unsigned char*)lds_raw; c.tid = tid_; c.lane = c.tid & 63; c.wave = __builtin_amdgcn_readfirstlane(c.tid >> 6); c.G = gridDim.x; c.bid = blockIdx.x;
    return c;
}
template <int SUB> DEVI void run_sub(const Ctx& c, const Params& p, int layer, int qslot = 0) {
    const bf16_t* xin_p = c.X2(); const bf16_t* xin_s = c.X2() + (size_t)NPR * DM;
    if constexpr (SUB == 1) { pg8::Gemm g{c.X2(), (const bf16_t*)(c.ws + WS_WIN) + (size_t)layer * NZ * DM, MPAD, NZ, DM}; pg8::StaticOrder S; S.init(MPAD, NZ, c.G, c.bid);
        EpiRowScaleBf16<0> E{c.Z(), NZ, c.SSQ(), c.lds + EPI_STG}; pg8::gemm_phase<EpiRowScaleBf16<0>, pg8::StaticOrder, true, true>(c.lds, g, S, E, c.tid);
        {
            const int nwg = (MPAD / 256) * (NZ / 256), full = nwg % c.G;
            const int i0 = layer == 0 ? CONV_ITEMS_WIN : CONV_ITEMS_PER_LAYER + CONV_ITEMS_WIN, i1 = layer == 0 ? CONV_ITEMS_PER_LAYER + CONV_ITEMS_WIN : 2 * CONV_ITEMS_PER_LAYER;
            if (full != 0 && c.bid >= full) convert_weights(c, i0, i1, (c.bid - full) * 8 + c.wave, (c.G - full) * 8);
            else if (full == 0) convert_weights(c, i0, i1, c.bid * 8 + c.wave, c.G * 8); } }
    else if constexpr (SUB == 2) phase_mix_local(c, layer, qslot);
    else if constexpr (SUB == 3) phase_scan(c, layer);
    else if constexpr (SUB == 4) phase_mix_out(c, layer, qslot);
    else if constexpr (SUB == 5) { const bf16_t* wt = (const bf16_t*)(c.ws + WS_WOUT) + (size_t)layer * DM * DM;
        { SkEpiResidualNorm se{xin_s, c.X1() + (size_t)NPR * DM, c.SSQ() + (size_t)NPR * 16}; skinny_gemm(c, c.MIX() + (size_t)NPR * DM, wt, DM, DM, se); }
        pg8::Gemm g{c.MIX(), wt, NPR, DM, DM}; pg8::StaticOrder S; S.init(NPR, DM, c.G, c.bid);
        EpiResidualNorm E{xin_p, c.X1(), c.SSQ(), c.lds + EPI_STG}; pg8::gemm_phase<EpiResidualNorm, pg8::StaticOrder, true, true>(c.lds, g, S, E, c.tid); }
    else if constexpr (SUB == 7) { const bf16_t* wt = (const bf16_t*)(c.ws + WS_WUP) + (size_t)layer * FF * DM;
        { SkEpiRelu2 se{c.Hb() + (size_t)NPR * FF, c.SSQ() + (size_t)NPR * 16}; skinny_gemm(c, c.X1() + (size_t)NPR * DM, wt, FF, DM, se); }
        pg8::Gemm g{c.X1(), wt, NPR, FF, DM}; pg8::StaticOrder S; S.init(NPR, FF, c.G, c.bid);
        EpiRowScaleBf16<1> E{c.Hb(), FF, c.SSQ(), c.lds + EPI_STG}; pg8::gemm_phase<EpiRowScaleBf16<1>, pg8::StaticOrder, true, true>(c.lds, g, S, E, c.tid); }
    else if constexpr (SUB == 8) { const bf16_t* wt = (const bf16_t*)(c.ws + WS_WDN) + (size_t)layer * DM * FF;
        { SkEpiResidualNorm se{c.X1() + (size_t)NPR * DM, c.X2() + (size_t)NPR * DM, c.SSQ() + (size_t)NPR * 16}; skinny_gemm(c, c.Hb() + (size_t)NPR * FF, wt, DM, FF, se); }
        pg8::Gemm g{c.Hb(), wt, NPR, DM, FF}; pg8::StaticOrder S; S.init(NPR, DM, c.G, c.bid);
        EpiResidualNorm E{c.X1(), c.X2(), c.SSQ(), c.lds + EPI_STG}; pg8::gemm_phase<EpiResidualNorm, pg8::StaticOrder, true, true>(c.lds, g, S, E, c.tid); }
    else if constexpr (SUB == 9) phase_prologue(c);
    else phase_final(c);
}
template <int SUB> __global__ void __launch_bounds__(NTHREADS, 2) k_sub(Params p, int layer) {
    extern __shared__ __attribute__((aligned(16))) unsigned char lds_raw[];
    const Ctx c = make_ctx(p, lds_raw, __builtin_amdgcn_readfirstlane((int)threadIdx.x >> 6));
    run_sub<SUB>(c, p, layer);
}
template <int SUB> static void launch_sub(const Params& p, int layer, int grid, hipStream_t stream) {
    static bool attr_set = false;
    if (!attr_set) { (void)hipFuncSetAttribute((const void*)k_sub<SUB>, hipFuncAttributeMaxDynamicSharedMemorySize, LDS_BYTES); attr_set = true; }
    hipLaunchKernelGGL(k_sub<SUB>, dim3(grid), dim3(NTHREADS), LDS_BYTES, stream, p, layer);
}

#ifndef REP_A
#define REP_A 1
#endif
#ifndef REP_B
#define REP_B 1
#endif
#ifndef REP_C
#define REP_C 1
#endif
#ifndef REP_D
#define REP_D 1
#endif
#ifndef REP_G1
#define REP_G1 1
#endif
#ifndef REP_G2
#define REP_G2 1
#endif
#ifndef REP_G3
#define REP_G3 1
#endif
#ifndef REP_G4
#define REP_G4 1
#endif
#ifndef REP_ML
#define REP_ML 1
#endif
#ifndef REP_MO
#define REP_MO 1
#endif
#ifndef REP_BAR
#define REP_BAR 1
#endif
#define GRID_BAR() do { for (int rb_ = 0; rb_ < REP_BAR; ++rb_) { XcdBarrier b_; b_.bar = (unsigned*)(c.ws + WS_CTL); b_.x = xb_xcc_id(); b_.st = (volatile LAS unsigned*)(c.lds + LDS_BYTES - 64); xcd_barrier(b_, wave0 == 0 && lane_opaque() == 0); c = make_ctx(p, lds_raw, wave0); } } while (0)
__global__ void __launch_bounds__(NTHREADS, 2) mk_fwd(Params p) {
    extern __shared__ __attribute__((aligned(16))) unsigned char lds_raw[];
    const int wave0 = __builtin_amdgcn_readfirstlane((int)threadIdx.x >> 6);
    Ctx c = make_ctx(p, lds_raw, wave0);
    volatile LAS unsigned* st = (volatile LAS unsigned*)(c.lds + LDS_BYTES - 64);
    if (c.tid < 16) st[c.tid] = 0u;
    __syncthreads();
    (void)xcd_barrier_post((unsigned*)(c.ws + WS_CTL), st, c.tid == 0);
    c = make_ctx(p, lds_raw, wave0);
    if (p.ph_lo < 0) cg::this_grid().sync();
    for (int rep = 0; rep < REP_D; ++rep) run_sub<9>(c, p, 0);
    GRID_BAR();
#pragma unroll 1
    for (int layer = 0; layer < NLAYER; ++layer) {
        for (int rep = 0; rep < REP_A * REP_G1; ++rep) run_sub<1>(c, p, layer);
        GRID_BAR();
        for (int rep = 0; rep < REP_ML; ++rep) run_sub<2>(c, p, layer, rep);
        GRID_BAR();
        for (int rep = 0; rep < REP_D; ++rep) run_sub<3>(c, p, layer);
        GRID_BAR();
        for (int rep = 0; rep < REP_MO; ++rep) run_sub<4>(c, p, layer, rep);
        GRID_BAR();
        for (int rep = 0; rep < REP_A * REP_G2; ++rep) run_sub<5>(c, p, layer);
        GRID_BAR();
        for (int rep = 0; rep < REP_A * REP_G3; ++rep) run_sub<7>(c, p, layer);
        GRID_BAR();
        for (int rep = 0; rep < REP_A * REP_G4; ++rep) run_sub<8>(c, p, layer);
        GRID_BAR();
    }
    for (int rep = 0; rep < REP_D; ++rep) run_sub<10>(c, p, 0);
}

extern "C" void kernel_launch(void* const* d_in, const int* in_sizes, int n_in, void* d_out, int out_size, void* d_ws, size_t ws_size, hipStream_t stream) {
    static int grid = 0;
    if (grid == 0) {
        if (n_in != N_IN || (size_t)out_size != O_END || ws_size < WS_END) { fprintf(stderr, "kernel_launch: unexpected shapes: n_in %d out %d (want %zu) ws %zu (want %zu)\n", n_in, out_size, (size_t)O_END, ws_size, (size_t)WS_END); grid = -1; return; }
        int dev = 0, cus = 0, per_cu = 0;
        (void)hipGetDevice(&dev); (void)hipDeviceGetAttribute(&cus, hipDeviceAttributeMultiprocessorCount, dev);
        if (hipFuncSetAttribute((const void*)mk_fwd, hipFuncAttributeMaxDynamicSharedMemorySize, LDS_BYTES) != hipSuccess) { fprintf(stderr, "kernel_launch: hipFuncSetAttribute failed\n"); grid = -1; return; }
        if (hipOccupancyMaxActiveBlocksPerMultiprocessor(&per_cu, (const void*)mk_fwd, NTHREADS, LDS_BYTES) != hipSuccess || per_cu < 1) { fprintf(stderr, "kernel_launch: occupancy query says %d blocks per CU\n", per_cu); (void)hipGetLastError(); grid = -1; return; }
        grid = (cus > 0 ? cus : 256);
    }
    if (grid < 0) return;
    (void)hipMemsetAsync((char*)d_ws + WS_CTL, 0, CTL_ZERO_BYTES, stream);
    Params p{};
    for (int i = 0; i < N_IN; ++i) p.in[i] = (const float*)d_in[i];
    p.out = (float*)d_out; p.ws = (unsigned char*)d_ws;
    void* args[] = {&p};
    const hipError_t e = hipLaunchCooperativeKernel((const void*)mk_fwd, dim3(grid), dim3(NTHREADS), args, LDS_BYTES, stream);
    if (e != hipSuccess) fprintf(stderr, "kernel_launch: cooperative launch failed: %s (grid %d)\n", hipGetErrorString(e), grid);
}
```

```cpp
#include <hip/hip_runtime.h>
#include <hip/hip_cooperative_groups.h>
#include <cstdio>
#include <cstdint>
namespace cg = cooperative_groups;

namespace pg8 {
#define PG8_LAS __attribute__((address_space(3)))
typedef unsigned short bf16_t;
typedef short bf16x8 __attribute__((ext_vector_type(8)));
typedef float f32x4 __attribute__((ext_vector_type(4)));
typedef unsigned u32x4 __attribute__((ext_vector_type(4)));
constexpr int BM = 256, BK = 64, HALF = 128, HTB = HALF * BK * 2  , STAGE_BYTES = 8 * HTB, NXCD = 8, WGM = 8;

__host__ __device__ __forceinline__ int lds_byte(int r, int c) { const int st = (r >> 4) * 2 + (c >> 5), rr = r & 15, cc = c & 31, ob = rr * 64 + cc * 2; return st * 1024 + (ob ^ (((ob >> 9) & 1) << 5)); }
__host__ __device__ __forceinline__ void stage_rc(int b, int& R, int& C) { const int st = b / 1024, sb = b % 1024, swz = sb ^ (((sb >> 9) & 1) << 5); R = (st >> 1) * 16 + swz / 64; C = (st & 1) * 32 + (swz % 64) / 2; }
__host__ __device__ __forceinline__ int perm32(int rho) { const int n = rho >> 4, i = rho & 15; return 8 * (i >> 2) + 4 * n + (i & 3); }

struct Unit { int pm, pn; };
struct Gemm { const bf16_t* A; const bf16_t* Bt; int M, N, K; };

struct StaticOrder {
    int nM, nN, nwg, G, c;
    __host__ __device__ void init(int M, int N, int G_, int c_) { nM = M / BM; nN = N / BM; nwg = nM * nN; G = G_; c = c_; }
    __host__ __device__ bool next(int i, Unit& u) const {
        const long L = (long)i * G + c; if (L >= nwg) return false;
        int wgid = (int)L; { const int q = nwg / NXCD, r = nwg % NXCD, xcd = wgid % NXCD, off = wgid / NXCD; wgid = (xcd < r ? xcd * (q + 1) : r * (q + 1) + (xcd - r) * q) + off; }
        const int nig = WGM * nN, gid = wgid / nig, fm = gid * WGM, gsz = (nM - fm) < WGM ? (nM - fm) : WGM;
        u.pm = fm + ((wgid % nig) % gsz); u.pn = (wgid % nig) / gsz; return true;
    }
    __device__ __forceinline__ void a_ready(const Unit&) const {}
    __device__ __forceinline__ void done(const Unit&) const {}
};

template <class Epi, class Sched, bool ALIGN_EPI = false, bool SP2 = false>
__device__ __forceinline__ void gemm_phase(PG8_LAS unsigned char* lds, const Gemm g, const Sched& S, const Epi& E, int tid_in) {
    int tid_ = tid_in; asm volatile("" : "+v"(tid_));
    const int tid = tid_, wid = __builtin_amdgcn_readfirstlane(tid >> 6), lane = tid & 63, wr = wid >> 2, wc = wid & 3, fr = lane & 15, fq = lane >> 4;
    const int K = g.K, nt = K / BK;
    unsigned voffA[2], voffB[2];
#pragma unroll
    for (int i = 0; i < 2; ++i) { int R, C; stage_rc(tid * 16 + i * 8192, R, C); const int Rb = Epi::WIDE ? ((R >> 5) * 64 + perm32(R & 31)) : (Epi::PERM ? ((R & ~31) + perm32(R & 31)) : R);
        voffA[i] = (unsigned)(R * K + C) * 2u; voffB[i] = (unsigned)(Rb * K + C) * 2u; }
    const size_t kstep = (size_t)(BK * 2);
    const size_t hstep = (size_t)HALF * K * 2;
    const size_t hstepB = Epi::WIDE ? (size_t)32 * K * 2 : hstep;
    const size_t tstep = 2 * hstep;
    const unsigned ldsw = (unsigned)wid * 1024u;
    const int aoff = lds_byte(wr * 64 + fr, fq * 8), boff = lds_byte(wc * 32 + fr, fq * 8);
#define PG8_SA(b, h) (((b) * 2 + (h)) * HTB)
#define PG8_SB(b, h) ((4 + (b) * 2 + (h)) * HTB)
#define PG8_STAGE(bufoff, gbase, voff) do { _Pragma("unroll") for (int _i = 0; _i < 2; ++_i) \
        __builtin_amdgcn_global_load_lds((const unsigned*)((const char*)(gbase) + (voff)[_i]), (PG8_LAS unsigned*)(lds + (bufoff) + ldsw + _i * 8192), 16, 0, 0); } while (0)
#define PG8_LDA(dst, b, h) do { _Pragma("unroll") for (int m = 0; m < 4; ++m) _Pragma("unroll") for (int k = 0; k < 2; ++k) dst[m][k] = *(const PG8_LAS bf16x8*)(lds + PG8_SA(b, h) + aoff + m * 2048 + k * 1024); } while (0)
#define PG8_LDB(dst, b, h) do { _Pragma("unroll") for (int n = 0; n < 2; ++n) _Pragma("unroll") for (int k = 0; k < 2; ++k) dst[n][k] = *(const PG8_LAS bf16x8*)(lds + PG8_SB(b, h) + boff + n * 2048 + k * 1024); } while (0)
#define PG8_MMA(ai, bj, At, Bt) do { __builtin_amdgcn_s_setprio(1); _Pragma("unroll") for (int m = 0; m < 4; ++m) _Pragma("unroll") for (int n = 0; n < 2; ++n) _Pragma("unroll") for (int k = 0; k < 2; ++k) \
        acc[ai][bj][m][n] = __builtin_amdgcn_mfma_f32_16x16x32_bf16(Bt[n][k], At[m][k], acc[ai][bj][m][n], 0, 0, 0); __builtin_amdgcn_s_setprio(0); } while (0)
#define PG8_WAIT_V(n) asm volatile("s_waitcnt vmcnt(" #n ")" ::: "memory")
#define PG8_WAIT_L(n) asm volatile("s_waitcnt lgkmcnt(" #n ")" ::: "memory")
#define PG8_BAR __builtin_amdgcn_s_barrier()
#define PG8_SCHED __builtin_amdgcn_sched_barrier(0)
    Unit cur, nxt; int ui = 0;
    if (!S.next(0, cur)) return;
    f32x4 acc[2][2][4][2];
#pragma unroll
    for (int a = 0; a < 2; ++a)
#pragma unroll
        for (int b = 0; b < 2; ++b)
#pragma unroll
            for (int m = 0; m < 4; ++m)
#pragma unroll
                for (int n = 0; n < 2; ++n) acc[a][b][m][n] = (f32x4){0.f, 0.f, 0.f, 0.f};
    bf16x8 At[4][2], B0[2][2], B1[2][2];
    const char* cA = (const char*)g.A + (size_t)cur.pm * tstep; const char* cB = (const char*)g.Bt + (size_t)cur.pn * tstep;
    S.a_ready(cur);
    if constexpr (SP2) {
        PG8_STAGE(PG8_SB(0, 0), cB, voffB); PG8_STAGE(PG8_SB(0, 1), cB + hstepB, voffB); PG8_STAGE(PG8_SA(0, 0), cA, voffA); PG8_STAGE(PG8_SA(0, 1), cA + hstep, voffA);
        if (wr == 1) PG8_BAR;
        PG8_WAIT_V(2); PG8_BAR;
        PG8_STAGE(PG8_SB(1, 0), cB + kstep, voffB); PG8_STAGE(PG8_SA(1, 0), cA + kstep, voffA); PG8_STAGE(PG8_SB(1, 1), cB + hstepB + kstep, voffB);
        PG8_WAIT_V(6); PG8_BAR;
    } else {
        PG8_STAGE(PG8_SB(0, 0), cB, voffB); PG8_STAGE(PG8_SA(0, 0), cA, voffA); PG8_STAGE(PG8_SB(0, 1), cB + hstepB, voffB); PG8_STAGE(PG8_SA(0, 1), cA + hstep, voffA);
        if (wr == 1) PG8_BAR;
        PG8_WAIT_V(4); PG8_BAR;
        PG8_STAGE(PG8_SB(1, 0), cB + kstep, voffB); PG8_STAGE(PG8_SA(1, 0), cA + kstep, voffA); PG8_STAGE(PG8_SB(1, 1), cB + hstepB + kstep, voffB);
        PG8_WAIT_V(6); PG8_BAR;
    }
    for (;;) {
        const bool has_next = S.next(ui + 1, nxt);
        const char* nA = has_next ? (const char*)g.A + (size_t)nxt.pm * tstep : cA; const char* nB = has_next ? (const char*)g.Bt + (size_t)nxt.pn * tstep : cB;
        for (int t = 0; t < nt; t += 2) {
            const bool last = (t == nt - 2);
            const char* a1 = cA + (size_t)(t + 1) * kstep;
            const char* a2 = last ? nA : cA + (size_t)(t + 2) * kstep; const char* b2 = last ? nB : cB + (size_t)(t + 2) * kstep;
            const char* a3 = a2 + kstep; const char* b3 = b2 + kstep;
            if (last && has_next) S.a_ready(nxt);
            if constexpr (SP2) {
            PG8_LDB(B0, 0, 0); PG8_LDB(B1, 0, 1); PG8_SCHED; PG8_LDA(At, 0, 0); PG8_STAGE(PG8_SA(1, 1), a1 + hstep, voffA);
            PG8_WAIT_V(8); PG8_WAIT_L(0); PG8_BAR; PG8_MMA(0, 0, At, B0); PG8_MMA(0, 1, At, B1); PG8_BAR; PG8_SCHED;
            PG8_LDA(At, 0, 1); PG8_STAGE(PG8_SB(0, 0), b2, voffB); PG8_STAGE(PG8_SB(0, 1), b2 + hstepB, voffB); PG8_STAGE(PG8_SA(0, 0), a2, voffA);
            PG8_WAIT_V(8); PG8_WAIT_L(0); PG8_BAR; PG8_MMA(1, 0, At, B0); PG8_MMA(1, 1, At, B1); PG8_BAR; PG8_SCHED;
            PG8_LDB(B0, 1, 0); PG8_LDB(B1, 1, 1); PG8_SCHED; PG8_LDA(At, 1, 0); PG8_STAGE(PG8_SA(0, 1), a2 + hstep, voffA);
            PG8_WAIT_V(8); PG8_WAIT_L(0); PG8_BAR; PG8_MMA(0, 0, At, B0); PG8_MMA(0, 1, At, B1); PG8_BAR; PG8_SCHED;
            PG8_LDA(At, 1, 1); PG8_STAGE(PG8_SB(1, 0), b3, voffB); PG8_STAGE(PG8_SB(1, 1), b3 + hstepB, voffB); PG8_STAGE(PG8_SA(1, 0), a3, voffA);
            PG8_WAIT_V(8); PG8_WAIT_L(0); PG8_BAR; PG8_MMA(1, 0, At, B0); PG8_MMA(1, 1, At, B1); PG8_BAR; PG8_SCHED;
            } else {
            PG8_LDB(B0, 0, 0); PG8_SCHED; PG8_LDA(At, 0, 0); PG8_STAGE(PG8_SA(1, 1), a1 + hstep, voffA);
            PG8_WAIT_L(8); PG8_BAR; PG8_WAIT_L(0); PG8_MMA(0, 0, At, B0); PG8_BAR; PG8_SCHED;
            PG8_LDB(B1, 0, 1); PG8_STAGE(PG8_SB(0, 0), b2, voffB);
            PG8_BAR; PG8_WAIT_L(0); PG8_MMA(0, 1, At, B1); PG8_BAR;
            PG8_LDA(At, 0, 1); PG8_STAGE(PG8_SA(0, 0), a2, voffA);
            PG8_BAR; PG8_WAIT_L(0); PG8_MMA(1, 0, At, B0); PG8_BAR; PG8_SCHED;
            PG8_STAGE(PG8_SB(0, 1), b2 + hstepB, voffB);
            PG8_WAIT_V(6); PG8_BAR; PG8_MMA(1, 1, At, B1); PG8_BAR;
            PG8_LDB(B0, 1, 0); PG8_SCHED; PG8_LDA(At, 1, 0); PG8_STAGE(PG8_SA(0, 1), a2 + hstep, voffA);
            PG8_WAIT_L(8); PG8_BAR; PG8_WAIT_L(0); PG8_MMA(0, 0, At, B0); PG8_BAR; PG8_SCHED;
            PG8_LDB(B1, 1, 1); PG8_STAGE(PG8_SB(1, 0), b3, voffB);
            PG8_BAR; PG8_WAIT_L(0); PG8_MMA(0, 1, At, B1); PG8_BAR;
            PG8_LDA(At, 1, 1); PG8_STAGE(PG8_SA(1, 0), a3, voffA);
            PG8_BAR; PG8_WAIT_L(0); PG8_MMA(1, 0, At, B0); PG8_BAR; PG8_SCHED;
            PG8_STAGE(PG8_SB(1, 1), b3 + hstepB, voffB);
            PG8_WAIT_V(6); PG8_BAR; PG8_MMA(1, 1, At, B1); PG8_BAR;
            }
        }
        if constexpr (ALIGN_EPI) { if (wr == 0) PG8_BAR; }
        if constexpr (!Epi::AFTER_DRAIN) { E(acc, cur, wr, wc, fr, fq); S.done(cur); }
        if (!has_next) break;
#pragma unroll
        for (int a = 0; a < 2; ++a)
#pragma unroll
            for (int b = 0; b < 2; ++b)
#pragma unroll
                for (int m = 0; m < 4; ++m)
#pragma unroll
                    for (int n = 0; n < 2; ++n) acc[a][b][m][n] = (f32x4){0.f, 0.f, 0.f, 0.f};
        cur = nxt; cA = nA; cB = nB; ++ui;
        if constexpr (ALIGN_EPI) { if (wr == 1) PG8_BAR; }
    }
    PG8_WAIT_V(0);
    if constexpr (!ALIGN_EPI) { if (wr == 0) PG8_BAR; }
    PG8_BAR;
    if constexpr (Epi::AFTER_DRAIN) { E.fused(acc, cur, wr, wc, fr, fq, lds, wid, lane); S.done(cur); }
#undef PG8_SA
#undef PG8_SB
#undef PG8_STAGE
#undef PG8_LDA
#undef PG8_LDB
#undef PG8_MMA
#undef PG8_WAIT_V
#undef PG8_WAIT_L
#undef PG8_BAR
#undef PG8_SCHED
}
}

#define LAS __attribute__((address_space(3)))
#define DEVI __device__ __forceinline__
typedef unsigned short bf16_t;
typedef float f32x4 __attribute__((ext_vector_type(4)));
typedef unsigned u32x4 __attribute__((ext_vector_type(4)));
typedef unsigned u32x2 __attribute__((ext_vector_type(2)));
typedef short bf16x8_t __attribute__((ext_vector_type(8)));

constexpr int DM = 1024, TSEQ = 8192, NPR = 16384  , NSR = 128  , NTOK = NPR + NSR, MPAD = 16640  ;
constexpr int DIN = 3336, NZ = 3584, FF = 4096, NH = 4, DH = 64, NLAYER = 2, WB = 2048, DECB = 32, DECT = 4;
constexpr float EPSN = 1e-6f, NEGV = -1e30f;
constexpr int ZC_AQ = 0, ZC_AK = 256, ZC_AV = 512, ZC_BQ = 768, ZC_BK = 1024, ZC_BV = 1280, ZC_BO = 1536, ZC_CU = 1792, ZC_CV = 2048, ZC_DQ = 2304, ZC_DF = 2560, ZC_DI = 2816, ZC_DG = 3072;
constexpr int SRC_GATE = 1792, ZC_GI = 3328, ZC_GF = 3332;
enum { I_XP = 0, I_XS, I_CK, I_CV, I_MC, I_MN, I_MM, I_HS, I_RB, I_WIN, I_WOUT, I_GATTN, I_GMLP, I_WUP, I_WDN, I_BI, I_BF, I_GML, I_GCV, I_WS, I_BS, I_LB, I_GHG, I_GFIN, N_IN };
constexpr size_t O_YP = 0, O_YS = O_YP + (size_t)NPR * DM, O_KWP = O_YS + (size_t)NSR * DM, O_VWP = O_KWP + (size_t)NLAYER * 2 * WB * 256, O_KWS = O_VWP + (size_t)NLAYER * 2 * WB * 256,
                 O_VWS = O_KWS + (size_t)NLAYER * DECB * WB * 256, O_CP = O_VWS + (size_t)NLAYER * DECB * WB * 256, O_NP = O_CP + (size_t)NLAYER * 2 * NH * 4096, O_MP = O_NP + (size_t)NLAYER * 2 * NH * 64,
                 O_CS = O_MP + (size_t)NLAYER * 2 * NH, O_NS = O_CS + (size_t)NLAYER * DECB * NH * 4096, O_MS = O_NS + (size_t)NLAYER * DECB * NH * 64, O_SP = O_MS + (size_t)NLAYER * DECB * NH,
                 O_SS = O_SP + (size_t)NLAYER * 2 * NH * 4096, O_CVS = O_SS + (size_t)NLAYER * DECB * NH * 4096, O_END = O_CVS + (size_t)NLAYER * DECB * DECT * 256;
constexpr size_t MiB = 1u << 20;
constexpr size_t WS_CTL = 0, CTL_ZERO_BYTES = 64 * 1024;
constexpr size_t WS_WIN = 1 * MiB, WS_WOUT = 15 * MiB, WS_WUP = 19 * MiB, WS_WDN = 35 * MiB;
constexpr size_t WS_XN = 51 * MiB;
constexpr size_t WS_SMALL = 84 * MiB;
constexpr size_t WS_Z = 86 * MiB, WS_MIX = 200 * MiB, WS_H = WS_Z;
constexpr size_t WS_X1 = 233 * MiB, WS_X2 = 298 * MiB;
constexpr size_t WS_MU = 363 * MiB, WS_MCS = 372 * MiB, WS_HU = 381 * MiB, WS_HSS = 390 * MiB, WS_END = 399 * MiB;
static_assert(WS_Z + (size_t)MPAD * NZ * 2 <= WS_MIX && WS_MIX + (size_t)MPAD * DM * 2 <= WS_X1 && WS_H + (size_t)MPAD * FF * 2 <= WS_X1, "ws map");
static_assert(WS_WIN + 2 * (size_t)NZ * DM * 2 <= WS_WOUT && WS_XN + (size_t)MPAD * DM * 2 <= WS_SMALL, "ws map 2");
constexpr int CONV_ITEMS_WIN = 16 * ((3328 + 32) / 32);
constexpr int CONV_ITEMS_PER_LAYER = 16 * ((3328 + 32) / 32) + 16 * 32 + 16 * (4096 / 32) + 64 * 32;
constexpr size_t SM_SSQ = 0, SM_BT = 1280 * 1024;
constexpr int NCHUNK = 64, NITEM_REC = 2 * NH * NCHUNK;
constexpr size_t REC_N_OFF = (size_t)NITEM_REC * 4096 * 4, REC_M_OFF = REC_N_OFF + (size_t)NITEM_REC * 64 * 4, REC_B_OFF = REC_M_OFF + (size_t)NITEM_REC * 4;
static_assert(REC_B_OFF + NITEM_REC * 4 <= 9 * MiB, "rec scratch");

constexpr int LDS_BYTES = 148480, NTHREADS = 512, EPI_STG = 131072;
#ifndef REP_ATT
#define REP_ATT 1
#endif
#ifndef REP_GMLP
#define REP_GMLP 1
#endif
#ifndef REP_STATE
#define REP_STATE 1
#endif
#ifndef REP_OUT
#define REP_OUT 1
#endif
#ifndef REP_COPY
#define REP_COPY 1
#endif
#ifndef REP_SATT
#define REP_SATT 1
#endif
#ifndef REP_SREC
#define REP_SREC 1
#endif


struct Params { const float* in[N_IN]; float* out; unsigned char* ws; int ph_lo, ph_hi; };

DEVI float bf2f(unsigned v) { return __uint_as_float(v << 16); }
DEVI unsigned pk2(float lo, float hi) { unsigned r; asm("v_cvt_pk_bf16_f32 %0, %1, %2" : "=v"(r) : "v"(lo), "v"(hi)); return r; }
DEVI unsigned f2bf(float f) { return pk2(f, 0.f) & 0xffffu; }
DEVI float bflo(unsigned u) { return __uint_as_float(u << 16); }
DEVI float bfhi(unsigned u) { return __uint_as_float(u & 0xffff0000u); }
DEVI void unpack8(const u32x4 u, float* f) { f[0] = bflo(u.x); f[1] = bfhi(u.x); f[2] = bflo(u.y); f[3] = bfhi(u.y); f[4] = bflo(u.z); f[5] = bfhi(u.z); f[6] = bflo(u.w); f[7] = bfhi(u.w); }
DEVI int lane_opaque() { unsigned z = 0u; asm volatile("" : "+s"(z)); return (int)__builtin_amdgcn_mbcnt_hi(~0u, __builtin_amdgcn_mbcnt_lo(~0u, z)); }
DEVI float shfl_xor_f(float v, int m) {
    const unsigned b = __builtin_bit_cast(unsigned, v);
    if (m == 32) { const auto r = __builtin_amdgcn_permlane32_swap(b, b, false, false); return __builtin_bit_cast(float, (lane_opaque() & 32) ? r[0] : r[1]); }
    if (m == 16) { const auto r = __builtin_amdgcn_permlane16_swap(b, b, false, false); return __builtin_bit_cast(float, (lane_opaque() & 16) ? r[0] : r[1]); }
    return __builtin_bit_cast(float, __builtin_amdgcn_ds_bpermute((lane_opaque() ^ m) << 2, __builtin_bit_cast(int, v)));
}
DEVI float shfl_up_f(float v, int o) { const int l = lane_opaque(); const int s = l - o; return __builtin_bit_cast(float, __builtin_amdgcn_ds_bpermute((s < 0 ? l : s) << 2, __builtin_bit_cast(int, v))); }
typedef short v4i16_t __attribute__((ext_vector_type(4)));
template <int PITCH = 144> DEVI bf16x8_t lds_tfrag(const LAS unsigned char* stage, int ks, int col, int gq) {
    const int i = col & 15, q = i >> 2, p = i & 3;
    const LAS unsigned char* a0 = stage + (32 * ks + 4 * gq + q) * PITCH + ((col - i) + 4 * p) * 2;
    const v4i16_t lo = __builtin_amdgcn_ds_read_tr16_b64_v4i16((LAS v4i16_t*)a0), hi = __builtin_amdgcn_ds_read_tr16_b64_v4i16((LAS v4i16_t*)(a0 + 16 * PITCH));
    return (bf16x8_t){lo[0], lo[1], lo[2], lo[3], hi[0], hi[1], hi[2], hi[3]};
}
DEVI float wave_sum(float v) {
#pragma unroll
    for (int o = 1; o < 64; o <<= 1) v += shfl_xor_f(v, o);
    return v;
}
DEVI float wave_max(float v) {
#pragma unroll
    for (int o = 1; o < 64; o <<= 1) v = fmaxf(v, shfl_xor_f(v, o));
    return v;
}
DEVI float sum8(float v) {
    v += __builtin_bit_cast(float, __builtin_amdgcn_update_dpp(0, __builtin_bit_cast(int, v), 0xB1, 0xF, 0xF, true));
    v += __builtin_bit_cast(float, __builtin_amdgcn_update_dpp(0, __builtin_bit_cast(int, v), 0x4E, 0xF, 0xF, true));
    v += __builtin_bit_cast(float, __builtin_amdgcn_update_dpp(0, __builtin_bit_cast(int, v), 0x141, 0xF, 0xF, true));
    return v;
}
DEVI float sum16(float v) {
    v = sum8(v);
    v += __builtin_bit_cast(float, __builtin_amdgcn_update_dpp(0, __builtin_bit_cast(int, v), 0x140, 0xF, 0xF, true));
    return v;
}
DEVI float frcp(float x) { return __builtin_amdgcn_rcpf(x); }
DEVI float sigmoidf_(float x) { return frcp(1.0f + __expf(-x)); }
DEVI float log1pexp_neg(float a) { return __logf(1.0f + __expf(-a)); }
DEVI float log_sigmoid(float x) { return fminf(x, 0.f) - log1pexp_neg(fabsf(x)); }
DEVI float gelu_tanh(float x) { const float u = 0.7978845608028654f * (x + 0.044715f * x * x * x); return x * frcp(1.0f + __expf(-2.0f * u)); }

#define GAS __attribute__((address_space(1)))
struct InPtrs { GAS const float* const __attribute__((address_space(4)))* p; DEVI const float* operator[](int i) const { return (const float*)p[i]; } };
struct ParamsDev { GAS const float* in[N_IN]; GAS float* out; GAS unsigned char* ws; int ph_lo, ph_hi; };
struct Ctx {
    InPtrs in; float* out; unsigned char* ws;
    LAS unsigned char* lds; int tid, lane, wave, G, bid;
    DEVI bf16_t* Z() const { return (bf16_t*)(ws + WS_Z); }
    DEVI bf16_t* MIX() const { return (bf16_t*)(ws + WS_MIX); }
    DEVI bf16_t* Hb() const { return (bf16_t*)(ws + WS_H); }
    DEVI bf16_t* X1() const { return (bf16_t*)(ws + WS_X1); }
    DEVI bf16_t* X2() const { return (bf16_t*)(ws + WS_X2); }
    DEVI float* SSQ() const { return (float*)(ws + WS_SMALL + SM_SSQ); }
    DEVI float* BT() const { return (float*)(ws + WS_SMALL + SM_BT); }
};

DEVI Ctx relaunder(const Ctx& c0) {
    Ctx c = c0; int t = c0.wave * 64 + lane_opaque(); asm volatile("" : "+v"(t)); c.tid = t; c.lane = t & 63; c.wave = c0.wave;
    auto inp = c0.in.p; asm volatile("" : "+s"(inp)); c.in.p = inp; GAS unsigned char* w = (GAS unsigned char*)c0.ws; asm volatile("" : "+s"(w)); c.ws = (unsigned char*)w; GAS float* o = (GAS float*)c0.out; asm volatile("" : "+s"(o)); c.out = (float*)o; return c;
}
constexpr int CW_QUEUE = 4096;
#define RLX_AGENT __ATOMIC_RELAXED, __HIP_MEMORY_SCOPE_AGENT
DEVI void wt_f32(float* p, float v) { __hip_atomic_store((GAS unsigned*)p, __float_as_uint(v), RLX_AGENT); }
DEVI void handoff_publish(const Ctx& c, unsigned* ctr) {
    asm volatile("s_waitcnt vmcnt(0)" ::: "memory");
    __syncthreads();
    if (c.wave == 0 && lane_opaque() == 0) (void)__hip_atomic_fetch_add((GAS unsigned*)ctr, 1u, RLX_AGENT);
}
DEVI void handoff_wait(const Ctx& c, unsigned* ctr, unsigned want, unsigned* tmo) {
    if (c.wave == 0) {
        if (lane_opaque() == 0) { unsigned sp = 0;
            while (__hip_atomic_load((GAS unsigned*)ctr, RLX_AGENT) < want) { __builtin_amdgcn_s_sleep(1);
                if ((++sp & 255u) == 0u) { if (__hip_atomic_load((GAS unsigned*)tmo, RLX_AGENT)) break; if (sp > (1u << 18)) { (void)__hip_atomic_fetch_add((GAS unsigned*)tmo, 1u, RLX_AGENT); break; } } } }
        __builtin_amdgcn_fence(__ATOMIC_ACQUIRE, "agent");
        asm volatile("s_waitcnt vmcnt(0)" ::: "memory");
    }
    __syncthreads();
}
struct WorkQueue {
    unsigned* ctr; int nxt;
    DEVI void prefetch(const Ctx& c) { int t = 0; if (c.wave == 0 && lane_opaque() == 0) t = (int)__hip_atomic_fetch_add(ctr, 1u, __ATOMIC_RELAXED, __HIP_MEMORY_SCOPE_AGENT); nxt = t; }
    DEVI void start(const Ctx& c, unsigned* counter) { ctr = counter; nxt = 0; prefetch(c); }
    DEVI int pop(const Ctx& c) {
        LAS int* slot = (LAS int*)(c.lds + LDS_BYTES - 32);
        __syncthreads();
        if (c.wave == 0 && lane_opaque() == 0) *slot = nxt;
        __syncthreads();
        return *slot;
    }
};

DEVI float row_rs(const float* ssq, int row) {
    const f32x4* p = (const f32x4*)(ssq + (size_t)row * 16); const f32x4 a = p[0], b = p[1], c2 = p[2], d = p[3];
    const float s = ((a[0] + a[1]) + (a[2] + a[3])) + ((b[0] + b[1]) + (b[2] + b[3])) + ((c2[0] + c2[1]) + (c2[2] + c2[3])) + ((d[0] + d[1]) + (d[2] + d[3]));
    return rsqrtf(s * (1.0f / DM) + EPSN);
}
template <int ACT  > struct EpiRowScaleBf16 {
    static constexpr bool PERM = true, WIDE = true, AFTER_DRAIN = false;
    bf16_t* O; int ldc; const float* ssq; LAS unsigned char* stg;
    __device__ __forceinline__ void operator()(const pg8::f32x4 (&acc)[2][2][4][2], const pg8::Unit& u, int wr, int wc, int fr, int fq) const {
        const int row0 = u.pm * 256 + wr * 64 + fr;
        const int lane = fr + 16 * fq, rr = lane >> 3, sg = lane & 7;
        LAS unsigned char* my = stg + (wr * 4 + wc) * 2048;
        float rsv[2];
#pragma unroll
        for (int j = 0; j < 2; ++j) { const int row = row0 + (fq >> 1) * 128 + (2 * (fq & 1) + j) * 16; rsv[j] = row_rs(ssq, row < NTOK ? row : NTOK - 1); }
        bf16_t* obase = O + (size_t)(u.pm * 256 + wr * 64 + rr) * ldc + u.pn * 256 + wc * 64 + sg * 8;
#pragma unroll
        for (int ai = 0; ai < 2; ++ai)
#pragma unroll
            for (int m = 0; m < 4; ++m) {
                const float s = __builtin_bit_cast(float, __builtin_amdgcn_ds_bpermute((fr + 16 * (2 * ai + (m >> 1))) << 2, __builtin_bit_cast(int, rsv[m & 1])));
#pragma unroll
                for (int bj = 0; bj < 2; ++bj) {
                    pg8::f32x4 v0 = acc[ai][bj][m][0] * s, v1 = acc[ai][bj][m][1] * s;
                    if (ACT == 1) {
#pragma unroll
                        for (int e = 0; e < 4; ++e) { const float a = fmaxf(v0[e], 0.f), b = fmaxf(v1[e], 0.f); v0[e] = a * a; v1[e] = b * b; }
                    }
                    u32x4 w; w.x = pk2(v0[0], v0[1]); w.y = pk2(v0[2], v0[3]); w.z = pk2(v1[0], v1[1]); w.w = pk2(v1[2], v1[3]);
                    *(LAS u32x4*)(my + fr * 128 + (((bj * 4 + fq) ^ (fr & 7)) * 16)) = w;
                }
#pragma unroll
                for (int k = 0; k < 2; ++k) { const int r = rr + 8 * k; const u32x4 w = *(const LAS u32x4*)(my + r * 128 + ((sg ^ (r & 7)) * 16));
                    *(u32x4*)(obase + (size_t)(ai * 128 + m * 16 + 8 * k) * ldc) = w; }
            }
    }
};
struct EpiResidualNorm {
    static constexpr bool PERM = false, WIDE = false, AFTER_DRAIN = false;
    const bf16_t* base; bf16_t* out; float* ssq; LAS unsigned char* stg;
    __device__ __forceinline__ void operator()(const pg8::f32x4 (&acc)[2][2][4][2], const pg8::Unit& u, int wr, int wc, int fr, int fq) const {
        const int lane = fr + 16 * fq, rr = lane >> 3, sg = lane & 7;
        LAS unsigned char* my = stg + (wr * 4 + wc) * 2048;
        const int rbase = u.pm * 256 + wr * 64, cb = u.pn * 256 + wc * 32 + 4 * sg;
        u32x2 pre[4][2][2];
#define RN_LOAD(G) do { _Pragma("unroll") for (int k = 0; k < 2; ++k) _Pragma("unroll") for (int bj = 0; bj < 2; ++bj) \
            pre[(G) & 3][k][bj] = *(const u32x2*)(base + (size_t)(rbase + ((G) >> 2) * 128 + ((G) & 3) * 16 + rr + 8 * k) * DM + cb + bj * 128); } while (0)
        RN_LOAD(0); RN_LOAD(1); RN_LOAD(2); RN_LOAD(3);
        __builtin_amdgcn_sched_barrier(0);
#pragma unroll
        for (int G = 0; G < 8; ++G) {
            const int ai = G >> 2, m = G & 3; float ss[2] = {0.f, 0.f};
#pragma unroll
            for (int bj = 0; bj < 2; ++bj) {
#pragma unroll
                for (int n = 0; n < 2; ++n) *(LAS pg8::f32x4*)(my + fr * 128 + (((n * 4 + fq) ^ (fr & 7)) * 16)) = acc[ai][bj][m][n];
#pragma unroll
                for (int k = 0; k < 2; ++k) { const int r = rr + 8 * k; const pg8::f32x4 v = *(const LAS pg8::f32x4*)(my + r * 128 + ((sg ^ (r & 7)) * 16));
                    const u32x2 pb = pre[G & 3][k][bj]; const pg8::f32x4 x = (pg8::f32x4){bflo(pb.x), bfhi(pb.x), bflo(pb.y), bfhi(pb.y)} + v; const size_t o = (size_t)(rbase + ai * 128 + m * 16 + r) * DM + cb + bj * 128;
                    { u32x2 xb; xb.x = pk2(x[0], x[1]); xb.y = pk2(x[2], x[3]); *(u32x2*)(out + o) = xb; } ss[k] += (x[0] * x[0] + x[1] * x[1]) + (x[2] * x[2] + x[3] * x[3]); }
            }
            if (G + 4 < 8) RN_LOAD(G + 4);
#pragma unroll
            for (int k = 0; k < 2; ++k) { const float s = sum8(ss[k]); if (sg == 0) ssq[(size_t)(rbase + ai * 128 + m * 16 + rr + 8 * k) * 16 + u.pn * 4 + wc] = s; }
        }
#undef RN_LOAD
    }
};

template <class E> DEVI void skinny_gemm(const Ctx& c, const bf16_t* A, const bf16_t* Bt, int N, int K, const E& epi) {
    const int lane = c.lane, fr = lane & 15, gq = lane >> 4, ngrp = N >> 6, total = ngrp * 8, kw = K >> 3;
    LAS float* red = (LAS float*)c.lds;
    bf16x8_t a0[4], b0[4][4], a1[4], b1[4][4];
    const bf16_t* ap = A; const bf16_t* bp = Bt;
#define SK_PTRS(T) { const int ng_ = (T) % ngrp, mg_ = (T) / ngrp; ap = A + (size_t)(mg_ * 16 + fr) * K + c.wave * kw + 8 * gq; bp = Bt + (size_t)(ng_ * 64 + fr) * K + c.wave * kw + 8 * gq; }
#define SK_LOAD(AF, BF, KC) { _Pragma("unroll") for (int s4 = 0; s4 < 4; ++s4) { AF[s4] = *(const bf16x8_t*)(ap + (KC) + 32 * s4); _Pragma("unroll") for (int e = 0; e < 4; ++e) BF[s4][e] = *(const bf16x8_t*)(bp + (size_t)(16 * e) * K + (KC) + 32 * s4); } }
#define SK_MMA(AF, BF) { _Pragma("unroll") for (int s4 = 0; s4 < 4; ++s4) { _Pragma("unroll") for (int e = 0; e < 4; ++e) acc[e] = __builtin_amdgcn_mfma_f32_16x16x32_bf16(BF[s4][e], AF[s4], acc[e], 0, 0, 0); } }
    if (c.bid < total) { SK_PTRS(c.bid); SK_LOAD(a0, b0, 0); }
    for (int task = c.bid; task < total; task += c.G) {
        const int ng = task % ngrp, mg = task / ngrp;
        f32x4 acc[4];
#pragma unroll
        for (int e = 0; e < 4; ++e) acc[e] = (f32x4){0.f, 0.f, 0.f, 0.f};
#pragma unroll 1
        for (int kc = 0; kc < kw; kc += 256) {
            const bool h1 = kc + 128 < kw;
            if (h1) SK_LOAD(a1, b1, kc + 128);
            __builtin_amdgcn_sched_barrier(0);
            SK_MMA(a0, b0);
            __builtin_amdgcn_sched_barrier(0);
            if (h1) {
                if (kc + 256 < kw) SK_LOAD(a0, b0, kc + 256);
                __builtin_amdgcn_sched_barrier(0);
                SK_MMA(a1, b1);
                __builtin_amdgcn_sched_barrier(0);
            }
        }
        if (task + c.G < total) { SK_PTRS(task + c.G); SK_LOAD(a0, b0, 0); }
        __builtin_amdgcn_sched_barrier(0);
        __syncthreads();
#pragma unroll
        for (int e = 0; e < 4; ++e) *(LAS f32x4*)(red + ((c.wave * 4 + e) * 64 + lane) * 4) = acc[e];
        __syncthreads();
        { const int row = c.tid >> 5, cp = c.tid & 31, col = 2 * cp, e = col >> 4, g2 = (col >> 2) & 3, r = col & 3; float s0 = 0.f, s1 = 0.f;
#pragma unroll
          for (int w = 0; w < 8; ++w) { const LAS float* p = red + ((w * 4 + e) * 64 + (g2 * 16 + row)) * 4 + r; s0 += p[0]; s1 += p[1]; }
          float ss = epi.pair(mg * 16 + row, ng * 64 + col, s0, s1);
          ss += shfl_xor_f(ss, 1); ss += shfl_xor_f(ss, 2); ss += shfl_xor_f(ss, 4); ss += shfl_xor_f(ss, 8); ss += shfl_xor_f(ss, 16);
          if (cp == 0) epi.rowsum(mg * 16 + row, ng, ss); }
    }
#undef SK_PTRS
#undef SK_LOAD
#undef SK_MMA
    __syncthreads();
}
struct SkEpiResidualNorm {
    const bf16_t* base; bf16_t* out; float* ssq;
    DEVI float pair(int row, int col, float v0, float v1) const { const size_t o = (size_t)row * DM + col; const unsigned bb = *(const unsigned*)(base + o); const float x0 = bflo(bb) + v0, x1 = bfhi(bb) + v1; *(unsigned*)(out + o) = pk2(x0, x1); return x0 * x0 + x1 * x1; }
    DEVI void rowsum(int row, int slot, float s) const { ssq[(size_t)row * 16 + slot] = s; }
};
struct SkEpiRelu2 { bf16_t* H; const float* ssq;
    DEVI float pair(int row, int col, float v0, float v1) const { const float rs = row_rs(ssq, row); const float a = fmaxf(v0 * rs, 0.f), b = fmaxf(v1 * rs, 0.f); *(unsigned*)(H + (size_t)row * FF + col) = pk2(a * a, b * b); return 0.f; }
    DEVI void rowsum(int, int, float) const {}
};

DEVI void transpose_item(const float* W, int ldw, int src_col0, int K, bf16_t* WT, int dst_row0, LAS float* scr, int k0, int lane, const float* gk) {
    float wv[32];
#pragma unroll
    for (int i = 0; i < 32; ++i) wv[i] = __builtin_nontemporal_load(W + (size_t)(k0 + 2 * i + (lane >> 5)) * ldw + src_col0 + (lane & 31));
#pragma unroll
    for (int i = 0; i < 32; ++i) scr[(2 * i + (lane >> 5)) * 33 + (lane & 31)] = gk ? wv[i] * gk[k0 + 2 * i + (lane >> 5)] : wv[i];
    asm volatile("s_waitcnt lgkmcnt(0)" ::: "memory");
    const int c = lane & 7;
#pragma unroll
    for (int j = 0; j < 4; ++j) { const int n = (lane >> 3) + 8 * j; const LAS float* s = scr + (8 * c) * 33 + n;
        u32x4 o; o.x = pk2(s[0 * 33], s[1 * 33]); o.y = pk2(s[2 * 33], s[3 * 33]); o.z = pk2(s[4 * 33], s[5 * 33]); o.w = pk2(s[6 * 33], s[7 * 33]);
        *(u32x4*)(WT + (size_t)(dst_row0 + n) * K + k0 + 8 * c) = o; }
    asm volatile("s_waitcnt lgkmcnt(0)" ::: "memory");
}
DEVI int rel_bucket(int dist) {
    if (dist < 16) return dist;
    int large = 16 + (int)(log((double)dist / 16.0) / log(128.0) * 16.0);
    large = large < 16 ? 16 : (large > 31 ? 31 : large);
    return large;
}
DEVI void convert_weights(const Ctx& c, int it0, int it1, int wi, int nw) {
    LAS float* scr = (LAS float*)(c.lds + c.wave * 16384);
    constexpr int NZS = 3328 + 32;
    constexpr int I_IN = 16 * (NZS / 32), I_OUT = 16 * 32, I_UP = 16 * (FF / 32), I_DN = 64 * 32, I_L = I_IN + I_OUT + I_UP + I_DN;
    static_assert(I_L == CONV_ITEMS_PER_LAYER, "conversion item count");
    for (int it = it0 + wi; it < it1; it += nw) {
        const int l = it / I_L; int r = it % I_L;
        if (r < I_IN) { const int kb = r / (NZS / 32), nb = r % (NZS / 32), n0 = nb * 32;
            transpose_item(c.in[I_WIN] + (size_t)l * DM * DIN, DIN, n0 == 3328 ? SRC_GATE : n0 + (n0 >= SRC_GATE ? 8 : 0), DM, (bf16_t*)(c.ws + WS_WIN) + (size_t)l * NZ * DM, n0, scr, kb * 64, c.lane, c.in[I_GATTN] + l * DM); continue; }
        r -= I_IN;
        if (r < I_OUT) { const int kb = r / 32, nb = r % 32; transpose_item(c.in[I_WOUT] + (size_t)l * DM * DM, DM, nb * 32, DM, (bf16_t*)(c.ws + WS_WOUT) + (size_t)l * DM * DM, nb * 32, scr, kb * 64, c.lane, nullptr); continue; }
        r -= I_OUT;
        if (r < I_UP) { const int kb = r / (FF / 32), nb = r % (FF / 32); transpose_item(c.in[I_WUP] + (size_t)l * DM * FF, FF, nb * 32, DM, (bf16_t*)(c.ws + WS_WUP) + (size_t)l * FF * DM, nb * 32, scr, kb * 64, c.lane, c.in[I_GMLP] + l * DM); continue; }
        r -= I_UP;
        { const int kb = r / 32, nb = r % 32; transpose_item(c.in[I_WDN] + (size_t)l * FF * DM, DM, nb * 32, FF, (bf16_t*)(c.ws + WS_WDN) + (size_t)l * DM * FF, nb * 32, scr, kb * 64, c.lane, nullptr); }
    }
}
DEVI void phase_prologue(const Ctx& c) {
    const int gw = c.bid * 8 + c.wave, NGW = c.G * 8;
    convert_weights(c, 0, CONV_ITEMS_WIN, gw, NGW);
    for (int idx = c.bid * NTHREADS + c.tid; idx < NLAYER * 224 * (DM / 8); idx += c.G * NTHREADS) { const int l = idx / (224 * (DM / 8)), r = idx % (224 * (DM / 8));
        *(u32x4*)((bf16_t*)(c.ws + WS_WIN) + (size_t)l * NZ * DM + (size_t)3360 * DM + (size_t)r * 8) = (u32x4){0u, 0u, 0u, 0u}; }
    for (int row0 = gw; row0 < NTOK; row0 += 3 * NGW) {
        f32x4 v[3][4];
#pragma unroll
        for (int r = 0; r < 3; ++r) { const int row = row0 + r * NGW < NTOK ? row0 + r * NGW : row0;
            const float* xr = (row < NPR) ? c.in[I_XP] + (size_t)row * DM : c.in[I_XS] + (size_t)(row - NPR) * DM;
#pragma unroll
            for (int j = 0; j < 4; ++j) v[r][j] = __builtin_nontemporal_load((const f32x4*)(xr + 256 * j + 4 * c.lane)); }
        __builtin_amdgcn_sched_barrier(0);
#pragma unroll
        for (int r = 0; r < 3; ++r) { const int row = row0 + r * NGW; if (row < NTOK) {
            float ss = 0.f; u32x2* xb = (u32x2*)(c.X2() + (size_t)row * DM);
#pragma unroll
            for (int j = 0; j < 4; ++j) { ss += (v[r][j][0] * v[r][j][0] + v[r][j][1] * v[r][j][1]) + (v[r][j][2] * v[r][j][2] + v[r][j][3] * v[r][j][3]);
                u32x2 w2; w2.x = pk2(v[r][j][0], v[r][j][1]); w2.y = pk2(v[r][j][2], v[r][j][3]); xb[64 * j + c.lane] = w2; }
            ss = wave_sum(ss);
            if (c.lane < 16) c.SSQ()[(size_t)row * 16 + c.lane] = c.lane == 0 ? ss : 0.f; } }
    }
    {
        for (int i = c.bid * NTHREADS + c.tid; i < 3 * 129 * 4; i += c.G * NTHREADS) { const int h = i & 3, j = (i >> 2) % 129, pat = (i >> 2) / 129; const int d = pat == 0 ? 1 : (pat == 1 ? 4 : 16);
            c.BT()[i] = c.in[I_RB][rel_bucket(j * d) * 4 + h]; }
    }
}

DEVI void attn_sample_qh(const Ctx& c, int layer, int b, int h, int t) {
    const bf16_t* Z = c.Z(); const int lane = c.lane, kg = lane >> 4, c4 = lane & 15;
    const size_t rbase = (size_t)(NPR + b * DECT);
    const size_t qrow = rbase + t;
    LAS float* pl = (LAS float*)(c.lds + c.wave * 1024);
    const u32x2 qu = *(const u32x2*)(Z + qrow * NZ + ZC_AQ + h * 64 + 4 * c4);
    const f32x4 q4 = (f32x4){bflo(qu.x), bfhi(qu.x), bflo(qu.y), bfhi(qu.y)};
    const float* bt = c.BT() + h;
    const float* ck = c.in[I_CK] + ((size_t)(layer * DECB + b) * WB) * 256 + h * 64;
    const float* cv = c.in[I_CV] + ((size_t)(layer * DECB + b) * WB) * 256 + h * 64;
    float Mx = NEGV, wsum = 0.f; f32x4 accv = (f32x4){0.f, 0.f, 0.f, 0.f};
#pragma unroll 1
    for (int pat = 0; pat < 3; ++pat) {
        const int d = 1 << (2 * pat);
        const float* btp = bt + pat * 129 * 4;
        const int pos0 = t - kg * d; const bool isz = pos0 >= 0; const int zp = isz ? pos0 : 0, cp = isz ? -1 : pos0;
        const unsigned loff = (unsigned)((3 - kg) * d * 256 + 4 * c4), loff0 = (unsigned)((WB + cp) * 256 + 4 * c4), loff32 = (unsigned)(4 * c4);
        float lg[33]; f32x4 kv[33];
        const u32x2 uk = *(const u32x2*)(Z + (rbase + zp) * NZ + ZC_AK + h * 64 + 4 * c4);
        kv[0] = *(const f32x4*)(ck + loff0);
#pragma unroll
        for (int it = 1; it < 32; ++it) kv[it] = *(const f32x4*)(ck + (size_t)(WB + t - (4 * it + 3) * d) * 256 + loff);
        kv[32] = *(const f32x4*)(ck + (size_t)(WB + t - 128 * d) * 256 + loff32);
        { const float b0 = btp[lane * 4], b1 = btp[(64 + lane) * 4], b2 = btp[128 * 4]; pl[lane] = b0; pl[64 + lane] = b1; pl[128 + lane] = b2; }
        __builtin_amdgcn_sched_barrier(0);
        kv[0] = (f32x4){isz ? bflo(uk.x) : kv[0][0], isz ? bfhi(uk.x) : kv[0][1], isz ? bflo(uk.y) : kv[0][2], isz ? bfhi(uk.y) : kv[0][3]};
#pragma unroll
        for (int it = 0; it < 33; ++it) {
            const float dot = sum16((q4[0] * kv[it][0] + q4[1] * kv[it][1]) + (q4[2] * kv[it][2] + q4[3] * kv[it][3]));
            lg[it] = (it < 32 || kg == 0) ? dot * 0.125f + pl[4 * it + kg] : NEGV;
        }
        __builtin_amdgcn_sched_barrier(0);
        const u32x2 uv = *(const u32x2*)(Z + (rbase + zp) * NZ + ZC_AV + h * 64 + 4 * c4);
        kv[0] = *(const f32x4*)(cv + loff0);
#pragma unroll
        for (int it = 1; it < 32; ++it) kv[it] = *(const f32x4*)(cv + (size_t)(WB + t - (4 * it + 3) * d) * 256 + loff);
        kv[32] = *(const f32x4*)(cv + (size_t)(WB + t - 128 * d) * 256 + loff32);
        __builtin_amdgcn_sched_barrier(0);
        float m = lg[0];
#pragma unroll
        for (int it = 1; it < 33; ++it) m = fmaxf(m, lg[it]);
        m = fmaxf(m, shfl_xor_f(m, 16)); m = fmaxf(m, shfl_xor_f(m, 32));
        float den = 0.f;
#pragma unroll
        for (int it = 0; it < 33; ++it) { lg[it] = __expf(lg[it] - m); den += lg[it]; }
        den += shfl_xor_f(den, 16); den += shfl_xor_f(den, 32);
        __builtin_amdgcn_sched_barrier(0);
        f32x4 o4 = (f32x4){isz ? bflo(uv.x) : kv[0][0], isz ? bfhi(uv.x) : kv[0][1], isz ? bflo(uv.y) : kv[0][2], isz ? bfhi(uv.y) : kv[0][3]} * lg[0];
#pragma unroll
        for (int it = 1; it < 33; ++it) o4 += kv[it] * lg[it];
#pragma unroll
        for (int e = 0; e < 4; ++e) { o4[e] += shfl_xor_f(o4[e], 16); o4[e] += shfl_xor_f(o4[e], 32); }
        const float lse = m + __logf(den), Mn = fmaxf(Mx, lse), sc = __expf(Mx - Mn), wp = __expf(lse - Mn);
        accv = accv * sc + o4 * (wp / den); wsum = wsum * sc + wp; Mx = Mn;
    }
    if (kg == 0) { const f32x4 r = accv * (1.0f / wsum); u32x2 w; w.x = pk2(r[0], r[1]); w.y = pk2(r[2], r[3]); *(u32x2*)(c.MIX() + qrow * DM + h * 64 + 4 * c4) = w; }
}

constexpr int AT_LBW = 192;
constexpr int AT_OA = 0, AT_LM = 65536, AT_LW = AT_LM + 1024, AT_LB = AT_LW + 1024, AT_VS = AT_LB + 3 * AT_LBW * 4, AT_VS_WAVE = 32 * 144;
static_assert(AT_VS % 16 == 0 && AT_VS + 8 * AT_VS_WAVE <= LDS_BYTES - 64, "attention LDS map");
DEVI void attn_block_item(const Ctx& c, int layer, int b, int h, int blk, WorkQueue& q) {
    const int lane = c.lane, i = lane & 15, gq = lane >> 4;
    LAS float* OA = (LAS float*)(c.lds + AT_OA); LAS float* LM = (LAS float*)(c.lds + AT_LM); LAS float* LW = (LAS float*)(c.lds + AT_LW); LAS float* LB = (LAS float*)(c.lds + AT_LB);
    LAS unsigned char* VS = c.lds + AT_VS + c.wave * AT_VS_WAVE;
    __syncthreads();
    for (int idx = c.tid; idx < 3 * AT_LBW; idx += NTHREADS) { const int pat = idx / AT_LBW, x = idx % AT_LBW - 16, j = 128 - x; LB[idx] = (j >= 0 && j <= 128) ? 1.4426950408889634f * c.BT()[(pat * 129 + j) * 4 + h] : 0.f; }
    __syncthreads();
    const int base = blk * 256;
    const char* zb = (const char*)(c.Z() + (size_t)b * TSEQ * NZ + h * 64);
#define AT_T0(PAT, TK) (base + ((PAT) == 0 ? 16 * (TK) : ((PAT) == 1 ? 64 * ((TK) >> 2) + ((TK) & 3) : (TK))))
    bf16x8_t qf[2], kfr[9][2];
#define AT_KQLOAD(PAT, TK) do { const int d_ = 1 << (2 * (PAT)), t0_ = AT_T0(PAT, TK); const unsigned lk_ = (unsigned)((d_ * i * NZ + 8 * gq) * 2); \
        { const char* qb = zb + ((size_t)(unsigned)t0_ * NZ + ZC_AQ) * 2; qf[0] = *(const bf16x8_t*)(qb + lk_); qf[1] = *(const bf16x8_t*)(qb + lk_ + 64); } \
        _Pragma("unroll") for (int kt = 0; kt < 9; ++kt) { int u_ = t0_ + d_ * (16 * kt - 128); u_ = u_ < 0 ? 0 : u_;     \
            const char* kb = zb + ((size_t)(unsigned)u_ * NZ + ZC_AK) * 2; kfr[kt][0] = *(const bf16x8_t*)(kb + lk_); kfr[kt][1] = *(const bf16x8_t*)(kb + lk_ + 64); } } while (0)
    AT_KQLOAD(0, c.wave);
#pragma unroll 1
    for (int ti = 0; ti < 6; ++ti) {
        {
            const int pat = ti >> 1, tk = c.wave + 8 * (ti & 1), d = 1 << (2 * pat);
            const int t0 = AT_T0(pat, tk);
            const int tq = t0 + d * i;
            const int kmin = 128 - (t0 >> (2 * pat));
            const int vrow0 = lane >> 3;
            u32x4 vr[5][4];
            const unsigned lv = (unsigned)((d * vrow0 * NZ + 8 * (lane & 7)) * 2);
#define AT_VLOAD(S5) do { _Pragma("unroll") for (int n = 0; n < ((S5) == 4 ? 2 : 4); ++n) { int uv = t0 + d * (32 * (S5) + 8 * n - 128); uv = uv < 0 ? 0 : uv;     \
                vr[(S5)][n] = *(const u32x4*)(zb + ((size_t)(unsigned)uv * NZ + ZC_AV) * 2 + lv); } } while (0)
            AT_VLOAD(0); AT_VLOAD(1); AT_VLOAD(2); AT_VLOAD(3); AT_VLOAD(4);
            __builtin_amdgcn_sched_barrier(0);
            f32x4 s[10];
#pragma unroll
            for (int kt = 0; kt < 9; ++kt) {
                f32x4 a = (f32x4){0.f, 0.f, 0.f, 0.f};
                a = __builtin_amdgcn_mfma_f32_16x16x32_bf16(kfr[kt][0], qf[0], a, 0, 0, 0);
                a = __builtin_amdgcn_mfma_f32_16x16x32_bf16(kfr[kt][1], qf[1], a, 0, 0, 0);
                s[kt] = a;
            }
            s[9] = (f32x4){0.f, 0.f, 0.f, 0.f};
            const LAS float* lb = LB + pat * AT_LBW + 16 + 4 * gq - i;
            float mx = NEGV;
#pragma unroll
            for (int half = 0; half < 2; ++half) {
                float bz[5][4];
#pragma unroll
                for (int k5 = 0; k5 < 5; ++k5) { const int kt = 5 * half + k5; if (kt < 9) {
#pragma unroll
                    for (int r = 0; r < 4; ++r) bz[k5][r] = lb[16 * kt + r]; } }
                __builtin_amdgcn_sched_barrier(0);
#pragma unroll
                for (int k5 = 0; k5 < 5; ++k5) { const int kt = 5 * half + k5; if (kt < 9) {
#pragma unroll
                    for (int r = 0; r < 4; ++r) {
                        const bool valid = kt == 0 ? (kmin <= 0 && 4 * gq + r >= i) : (kt == 8 ? (4 * gq + r <= i) : (16 * kt >= kmin));
                        const float lg = valid ? s[kt][r] * (0.125f * 1.4426950408889634f) + bz[k5][r] : NEGV;
                        s[kt][r] = lg; mx = fmaxf(mx, lg);
                    } } }
                __builtin_amdgcn_sched_barrier(0);
            }
            mx = fmaxf(mx, shfl_xor_f(mx, 16)); mx = fmaxf(mx, shfl_xor_f(mx, 32));
            float den = 0.f;
#pragma unroll
            for (int kt = 0; kt < 9; ++kt)
#pragma unroll
                for (int r = 0; r < 4; ++r) { const float pv = __builtin_amdgcn_exp2f(s[kt][r] - mx); s[kt][r] = pv; den += pv; }
            den += shfl_xor_f(den, 16); den += shfl_xor_f(den, 32);
            u32x4 pf[5];
#pragma unroll
            for (int s5 = 0; s5 < 5; ++s5) { pf[s5].x = pk2(s[2 * s5][0], s[2 * s5][1]); pf[s5].y = pk2(s[2 * s5][2], s[2 * s5][3]); pf[s5].z = pk2(s[2 * s5 + 1][0], s[2 * s5 + 1][1]); pf[s5].w = pk2(s[2 * s5 + 1][2], s[2 * s5 + 1][3]); }
            f32x4 o[4];
#pragma unroll
            for (int dt = 0; dt < 4; ++dt) o[dt] = (f32x4){0.f, 0.f, 0.f, 0.f};
#pragma unroll
            for (int s5 = 0; s5 < 5; ++s5) {
                __builtin_amdgcn_sched_barrier(0);
                if (s5 == 2 && ti == 5) q.prefetch(c);
                if (s5 == 2 && ti + 1 < 6) { const int np_ = (ti + 1) >> 1, ntk_ = c.wave + 8 * ((ti + 1) & 1); AT_KQLOAD(np_, ntk_); }
#pragma unroll
                for (int n = 0; n < 4; ++n) *(LAS u32x4*)(VS + (vrow0 + 8 * n) * 144 + (lane & 7) * 16) = (s5 == 4 && n >= 2) ? vr[4][n - 2] : vr[s5][n];
#pragma unroll
                for (int dt = 0; dt < 4; ++dt) {
                    union { u32x4 u; bf16x8_t v; } pp; pp.u = pf[s5];
                    o[dt] = __builtin_amdgcn_mfma_f32_16x16x32_bf16(lds_tfrag<144>(VS, 0, 16 * dt + i, gq), pp.v, o[dt], 0, 0, 0);
                }
            }
#undef AT_VLOAD
            const float inv = frcp(den), lse = mx + __builtin_amdgcn_logf(den); const int tok = tq - base;
            if (pat == 0) {
#pragma unroll
                for (int dt = 0; dt < 4; ++dt) *(LAS f32x4*)(OA + tok * 64 + 16 * dt + 4 * gq) = o[dt] * inv;
                if (gq == 0) { LM[tok] = lse; LW[tok] = 1.0f; }
            } else {
                const float Mo = LM[tok], Wo = LW[tok]; const float Mn = fmaxf(Mo, lse), sc = __builtin_amdgcn_exp2f(Mo - Mn), wl = __builtin_amdgcn_exp2f(lse - Mn), wp = wl * inv; const float wn = Wo * sc + wl;
                if (pat == 1) {
#pragma unroll
                    for (int dt = 0; dt < 4; ++dt) o[dt] = (*(const LAS f32x4*)(OA + tok * 64 + 16 * dt + 4 * gq)) * sc + o[dt] * wp;
#pragma unroll
                    for (int dt = 0; dt < 4; ++dt) *(LAS f32x4*)(OA + tok * 64 + 16 * dt + 4 * gq) = o[dt];
                    asm volatile("s_waitcnt lgkmcnt(0)" ::: "memory");
                    if (gq == 0) { LM[tok] = Mn; LW[tok] = wn; }
                } else {
                    const float rw = frcp(wn);
#pragma unroll
                    for (int dt = 0; dt < 4; ++dt) o[dt] = ((*(const LAS f32x4*)(OA + tok * 64 + 16 * dt + 4 * gq)) * sc + o[dt] * wp) * rw;
#pragma unroll
                    for (int dt = 0; dt < 4; ++dt) { const f32x4 r = o[dt];
                        u32x2 w; w.x = pk2(r[0], r[1]); w.y = pk2(r[2], r[3]); *(u32x2*)(c.MIX() + ((size_t)b * TSEQ + tq) * DM + h * 64 + 16 * dt + 4 * gq) = w; }
                }
            }
        }
        if (ti & 1) __syncthreads();
    }
#undef AT_KQLOAD
#undef AT_T0
}

DEVI void gmlp_item(const Ctx& c, int layer, size_t row0, int nrows, float* chunk_v_out) {
    LAS float* vr = (LAS float*)c.lds;
    const bf16_t* Z = c.Z(); const int lane = c.lane;
    const float* gcv = c.in[I_GCV] + layer * 256;
    __syncthreads();
    for (int r = c.wave; r < nrows; r += 8) {
        const u32x2 u = *(const u32x2*)(Z + (row0 + r) * NZ + ZC_CV + 4 * lane);
        float e0 = gelu_tanh(bflo(u.x)), e1 = gelu_tanh(bfhi(u.x)), e2 = gelu_tanh(bflo(u.y)), e3 = gelu_tanh(bfhi(u.y));
        const float ss = wave_sum((e0 * e0 + e1 * e1) + (e2 * e2 + e3 * e3));
        const float rs = rsqrtf(ss * (1.0f / 256.0f) + EPSN);
        const f32x4 gv = *(const f32x4*)(gcv + 4 * lane);
        f32x4 o; o[0] = e0 * rs * gv[0]; o[1] = e1 * rs * gv[1]; o[2] = e2 * rs * gv[2]; o[3] = e3 * rs * gv[3];
        *(LAS f32x4*)(vr + r * 260 + 4 * lane) = o;
        if (chunk_v_out) *(f32x4*)(chunk_v_out + (size_t)r * 256 + 4 * lane) = o;
    }
    __syncthreads();
    const int t = c.tid >> 2, hh = c.tid & 3;
    const float* wrow = c.in[I_WS] + ((size_t)(layer * NH + hh) * 128 + t) * 128;
    int smax = c.wave * 16 + 15; if (smax > nrows - 1) smax = nrows - 1;
    const float bsv = (t < nrows) ? c.in[I_BS][(layer * NH + hh) * 128 + t] : 0.f;
#pragma unroll 1
    for (int half = 0; half < 2; ++half) {
        float acc[32];
#pragma unroll
        for (int i = 0; i < 32; ++i) acc[i] = 0.f;
#pragma unroll 1
        for (int s = 0; s <= smax; ++s) {
            const float w = (s <= t && t < nrows) ? wrow[s] : 0.f;
            const LAS f32x4* vp = (const LAS f32x4*)(vr + s * 260 + hh * 64 + half * 32);
#pragma unroll
            for (int i = 0; i < 8; ++i) { const f32x4 v = vp[i]; acc[4 * i] += w * v[0]; acc[4 * i + 1] += w * v[1]; acc[4 * i + 2] += w * v[2]; acc[4 * i + 3] += w * v[3]; }
        }
        if (t < nrows) {
            const u32x4* up = (const u32x4*)(Z + (row0 + t) * NZ + ZC_CU + hh * 64 + half * 32);
            u32x4* mp = (u32x4*)(c.MIX() + (row0 + t) * DM + 512 + hh * 64 + half * 32);
#pragma unroll
            for (int i = 0; i < 4; ++i) { float uf[8]; unpack8(up[i], uf); float o[8];
#pragma unroll
                for (int e = 0; e < 8; ++e) o[e] = gelu_tanh(uf[e]) * (acc[8 * i + e] + bsv);
                u32x4 w; w.x = pk2(o[0], o[1]); w.y = pk2(o[2], o[3]); w.z = pk2(o[4], o[5]); w.w = pk2(o[6], o[7]); mp[i] = w; }
        }
    }
    __syncthreads();
}

constexpr int L_A0 = 0, L_A1 = 4096, L_A2 = 8192, L_A3 = 12288, L_HB = 16384, L_SC = 20480;
struct RecIO {
    const float* st_in;
    const float* n_in; const float* m_in;
    float* st_out; float* n_out; float* m_out; float* b_out;
    bool native_in, native_out;
};
template <bool OUT> DEVI void mlstm_item(const Ctx& c, int layer, int hh, size_t row0, int nt, const RecIO& io, float m_init) {
    LAS float* L = (LAS float*)c.lds; const bf16_t* Z = c.Z(); const int tid = c.tid, v = tid >> 3, g = tid & 7;
    float C[8], n[8], m;
    if (io.st_in) { const f32x4 a = *(const f32x4*)(io.st_in + tid * 8), b = *(const f32x4*)(io.st_in + tid * 8 + 4); C[0] = a[0]; C[1] = a[1]; C[2] = a[2]; C[3] = a[3]; C[4] = b[0]; C[5] = b[1]; C[6] = b[2]; C[7] = b[3];
        const f32x4 na = *(const f32x4*)(io.n_in + g * 8), nb = *(const f32x4*)(io.n_in + g * 8 + 4); n[0] = na[0]; n[1] = na[1]; n[2] = na[2]; n[3] = na[3]; n[4] = nb[0]; n[5] = nb[1]; n[6] = nb[2]; n[7] = nb[3]; m = io.m_in[0]; }
    else {
#pragma unroll
        for (int j = 0; j < 8; ++j) { C[j] = 0.f; n[j] = 0.f; } m = m_init; }
    float bsum = 0.f;
    const float gbi = c.in[I_BI][layer * 4 + hh], gbf = c.in[I_BF][layer * 4 + hh];
    for (int seg = 0; seg < nt; seg += 64) {
        const int ns = (nt - seg) < 64 ? (nt - seg) : 64;
        __syncthreads();
        { const int tt = tid >> 3;
          if (tt < ns) { const size_t zr = (row0 + seg + tt) * NZ + hh * 64 + g * 8; float f[8];
            if (OUT) { unpack8(*(const u32x4*)(Z + zr + ZC_BQ), f); *(LAS f32x4*)(L + L_A0 + tt * 64 + g * 8) = (f32x4){f[0], f[1], f[2], f[3]}; *(LAS f32x4*)(L + L_A0 + tt * 64 + g * 8 + 4) = (f32x4){f[4], f[5], f[6], f[7]}; }
            unpack8(*(const u32x4*)(Z + zr + ZC_BK), f); *(LAS f32x4*)(L + L_A1 + tt * 64 + g * 8) = (f32x4){f[0], f[1], f[2], f[3]} * 0.125f; *(LAS f32x4*)(L + L_A1 + tt * 64 + g * 8 + 4) = (f32x4){f[4], f[5], f[6], f[7]} * 0.125f;
            unpack8(*(const u32x4*)(Z + zr + ZC_BV), f); *(LAS f32x4*)(L + L_A2 + tt * 64 + g * 8) = (f32x4){f[0], f[1], f[2], f[3]}; *(LAS f32x4*)(L + L_A2 + tt * 64 + g * 8 + 4) = (f32x4){f[4], f[5], f[6], f[7]}; }
          if (tid < ns) { L[L_SC + tid] = bf2f(Z[(row0 + seg + tid) * NZ + ZC_GI + hh]) + gbi; L[L_SC + 64 + tid] = log_sigmoid(bf2f(Z[(row0 + seg + tid) * NZ + ZC_GF + hh]) + gbf); } }
        __syncthreads();
#pragma unroll 2
        for (int tt = 0; tt < ns; ++tt) {
            const float ii = L[L_SC + tt], lf = L[L_SC + 64 + tt];
            const float mn = fmaxf(lf + m, ii);
            const float a = __expf(lf + m - mn), bb = __expf(ii - mn);
            bsum += lf; m = mn;
            const float bv = bb * L[L_A2 + tt * 64 + v];
            const f32x4 k0 = *(const LAS f32x4*)(L + L_A1 + tt * 64 + g * 8), k1 = *(const LAS f32x4*)(L + L_A1 + tt * 64 + g * 8 + 4);
            const float kk[8] = {k0[0], k0[1], k0[2], k0[3], k1[0], k1[1], k1[2], k1[3]};
#pragma unroll
            for (int j = 0; j < 8; ++j) { C[j] = a * C[j] + bv * kk[j]; n[j] = a * n[j] + bb * kk[j]; }
            if (OUT) {
                const f32x4 q0 = *(const LAS f32x4*)(L + L_A0 + tt * 64 + g * 8), q1 = *(const LAS f32x4*)(L + L_A0 + tt * 64 + g * 8 + 4);
                const float qq[8] = {q0[0], q0[1], q0[2], q0[3], q1[0], q1[1], q1[2], q1[3]};
                float num = 0.f, nq = 0.f;
#pragma unroll
                for (int j = 0; j < 8; ++j) { num += C[j] * qq[j]; nq += n[j] * qq[j]; }
                num = sum8(num); nq = sum8(nq);
                const float den = fmaxf(fabsf(nq), __expf(-mn));
                if (g == 0) L[L_HB + tt * 64 + v] = num / den;
            }
        }
        if (OUT) {
            __syncthreads();
            const int tt = tid >> 3;
            if (tt < ns) {
                const f32x4 h0 = *(const LAS f32x4*)(L + L_HB + tt * 64 + g * 8), h1 = *(const LAS f32x4*)(L + L_HB + tt * 64 + g * 8 + 4);
                float hv[8] = {h0[0], h0[1], h0[2], h0[3], h1[0], h1[1], h1[2], h1[3]}; float ss = 0.f;
#pragma unroll
                for (int j = 0; j < 8; ++j) ss += hv[j] * hv[j];
                ss = sum8(ss);
                const float rs = rsqrtf(ss * (1.0f / 64.0f) + EPSN);
                const float* gm = c.in[I_GML] + layer * 256 + hh * 64 + g * 8; float bo[8];
                unpack8(*(const u32x4*)(Z + (row0 + seg + tt) * NZ + ZC_BO + hh * 64 + g * 8), bo); float o[8];
#pragma unroll
                for (int j = 0; j < 8; ++j) o[j] = sigmoidf_(bo[j]) * (hv[j] * rs * gm[j]);
                u32x4 w; w.x = pk2(o[0], o[1]); w.y = pk2(o[2], o[3]); w.z = pk2(o[4], o[5]); w.w = pk2(o[6], o[7]);
                *(u32x4*)(c.MIX() + (row0 + seg + tt) * DM + 256 + hh * 64 + g * 8) = w;
            }
        }
    }
    if (io.st_out) { *(f32x4*)(io.st_out + tid * 8) = (f32x4){C[0], C[1], C[2], C[3]}; *(f32x4*)(io.st_out + tid * 8 + 4) = (f32x4){C[4], C[5], C[6], C[7]};
        if (v == 0) { *(f32x4*)(io.n_out + g * 8) = (f32x4){n[0], n[1], n[2], n[3]}; *(f32x4*)(io.n_out + g * 8 + 4) = (f32x4){n[4], n[5], n[6], n[7]}; }
        if (tid == 0) { io.m_out[0] = m; if (io.b_out) io.b_out[0] = bsum; } }
    __syncthreads();
}
DEVI float hgrn_lb(const Ctx& c, int layer, int col) {
    if (layer == 0) return 0.f;
    const float a = c.in[I_LB][col], b = c.in[I_LB][256 + col]; const float mx = fmaxf(a, b); const float ea = __expf(a - mx), eb = __expf(b - mx);
    return eb * frcp(ea + eb);
}
DEVI void hgrn_lb8(const Ctx& c, int layer, int col0, float* out) {
    if (layer == 0) {
#pragma unroll
        for (int j = 0; j < 8; ++j) out[j] = 0.f;
        return; }
    const float* lb = c.in[I_LB];
    const f32x4 a0 = *(const f32x4*)(lb + col0), a1 = *(const f32x4*)(lb + col0 + 4), b0 = *(const f32x4*)(lb + 256 + col0), b1 = *(const f32x4*)(lb + 256 + col0 + 4);
#pragma unroll
    for (int j = 0; j < 8; ++j) { const float a = j < 4 ? a0[j & 3] : a1[j & 3], b = j < 4 ? b0[j & 3] : b1[j & 3]; const float mx = fmaxf(a, b); const float ea = __expf(a - mx), eb = __expf(b - mx); out[j] = eb * frcp(ea + eb); }
}
template <bool OUT> DEVI void hgrn_item(const Ctx& c, int layer, int hh, size_t row0, int nt, const RecIO& io) {
    LAS float* L = (LAS float*)c.lds; const bf16_t* Z = c.Z(); const int tid = c.tid, v = tid >> 3, g = tid & 7;
    float S[8], fs[8];
#pragma unroll
    for (int j = 0; j < 8; ++j) { fs[j] = 0.f;
        S[j] = io.st_in ? (io.native_in ? io.st_in[tid * 8 + j] : io.st_in[(g * 8 + j) * 64 + v]) : 0.f; }
    float lbv[8], llb[8], l1m[8];
    {
        hgrn_lb8(c, layer, hh * 64 + g * 8, lbv);
#pragma unroll
        for (int j = 0; j < 8; ++j) { llb[j] = __logf(fmaxf(lbv[j], 1e-30f)); l1m[j] = __logf(1.0f - lbv[j]); }
    }
    for (int seg = 0; seg < nt; seg += 64) {
        const int ns = (nt - seg) < 64 ? (nt - seg) : 64;
        __syncthreads();
        { const int tt = tid >> 3;
          if (tt < ns) { const size_t zr = (row0 + seg + tt) * NZ + hh * 64 + g * 8; float f[8];
            if (OUT) { unpack8(*(const u32x4*)(Z + zr + ZC_DQ), f); *(LAS f32x4*)(L + L_A0 + tt * 64 + g * 8) = (f32x4){f[0], f[1], f[2], f[3]}; *(LAS f32x4*)(L + L_A0 + tt * 64 + g * 8 + 4) = (f32x4){f[4], f[5], f[6], f[7]}; }
            unpack8(*(const u32x4*)(Z + zr + ZC_DF), f); float ff[8], kd[8];
#pragma unroll
            for (int j = 0; j < 8; ++j) { const float x1 = llb[j], x2 = l1m[j] + log_sigmoid(f[j]); const float mx = fmaxf(x1, x2); const float lfd = mx + log1pexp_neg(fabsf(x1 - x2));
                ff[j] = lfd; kd[j] = (1.0f - lbv[j]) * sigmoidf_(-f[j]); }
            *(LAS f32x4*)(L + L_A1 + tt * 64 + g * 8) = (f32x4){ff[0], ff[1], ff[2], ff[3]}; *(LAS f32x4*)(L + L_A1 + tt * 64 + g * 8 + 4) = (f32x4){ff[4], ff[5], ff[6], ff[7]};
            *(LAS f32x4*)(L + L_A2 + tt * 64 + g * 8) = (f32x4){kd[0], kd[1], kd[2], kd[3]}; *(LAS f32x4*)(L + L_A2 + tt * 64 + g * 8 + 4) = (f32x4){kd[4], kd[5], kd[6], kd[7]};
            unpack8(*(const u32x4*)(Z + zr + ZC_DI), f); *(LAS f32x4*)(L + L_A3 + tt * 64 + g * 8) = (f32x4){f[0], f[1], f[2], f[3]}; *(LAS f32x4*)(L + L_A3 + tt * 64 + g * 8 + 4) = (f32x4){f[4], f[5], f[6], f[7]}; } }
        __syncthreads();
#pragma unroll 2
        for (int tt = 0; tt < ns; ++tt) {
            const float vv = L[L_A3 + tt * 64 + v];
            const f32x4 f0 = *(const LAS f32x4*)(L + L_A1 + tt * 64 + g * 8), f1 = *(const LAS f32x4*)(L + L_A1 + tt * 64 + g * 8 + 4);
            const f32x4 k0 = *(const LAS f32x4*)(L + L_A2 + tt * 64 + g * 8), k1 = *(const LAS f32x4*)(L + L_A2 + tt * 64 + g * 8 + 4);
            const float lf[8] = {f0[0], f0[1], f0[2], f0[3], f1[0], f1[1], f1[2], f1[3]}; const float kk[8] = {k0[0], k0[1], k0[2], k0[3], k1[0], k1[1], k1[2], k1[3]};
#pragma unroll
            for (int j = 0; j < 8; ++j) { fs[j] += lf[j]; S[j] = __expf(lf[j]) * S[j] + kk[j] * vv; }
            if (OUT) {
                const f32x4 q0 = *(const LAS f32x4*)(L + L_A0 + tt * 64 + g * 8), q1 = *(const LAS f32x4*)(L + L_A0 + tt * 64 + g * 8 + 4);
                const float qq[8] = {q0[0], q0[1], q0[2], q0[3], q1[0], q1[1], q1[2], q1[3]};
                float o = 0.f;
#pragma unroll
                for (int j = 0; j < 8; ++j) o += qq[j] * S[j];
                o = sum8(o);
                if (g == 0) L[L_HB + tt * 64 + v] = o;
            }
        }
        if (OUT) {
            __syncthreads();
            const int tt = tid >> 3;
            if (tt < ns) {
                const f32x4 h0 = *(const LAS f32x4*)(L + L_HB + tt * 64 + g * 8), h1 = *(const LAS f32x4*)(L + L_HB + tt * 64 + g * 8 + 4);
                float hv[8] = {h0[0], h0[1], h0[2], h0[3], h1[0], h1[1], h1[2], h1[3]}; float ss = 0.f;
#pragma unroll
                for (int j = 0; j < 8; ++j) ss += hv[j] * hv[j];
                ss = sum8(ss);
                const float rs = rsqrtf(ss * (1.0f / 64.0f) + EPSN);
                const float* gm = c.in[I_GHG] + layer * 256 + hh * 64 + g * 8; float dg[8];
                unpack8(*(const u32x4*)(Z + (row0 + seg + tt) * NZ + ZC_DG + hh * 64 + g * 8), dg); float o[8];
#pragma unroll
                for (int j = 0; j < 8; ++j) o[j] = (hv[j] * rs * gm[j]) * (dg[j] * sigmoidf_(dg[j]));
                u32x4 w; w.x = pk2(o[0], o[1]); w.y = pk2(o[2], o[3]); w.z = pk2(o[4], o[5]); w.w = pk2(o[6], o[7]);
                *(u32x4*)(c.MIX() + (row0 + seg + tt) * DM + 768 + hh * 64 + g * 8) = w;
            }
        }
    }
    if (io.st_out) {
#pragma unroll
        for (int j = 0; j < 8; ++j) { if (io.native_out) io.st_out[tid * 8 + j] = S[j]; else io.st_out[(g * 8 + j) * 64 + v] = S[j]; }
        if (io.b_out && v == 0) {
#pragma unroll
            for (int j = 0; j < 8; ++j) io.b_out[g * 8 + j] = __expf(fs[j]); } }
    __syncthreads();
}

constexpr int RSTG = 128 * 144;
DEVI bf16x8_t pack8(const float* f) { union { u32x4 u; bf16x8_t v; } r; r.u.x = pk2(f[0], f[1]); r.u.y = pk2(f[2], f[3]); r.u.z = pk2(f[4], f[5]); r.u.w = pk2(f[6], f[7]); return r.v; }
DEVI bf16x8_t pack8v(const f32x4 a, const f32x4 b) { union { u32x4 u; bf16x8_t v; } r; r.u.x = pk2(a[0], a[1]); r.u.y = pk2(a[2], a[3]); r.u.z = pk2(b[0], b[1]); r.u.w = pk2(b[2], b[3]); return r.v; }
struct StageRegs { u32x4 v[2]; };
DEVI StageRegs stage_load(const bf16_t* src  , int tid) {
    StageRegs r; const int tt = tid >> 2, ch = tid & 3;
#pragma unroll
    for (int e = 0; e < 2; ++e) r.v[e] = *(const u32x4*)(src + (size_t)tt * NZ + 8 * (2 * ch + e));
    return r;
}
DEVI void stage_store(LAS unsigned char* stage, const StageRegs& r, int tid) {
    const int tt = tid >> 2, ch = tid & 3;
#pragma unroll
    for (int e = 0; e < 2; ++e) *(LAS u32x4*)(stage + tt * 144 + (2 * ch + e) * 16) = r.v[e];
}
struct GateRegs { unsigned short gi0, gi1, gf0, gf1; float bi, bfv; };
DEVI GateRegs gate_load(const Ctx& c, int layer, size_t row0, int hh) {
    GateRegs g; const bf16_t* Z = c.Z(); const size_t r0 = (row0 + 2 * c.lane) * NZ, r1 = r0 + NZ;
    g.gi0 = Z[r0 + ZC_GI + hh]; g.gi1 = Z[r1 + ZC_GI + hh]; g.gf0 = Z[r0 + ZC_GF + hh]; g.gf1 = Z[r1 + ZC_GF + hh]; g.bi = c.in[I_BI][layer * 4 + hh]; g.bfv = c.in[I_BF][layer * 4 + hh]; return g;
}
DEVI void mlstm_scalars(const Ctx& c, LAS float* F, const GateRegs& gr, float mprev) {
    if (c.wave == 0) {
        const int lane = c.lane;
        const float i0 = bf2f(gr.gi0) + gr.bi, i1 = bf2f(gr.gi1) + gr.bi, l0 = log_sigmoid(bf2f(gr.gf0) + gr.bfv), l1 = log_sigmoid(bf2f(gr.gf1) + gr.bfv);
        float inc = l0 + l1;
#pragma unroll
        for (int o = 1; o < 64; o <<= 1) { const float y = shfl_up_f(inc, o); if (lane >= o) inc += y; }
        const float b0 = inc - l1, b1 = inc, u0 = i0 - b0, u1 = i1 - b1;
        float mxs = fmaxf(u0, u1);
#pragma unroll
        for (int o = 1; o < 64; o <<= 1) { const float y = shfl_up_f(mxs, o); if (lane >= o) mxs = fmaxf(mxs, y); }
        float ex = shfl_up_f(mxs, 1); if (lane == 0) ex = NEGV;
        const float c0 = fmaxf(ex, u0), c1 = fmaxf(c0, u1);
        F[2 * lane] = b0; F[2 * lane + 1] = b1; F[128 + 2 * lane] = u0; F[128 + 2 * lane + 1] = u1; F[256 + 2 * lane] = fmaxf(b0 + mprev, b0 + c0); F[256 + 2 * lane + 1] = fmaxf(b1 + mprev, b1 + c1);
        if (lane == 63) { F[704] = b1; F[705] = mxs; }
    }
    __syncthreads();
}
constexpr int ML_V = 0, ML_K = RSTG, ML_F = 2 * RSTG, ML_P = ML_F + 4096;
DEVI void mlstm_chunk_state(const Ctx& c, int layer, int hh, size_t row0, float* Uout, float* nout, float* mout, float* bout) {
    LAS unsigned char* VS = c.lds + ML_V; LAS unsigned char* KS = c.lds + ML_K; LAS float* F = (LAS float*)(c.lds + ML_F); LAS float* NP_ = (LAS float*)(c.lds + ML_P);
    const bf16_t* Z = c.Z(); const int tid = c.tid, lane = c.lane, i = lane & 15, gq = lane >> 4;
    const StageRegs vreg = stage_load(Z + row0 * NZ + ZC_BV + hh * 64, tid), kreg = stage_load(Z + row0 * NZ + ZC_BK + hh * 64, tid);
    GateRegs gr{}; if (c.wave == 0) gr = gate_load(c, layer, row0, hh);
    __syncthreads();
    stage_store(VS, vreg, tid);
    mlstm_scalars(c, F, gr, 0.f);
    const float bL = F[704], umax = F[705];
    { const int tt = tid >> 2, ch = tid & 3; const float wsc = 0.125f * __expf(F[128 + tt] - umax);
#pragma unroll
      for (int e = 0; e < 2; ++e) { float f[8]; unpack8(kreg.v[e], f);
#pragma unroll
          for (int j = 0; j < 8; ++j) f[j] *= wsc;
          union { u32x4 u; bf16x8_t v; } pk; pk.v = pack8(f); *(LAS u32x4*)(KS + tt * 144 + (2 * ch + e) * 16) = pk.u; } }
    __syncthreads();
    { const int mt = c.wave >> 1, nt0 = 2 * (c.wave & 1);
      f32x4 acc0 = (f32x4){0.f, 0.f, 0.f, 0.f}, acc1 = acc0;
#pragma unroll
      for (int ks = 0; ks < 4; ++ks) { const bf16x8_t vf = lds_tfrag(VS, ks, 16 * mt + i, gq), k0 = lds_tfrag(KS, ks, 16 * nt0 + i, gq), k1 = lds_tfrag(KS, ks, 16 * (nt0 + 1) + i, gq);
          acc0 = __builtin_amdgcn_mfma_f32_16x16x32_bf16(vf, k0, acc0, 0, 0, 0); acc1 = __builtin_amdgcn_mfma_f32_16x16x32_bf16(vf, k1, acc1, 0, 0, 0); }
#pragma unroll
      for (int r = 0; r < 4; ++r) { wt_f32(Uout + (16 * mt + 4 * gq + r) * 64 + 16 * nt0 + i, acc0[r]); wt_f32(Uout + (16 * mt + 4 * gq + r) * 64 + 16 * (nt0 + 1) + i, acc1[r]); } }
    { const int k = tid & 63, part = tid >> 6; float sum = 0.f;
#pragma unroll
      for (int s = 0; s < 16; ++s) sum += bf2f(*(const LAS unsigned short*)(KS + (16 * part + s) * 144 + k * 2));
      NP_[part * 64 + k] = sum; }
    __syncthreads();
    if (tid < 64) { float sum = 0.f;
#pragma unroll
        for (int p8 = 0; p8 < 8; ++p8) sum += NP_[p8 * 64 + tid];
        wt_f32(nout + tid, sum); }
    if (tid == 0) { wt_f32(mout, bL + umax); wt_f32(bout, bL); }
}
DEVI void mlstm_chunk_out(const Ctx& c, int layer, int hh, size_t row0, const float* Cp, const float* np, const float* mp_) {
    LAS unsigned char* VS = c.lds + ML_V; LAS float* F = (LAS float*)(c.lds + ML_F);
    const bf16_t* Z = c.Z(); const int tid = c.tid, lane = c.lane, i = lane & 15, gq = lane >> 4, w = c.wave;
    const int t = 16 * w + i;
    const StageRegs vreg = stage_load(Z + row0 * NZ + ZC_BV + hh * 64, tid);
    GateRegs gr{}; if (w == 0) gr = gate_load(c, layer, row0, hh);
    const float npv = (tid >= 128 && tid < 192) ? np[tid - 128] : 0.f;
    const float mprev = mp_[0];
    bf16x8_t qf[2], kfr[8][2];
    { const bf16_t* qp = Z + (row0 + t) * NZ + ZC_BQ + hh * 64 + 8 * gq; qf[0] = *(const bf16x8_t*)qp; qf[1] = *(const bf16x8_t*)(qp + 32); }
#pragma unroll
    for (int kt = 0; kt < 8; ++kt) if (kt <= w) { const bf16_t* kp = Z + (row0 + 16 * kt + i) * NZ + ZC_BK + hh * 64 + 8 * gq; kfr[kt][0] = *(const bf16x8_t*)kp; kfr[kt][1] = *(const bf16x8_t*)(kp + 32); }
    __syncthreads();
    stage_store(VS, vreg, tid);
    if (tid >= 128 && tid < 192) F[640 + tid - 128] = npv;
    mlstm_scalars(c, F, gr, mprev);
    u32x2 bog[4]; f32x4 gmv[4];
#pragma unroll
    for (int dt = 0; dt < 4; ++dt) { const int col = hh * 64 + 16 * dt + 4 * gq; gmv[dt] = *(const f32x4*)(c.in[I_GML] + layer * 256 + col); bog[dt] = *(const u32x2*)(Z + (row0 + t) * NZ + ZC_BO + col); }
    const float bt = F[t], mt_ = F[256 + t], wt = bt - mt_, gI = __expf(bt + mprev - mt_);
    f32x4 s[8]; float nqi = 0.f;
#pragma unroll
    for (int kt = 0; kt < 8; ++kt) {
        s[kt] = (f32x4){0.f, 0.f, 0.f, 0.f};
        if (kt <= w) {
            f32x4 a = (f32x4){0.f, 0.f, 0.f, 0.f};
            a = __builtin_amdgcn_mfma_f32_16x16x32_bf16(kfr[kt][0], qf[0], a, 0, 0, 0);
            a = __builtin_amdgcn_mfma_f32_16x16x32_bf16(kfr[kt][1], qf[1], a, 0, 0, 0);
            const f32x4 uu = *(const LAS f32x4*)(F + 128 + 16 * kt + 4 * gq);
#pragma unroll
            for (int r = 0; r < 4; ++r) { const bool valid = (16 * kt + 4 * gq + r) <= t; const float val = a[r] * 0.125f * __expf(valid ? uu[r] + wt : NEGV); a[r] = val; nqi += val; }
            s[kt] = a;
        }
    }
    nqi += shfl_xor_f(nqi, 16); nqi += shfl_xor_f(nqi, 32);
    f32x4 cpr[4][2][2];
#pragma unroll
    for (int dt = 0; dt < 4; ++dt)
#pragma unroll
        for (int ks = 0; ks < 2; ++ks) { const float* cp = Cp + (16 * dt + i) * 64 + 32 * ks + 8 * gq; cpr[dt][ks][0] = *(const f32x4*)cp; cpr[dt][ks][1] = *(const f32x4*)(cp + 4); }
    f32x4 o[4], oi[4];
#pragma unroll
    for (int dt = 0; dt < 4; ++dt) { o[dt] = (f32x4){0.f, 0.f, 0.f, 0.f}; oi[dt] = o[dt]; }
#pragma unroll
    for (int ks = 0; ks < 4; ++ks) {
        if (2 * ks <= w) {
            const bf16x8_t pf = pack8v(s[2 * ks], s[2 * ks + 1]);
#pragma unroll
            for (int dt = 0; dt < 4; ++dt) o[dt] = __builtin_amdgcn_mfma_f32_16x16x32_bf16(lds_tfrag(VS, ks, 16 * dt + i, gq), pf, o[dt], 0, 0, 0);
        }
    }
#pragma unroll
    for (int dt = 0; dt < 4; ++dt)
#pragma unroll
        for (int ks = 0; ks < 2; ++ks) oi[dt] = __builtin_amdgcn_mfma_f32_16x16x32_bf16(pack8v(cpr[dt][ks][0], cpr[dt][ks][1]), qf[ks], oi[dt], 0, 0, 0);
    float nqn = 0.f;
#pragma unroll
    for (int ks = 0; ks < 2; ++ks) { float qv[8]; union { u32x4 u; bf16x8_t v; } qq; qq.v = qf[ks]; unpack8(qq.u, qv);
#pragma unroll
        for (int j = 0; j < 8; ++j) nqn += qv[j] * F[640 + 32 * ks + 8 * gq + j]; }
    nqn += shfl_xor_f(nqn, 16); nqn += shfl_xor_f(nqn, 32);
    const float nq = nqi + gI * nqn, inv = frcp(fmaxf(fabsf(nq), __expf(-mt_)));
    float ss = 0.f;
#pragma unroll
    for (int dt = 0; dt < 4; ++dt) { o[dt] = (o[dt] + oi[dt] * gI) * inv; ss += (o[dt][0] * o[dt][0] + o[dt][1] * o[dt][1]) + (o[dt][2] * o[dt][2] + o[dt][3] * o[dt][3]); }
    ss += shfl_xor_f(ss, 16); ss += shfl_xor_f(ss, 32);
    const float rs = rsqrtf(ss * (1.0f / 64.0f) + EPSN);
#pragma unroll
    for (int dt = 0; dt < 4; ++dt) { const int col = hh * 64 + 16 * dt + 4 * gq; const f32x4 gm = gmv[dt]; const u32x2 bo = bog[dt];
        const float r0 = sigmoidf_(bflo(bo.x)) * (o[dt][0] * rs * gm[0]), r1 = sigmoidf_(bfhi(bo.x)) * (o[dt][1] * rs * gm[1]), r2 = sigmoidf_(bflo(bo.y)) * (o[dt][2] * rs * gm[2]), r3 = sigmoidf_(bfhi(bo.y)) * (o[dt][3] * rs * gm[3]);
        u32x2 wv; wv.x = pk2(r0, r1); wv.y = pk2(r2, r3); *(u32x2*)(c.MIX() + (row0 + t) * DM + 256 + col) = wv; }
}
constexpr int HG_V = 0, HG_K = RSTG, HG_BC = 2 * RSTG, HG_SEG = HG_BC + 32768;
DEVI void hgrn_logf_kd(float lbv, float llb, float l1m, float df, float& lfd, float& kd) {
    const float x2 = l1m + log_sigmoid(df), mx = fmaxf(llb, x2); lfd = mx + log1pexp_neg(fabsf(llb - x2)); kd = (1.0f - lbv) * sigmoidf_(-df);
}
struct DecayRegs { unsigned short df[16]; float lbv; };
DEVI DecayRegs decay_load(const Ctx& c, int layer, int hh, size_t row0) {
    DecayRegs r; const bf16_t* Z = c.Z(); const int d = c.tid & 63, seg = c.tid >> 6;
#pragma unroll
    for (int tt = 0; tt < 16; ++tt) r.df[tt] = Z[(row0 + 16 * seg + tt) * NZ + ZC_DF + hh * 64 + d];
    r.lbv = hgrn_lb(c, layer, hh * 64 + d); return r;
}
DEVI void hgrn_cumdecay(const Ctx& c, const DecayRegs& dr) {
    LAS float* BC = (LAS float*)(c.lds + HG_BC); LAS float* SEG = (LAS float*)(c.lds + HG_SEG);
    const int d = c.tid & 63, seg = c.tid >> 6; const float lbv = dr.lbv, llb = __logf(fmaxf(lbv, 1e-30f)), l1m = __logf(1.0f - lbv);
    float run = 0.f;
#pragma unroll
    for (int tt = 0; tt < 16; ++tt) { const int t = 16 * seg + tt; float lfd, kd; hgrn_logf_kd(lbv, llb, l1m, bf2f(dr.df[tt]), lfd, kd); run += lfd; BC[t * 64 + d] = run; }
    SEG[seg * 64 + d] = run;
    __syncthreads();
    float off = 0.f;
    for (int s2 = 0; s2 < seg; ++s2) off += SEG[s2 * 64 + d];
#pragma unroll 4
    for (int tt = 0; tt < 16; ++tt) BC[(16 * seg + tt) * 64 + d] += off;
    __syncthreads();
}
DEVI void hgrn_chunk_state(const Ctx& c, int layer, int hh, size_t row0, float* Uout  , float* dec_out) {
    LAS unsigned char* VS = c.lds + HG_V; LAS unsigned char* KS = c.lds + HG_K; LAS float* BC = (LAS float*)(c.lds + HG_BC);
    const bf16_t* Z = c.Z(); const int tid = c.tid, lane = c.lane, i = lane & 15, gq = lane >> 4;
    const StageRegs vreg = stage_load(Z + row0 * NZ + ZC_DI + hh * 64, tid), freg = stage_load(Z + row0 * NZ + ZC_DF + hh * 64, tid);
    const DecayRegs dr = decay_load(c, layer, hh, row0);
    float lb16[2][8];
#pragma unroll
    for (int e = 0; e < 2; ++e) hgrn_lb8(c, layer, hh * 64 + 8 * (2 * (tid & 3) + e), lb16[e]);
    __syncthreads();
    stage_store(VS, vreg, tid);
    hgrn_cumdecay(c, dr);
    { const int tt = tid >> 2, ch = tid & 3;
#pragma unroll
      for (int e = 0; e < 2; ++e) { const int d0 = 8 * (2 * ch + e); float f[8]; unpack8(freg.v[e], f);
#pragma unroll
          for (int j = 0; j < 8; ++j) { const float lbv = lb16[e][j]; float lfd, kd; hgrn_logf_kd(lbv, __logf(fmaxf(lbv, 1e-30f)), __logf(1.0f - lbv), f[j], lfd, kd);
              f[j] = kd * __expf(BC[127 * 64 + d0 + j] - BC[tt * 64 + d0 + j]); }
          union { u32x4 u; bf16x8_t v; } pk; pk.v = pack8(f); *(LAS u32x4*)(KS + tt * 144 + (2 * ch + e) * 16) = pk.u; } }
    __syncthreads();
    { const int mt = c.wave >> 1, nt0 = 2 * (c.wave & 1);
      f32x4 acc0 = (f32x4){0.f, 0.f, 0.f, 0.f}, acc1 = acc0;
#pragma unroll
      for (int ks = 0; ks < 4; ++ks) { const bf16x8_t vf = lds_tfrag(VS, ks, 16 * mt + i, gq), k0 = lds_tfrag(KS, ks, 16 * nt0 + i, gq), k1 = lds_tfrag(KS, ks, 16 * (nt0 + 1) + i, gq);
          acc0 = __builtin_amdgcn_mfma_f32_16x16x32_bf16(vf, k0, acc0, 0, 0, 0); acc1 = __builtin_amdgcn_mfma_f32_16x16x32_bf16(vf, k1, acc1, 0, 0, 0); }
#pragma unroll
      for (int r = 0; r < 4; ++r) { wt_f32(Uout + (16 * mt + 4 * gq + r) * 64 + 16 * nt0 + i, acc0[r]); wt_f32(Uout + (16 * mt + 4 * gq + r) * 64 + 16 * (nt0 + 1) + i, acc1[r]); } }
    if (tid < 64) wt_f32(dec_out + tid, __expf(BC[127 * 64 + tid]));
}
DEVI void hgrn_chunk_out(const Ctx& c, int layer, int hh, size_t row0, const float* Sst  ) {
    LAS unsigned char* VS = c.lds + HG_V; LAS float* BC = (LAS float*)(c.lds + HG_BC);
    const bf16_t* Z = c.Z(); const int tid = c.tid, lane = c.lane, i = lane & 15, gq = lane >> 4, w = c.wave;
    const int t = 16 * w + i;
    const StageRegs vreg = stage_load(Z + row0 * NZ + ZC_DI + hh * 64, tid);
    const DecayRegs dr = decay_load(c, layer, hh, row0);
    u32x4 qraw[2], dfr[8][2]; f32x4 spr[4][2][2]; u32x2 dgg[4]; f32x4 gmv[4];
#pragma unroll
    for (int ks = 0; ks < 2; ++ks) qraw[ks] = *(const u32x4*)(Z + (row0 + t) * NZ + ZC_DQ + hh * 64 + 32 * ks + 8 * gq);
#pragma unroll
    for (int kt = 0; kt < 8; ++kt) if (kt <= w) {
#pragma unroll
        for (int ks = 0; ks < 2; ++ks) dfr[kt][ks] = *(const u32x4*)(Z + (row0 + 16 * kt + i) * NZ + ZC_DF + hh * 64 + 32 * ks + 8 * gq); }
    float oml[2][8]; bf16x8_t qf1[2], qf2[2];
#pragma unroll
    for (int ks = 0; ks < 2; ++ks) { hgrn_lb8(c, layer, hh * 64 + 32 * ks + 8 * gq, oml[ks]);
#pragma unroll
        for (int j = 0; j < 8; ++j) oml[ks][j] = 1.0f - oml[ks][j]; }
    __syncthreads();
    stage_store(VS, vreg, tid);
    hgrn_cumdecay(c, dr);
#pragma unroll
    for (int ks = 0; ks < 2; ++ks) { float qv[8]; unpack8(qraw[ks], qv); float q1[8], q2[8];
        const f32x4 b0 = *(const LAS f32x4*)(BC + t * 64 + 32 * ks + 8 * gq), b1 = *(const LAS f32x4*)(BC + t * 64 + 32 * ks + 8 * gq + 4);
        f32x4 r0 = (f32x4){0.f, 0.f, 0.f, 0.f}, r1 = r0;
        if (w > 0) { r0 = *(const LAS f32x4*)(BC + (16 * w - 1) * 64 + 32 * ks + 8 * gq); r1 = *(const LAS f32x4*)(BC + (16 * w - 1) * 64 + 32 * ks + 8 * gq + 4); }
#pragma unroll
        for (int j = 0; j < 8; ++j) { const float bj = j < 4 ? b0[j] : b1[j - 4], rj = j < 4 ? r0[j] : r1[j - 4];
            q1[j] = qv[j] * oml[ks][j] * __expf(bj - rj); q2[j] = qv[j] * __expf(bj); }
        qf1[ks] = pack8(q1); qf2[ks] = pack8(q2); }
    f32x4 s[8];
#pragma unroll
    for (int kt = 0; kt < 8; ++kt) {
        s[kt] = (f32x4){0.f, 0.f, 0.f, 0.f};
        if (kt <= w) {
            const int sk = 16 * kt + i; f32x4 a = (f32x4){0.f, 0.f, 0.f, 0.f};
#pragma unroll
            for (int ks = 0; ks < 2; ++ks) { float f[8]; unpack8(dfr[kt][ks], f);
                const f32x4 b0 = *(const LAS f32x4*)(BC + sk * 64 + 32 * ks + 8 * gq), b1 = *(const LAS f32x4*)(BC + sk * 64 + 32 * ks + 8 * gq + 4);
                f32x4 r0 = (f32x4){0.f, 0.f, 0.f, 0.f}, r1 = r0;
                if (w > 0) { r0 = *(const LAS f32x4*)(BC + (16 * w - 1) * 64 + 32 * ks + 8 * gq); r1 = *(const LAS f32x4*)(BC + (16 * w - 1) * 64 + 32 * ks + 8 * gq + 4); }
#pragma unroll
                for (int j = 0; j < 8; ++j) { const float bj = j < 4 ? b0[j] : b1[j - 4], rj = j < 4 ? r0[j] : r1[j - 4]; f[j] = sigmoidf_(-f[j]) * __expf(fminf(rj - bj, 80.f)); }
                a = __builtin_amdgcn_mfma_f32_16x16x32_bf16(pack8(f), qf1[ks], a, 0, 0, 0); }
#pragma unroll
            for (int r = 0; r < 4; ++r) a[r] = ((16 * kt + 4 * gq + r) <= t) ? a[r] : 0.f;
            s[kt] = a;
        }
    }
#pragma unroll
    for (int dt = 0; dt < 4; ++dt) {
#pragma unroll
        for (int ks = 0; ks < 2; ++ks) { const float* sp = Sst + (16 * dt + i) * 64 + 32 * ks + 8 * gq; spr[dt][ks][0] = *(const f32x4*)sp; spr[dt][ks][1] = *(const f32x4*)(sp + 4); }
        const int col = hh * 64 + 16 * dt + 4 * gq; gmv[dt] = *(const f32x4*)(c.in[I_GHG] + layer * 256 + col); dgg[dt] = *(const u32x2*)(Z + (row0 + t) * NZ + ZC_DG + col); }
    f32x4 o[4];
#pragma unroll
    for (int dt = 0; dt < 4; ++dt) o[dt] = (f32x4){0.f, 0.f, 0.f, 0.f};
#pragma unroll
    for (int ks = 0; ks < 4; ++ks) {
        if (2 * ks <= w) {
            const bf16x8_t pf = pack8v(s[2 * ks], s[2 * ks + 1]);
#pragma unroll
            for (int dt = 0; dt < 4; ++dt) o[dt] = __builtin_amdgcn_mfma_f32_16x16x32_bf16(lds_tfrag(VS, ks, 16 * dt + i, gq), pf, o[dt], 0, 0, 0);
        }
    }
#pragma unroll
    for (int dt = 0; dt < 4; ++dt)
#pragma unroll
        for (int ks = 0; ks < 2; ++ks) o[dt] = __builtin_amdgcn_mfma_f32_16x16x32_bf16(pack8v(spr[dt][ks][0], spr[dt][ks][1]), qf2[ks], o[dt], 0, 0, 0);
    float ss = 0.f;
#pragma unroll
    for (int dt = 0; dt < 4; ++dt) ss += (o[dt][0] * o[dt][0] + o[dt][1] * o[dt][1]) + (o[dt][2] * o[dt][2] + o[dt][3] * o[dt][3]);
    ss += shfl_xor_f(ss, 16); ss += shfl_xor_f(ss, 32);
    const float rs = rsqrtf(ss * (1.0f / 64.0f) + EPSN);
#pragma unroll
    for (int dt = 0; dt < 4; ++dt) { const int col = hh * 64 + 16 * dt + 4 * gq; const f32x4 gm = gmv[dt];
        const u32x2 dg = dgg[dt]; const float g0 = bflo(dg.x), g1 = bfhi(dg.x), g2 = bflo(dg.y), g3 = bfhi(dg.y);
        const float r0 = (o[dt][0] * rs * gm[0]) * (g0 * sigmoidf_(g0)), r1 = (o[dt][1] * rs * gm[1]) * (g1 * sigmoidf_(g1)), r2 = (o[dt][2] * rs * gm[2]) * (g2 * sigmoidf_(g2)), r3 = (o[dt][3] * rs * gm[3]) * (g3 * sigmoidf_(g3));
        u32x2 wv; wv.x = pk2(r0, r1); wv.y = pk2(r2, r3); *(u32x2*)(c.MIX() + (row0 + t) * DM + 768 + col) = wv; }
}

constexpr int GM_PITCH = 528;
DEVI void gmlp_chunk_item(const Ctx& c, int layer, size_t row0) {
    LAS unsigned char* VS = c.lds; const bf16_t* Z = c.Z(); const int lane = c.lane, i = lane & 15, gq = lane >> 4, w = c.wave, t = 16 * w + i;
    bf16x8_t wf[4][4];
    u32x2 cvr[16];
    {
        f32x4 wr[4][4][2];
#pragma unroll
        for (int hh = 0; hh < 4; ++hh)
#pragma unroll
            for (int ks = 0; ks < 4; ++ks) { const float* wp = c.in[I_WS] + ((size_t)(layer * NH + hh) * 128 + t) * 128 + 32 * ks + 4 * gq; wr[hh][ks][0] = *(const f32x4*)wp; wr[hh][ks][1] = *(const f32x4*)(wp + 16); }
#pragma unroll
        for (int rr = 0; rr < 16; ++rr) cvr[rr] = *(const u32x2*)(Z + (row0 + w * 16 + rr) * NZ + ZC_CV + 4 * lane);
#pragma unroll
        for (int hh = 0; hh < 4; ++hh)
#pragma unroll
            for (int ks = 0; ks < 4; ++ks) if (2 * ks <= w) { f32x4 w0 = wr[hh][ks][0], w1 = wr[hh][ks][1];
#pragma unroll
                for (int r = 0; r < 4; ++r) { if (32 * ks + 4 * gq + r > t) w0[r] = 0.f; if (32 * ks + 16 + 4 * gq + r > t) w1[r] = 0.f; }
                wf[hh][ks] = pack8v(w0, w1); }
    }
    __syncthreads();
    { const float* gcv = c.in[I_GCV] + layer * 256; const f32x4 gv = *(const f32x4*)(gcv + 4 * lane);
#pragma unroll
      for (int rr = 0; rr < 16; ++rr) { const u32x2 u = cvr[rr];
          const float e0 = gelu_tanh(bflo(u.x)), e1 = gelu_tanh(bfhi(u.x)), e2 = gelu_tanh(bflo(u.y)), e3 = gelu_tanh(bfhi(u.y));
          const float rs = rsqrtf(wave_sum((e0 * e0 + e1 * e1) + (e2 * e2 + e3 * e3)) * (1.0f / 256.0f) + EPSN);
          u32x2 o; o.x = pk2(e0 * rs * gv[0], e1 * rs * gv[1]); o.y = pk2(e2 * rs * gv[2], e3 * rs * gv[3]);
          *(LAS u32x2*)(VS + (w * 16 + rr) * GM_PITCH + 8 * lane) = o; } }
    __syncthreads();
    u32x2 cur4[4][4]; float bs4[4];
#pragma unroll
    for (int hh = 0; hh < 4; ++hh) {
#pragma unroll
        for (int ct = 0; ct < 4; ++ct) cur4[hh][ct] = *(const u32x2*)(Z + (row0 + t) * NZ + ZC_CU + hh * 64 + 16 * ct + 4 * gq);
        bs4[hh] = c.in[I_BS][(layer * NH + hh) * 128 + t]; }
    __builtin_amdgcn_sched_barrier(0);
#pragma unroll
    for (int hh = 0; hh < 4; ++hh) {
        const u32x2* cur = cur4[hh]; const float bsv = bs4[hh];
        f32x4 acc[4];
#pragma unroll
        for (int ct = 0; ct < 4; ++ct) acc[ct] = (f32x4){0.f, 0.f, 0.f, 0.f};
#pragma unroll
        for (int ks = 0; ks < 4; ++ks) if (2 * ks <= w) {
#pragma unroll
            for (int ct = 0; ct < 4; ++ct) acc[ct] = __builtin_amdgcn_mfma_f32_16x16x32_bf16(lds_tfrag<GM_PITCH>(VS, ks, hh * 64 + 16 * ct + i, gq), wf[hh][ks], acc[ct], 0, 0, 0);
        }
#pragma unroll
        for (int ct = 0; ct < 4; ++ct) { const u32x2 u = cur[ct];
            const float r0 = gelu_tanh(bflo(u.x)) * (acc[ct][0] + bsv), r1 = gelu_tanh(bfhi(u.x)) * (acc[ct][1] + bsv), r2 = gelu_tanh(bflo(u.y)) * (acc[ct][2] + bsv), r3 = gelu_tanh(bfhi(u.y)) * (acc[ct][3] + bsv);
            u32x2 wv; wv.x = pk2(r0, r1); wv.y = pk2(r2, r3); *(u32x2*)(c.MIX() + (row0 + t) * DM + 512 + hh * 64 + 16 * ct + 4 * gq) = wv; }
    }
}

DEVI void copy_item(const Ctx& c, int layer, int it) {
    constexpr int PER_T_P = 2 * WB * 256 / 16384  , PER_T_S = DECB * WB * 256 / 16384  ;
    const bf16_t* Z = c.Z();
    if (it < 2 * PER_T_P) {
        const int kv = it / PER_T_P, r = it % PER_T_P; float* o = c.out + (kv ? O_VWP : O_KWP) + (size_t)layer * 2 * WB * 256 + (size_t)r * 16384; const int zc = kv ? ZC_AV : ZC_AK;
        for (int i = c.tid; i < 4096; i += NTHREADS) { const size_t e = (size_t)r * 16384 + 4 * i; const int b = (int)(e / (WB * 256)), rr = (int)((e / 256) % WB), col = (int)(e % 256);
            const u32x2 u = *(const u32x2*)(Z + ((size_t)b * TSEQ + (TSEQ - WB) + rr) * NZ + zc + col); *(f32x4*)(o + 4 * i) = (f32x4){bflo(u.x), bfhi(u.x), bflo(u.y), bfhi(u.y)}; }
    } else {
        it -= 2 * PER_T_P; const int kv = it / PER_T_S, r = it % PER_T_S; float* o = c.out + (kv ? O_VWS : O_KWS) + (size_t)layer * DECB * WB * 256 + (size_t)r * 16384; const int zc = kv ? ZC_AV : ZC_AK;
        const float* src = c.in[kv ? I_CV : I_CK] + (size_t)layer * DECB * WB * 256;
        if ((r & 31) != 31) {
            const f32x4* s4 = (const f32x4*)(src + (size_t)r * 16384 + DECT * 256); f32x4* o4 = (f32x4*)o; f32x4 v[8];
#pragma unroll
            for (int k = 0; k < 8; ++k) v[k] = __builtin_nontemporal_load(s4 + c.tid + k * NTHREADS);
#pragma unroll
            for (int k = 0; k < 8; ++k) __builtin_nontemporal_store(v[k], o4 + c.tid + k * NTHREADS);
            return;
        }
        for (int i = c.tid; i < 4096; i += NTHREADS) { const size_t e = (size_t)r * 16384 + 4 * i; const int b = (int)(e / (WB * 256)), rr = (int)((e / 256) % WB), col = (int)(e % 256);
            f32x4 val;
            if (rr < WB - DECT) val = *(const f32x4*)(src + ((size_t)b * WB + rr + DECT) * 256 + col);
            else { const u32x2 u = *(const u32x2*)(Z + ((size_t)NPR + b * DECT + (rr - (WB - DECT))) * NZ + zc + col); val = (f32x4){bflo(u.x), bfhi(u.x), bflo(u.y), bfhi(u.y)}; }
            *(f32x4*)(o + 4 * i) = val; }
    }
}
constexpr int N_BIG = 2 * DECB * 8;
DEVI void big_copy_item(const Ctx& c, int layer, int it) {
    const int kv = it >> 8, b = (it >> 3) & 31, j = it & 7, n16 = (j == 7) ? 3 : 4;
    const size_t off = ((size_t)(layer * DECB + b) * WB) * 256 + (size_t)j * 4 * 16384;
    const f32x4* s4 = (const f32x4*)(c.in[kv ? I_CV : I_CK] + off + DECT * 256); f32x4* o4 = (f32x4*)(c.out + (kv ? O_VWS : O_KWS) + off);
    f32x4 v[32];
#pragma unroll
    for (int k = 0; k < 32; ++k) if (k < 8 * n16) v[k] = __builtin_nontemporal_load(s4 + c.tid + k * NTHREADS);
#pragma unroll
    for (int k = 0; k < 32; ++k) if (k < 8 * n16) __builtin_nontemporal_store(v[k], o4 + c.tid + k * NTHREADS);
}
DEVI void scan_item(const Ctx& c, int layer, int it);
constexpr int IT_SCAN = 4000;
DEVI void phase_mix_local(const Ctx& c0, int layer0, int qslot) {
    unsigned* seqctr = (unsigned*)(c0.ws + WS_CTL) + CW_QUEUE + 64 * (48 + 16 * layer0) + 64 * 32 * qslot;
    unsigned* tmo = (unsigned*)(c0.ws + WS_CTL) + 128;
    WorkQueue q; q.start(c0, (unsigned*)(c0.ws + WS_CTL) + CW_QUEUE + 64 * (2 * layer0) + 64 * 8 * qslot);
    for (;;) {
        const int pos = q.pop(c0);
        if (pos >= 64 + 102 * 20 + 232) break;
        int it; bool big = false;
        if (pos < 64) it = 1440 + pos;
        else if (pos >= 64 + 102 * 20) { const int t = pos - (64 + 102 * 20);
            if (t < 208) { if (t & 1) { big = true; it = 408 + (t >> 1); } else it = IT_SCAN + (t >> 1); }
            else it = IT_SCAN + 104 + (t - 208); }
        else { const int p = pos - 64, g = p / 20, m = p % 20;
            if (m % 5 == 4) { big = true; it = g * 4 + m / 5; }
            else { const int nb = g * 16 + m - m / 5;
                if (nb < 416) it = nb;
                else { const int p2 = nb - 416, g2 = p2 / 19, m2 = p2 % 19; it = (m2 < 16) ? 416 + g2 * 16 + m2 : 1504 + g2 * 3 + (m2 - 16); } } }
        const Ctx c = relaunder(c0); int layer = layer0; asm volatile("" : "+s"(layer));
        float* MU = (float*)(c.ws + WS_MU); float* HU = (float*)(c.ws + WS_HU);
        if (big || it >= 256) q.prefetch(c);
        if (big) big_copy_item(c, layer, it);
        else if (it < 256) { const int itu = __builtin_amdgcn_readfirstlane(it); const int blk = itu & 31, hh = (itu >> 5) & 3, b = itu >> 7; for (int rp = 0; rp < REP_ATT; ++rp) attn_block_item(c, layer, b, hh, blk, q); }
        else if (it < 384) { for (int rp = 0; rp < REP_GMLP; ++rp) gmlp_chunk_item(c, layer, (size_t)(it - 256) * 128); }
        else if (it < 416) { const int b = it - 384; gmlp_item(c, layer, (size_t)NPR + b * DECT, DECT, c.out + O_CVS + ((size_t)layer * DECB + b) * DECT * 256); }
        else if (it < 928) { const int i2 = it - 416, b = i2 >> 8, hh = (i2 >> 6) & 3, ch = i2 & 63;
            for (int rp = 0; rp < REP_STATE; ++rp) mlstm_chunk_state(c, layer, hh, (size_t)b * TSEQ + ch * 128, MU + (size_t)i2 * 4096, (float*)((char*)MU + REC_N_OFF) + i2 * 64, (float*)((char*)MU + REC_M_OFF) + i2, (float*)((char*)MU + REC_B_OFF) + i2);
            handoff_publish(c, seqctr + 64 * (i2 >> 6)); }
        else if (it < 1440) { const int i2 = it - 928, b = i2 >> 8, hh = (i2 >> 6) & 3, ch = i2 & 63;
            for (int rp = 0; rp < REP_STATE; ++rp) hgrn_chunk_state(c, layer, hh, (size_t)b * TSEQ + ch * 128, HU + (size_t)i2 * 4096, (float*)((char*)HU + REC_N_OFF) + i2 * 64);
            handoff_publish(c, seqctr + 64 * (8 + (i2 >> 6))); }
        else if (it < 1504) { const int qh = __builtin_amdgcn_readfirstlane((it - 1440) * 8 + c.wave); const int t = qh & 3, hh = (qh >> 2) & 3, b = qh >> 4; for (int rp = 0; rp < REP_SATT; ++rp) attn_sample_qh(c, layer, b, hh, t); }
        else if (it >= IT_SCAN) { const int si = __builtin_amdgcn_readfirstlane(it - IT_SCAN); handoff_wait(c, seqctr + 64 * (si >> 3), 64u * REP_STATE, tmo); scan_item(c, layer, si); }
        else if (it < 1632) copy_item(c, layer, it - 1504);
        else { const int s = it - 1632; copy_item(c, layer, 128 + (s >> 5) * 1024 + (s & 31) * 32 + 31); }
    }
}

DEVI void scan_item(const Ctx& c, int layer, int it) {
    float* MU = (float*)(c.ws + WS_MU); float* MCS = (float*)(c.ws + WS_MCS); float* HU = (float*)(c.ws + WS_HU); float* HSS = (float*)(c.ws + WS_HSS);
    const int tid = c.tid; constexpr int GRP = 16;
    {
        const int seq = it >> 3, e = (it & 7) * 512 + tid;
        if (seq < 8) {
            const float* un = (const float*)((const char*)MU + REC_N_OFF); const float* um = (const float*)((const char*)MU + REC_M_OFF); const float* ub = (const float*)((const char*)MU + REC_B_OFF);
            float* csn = (float*)((char*)MCS + REC_N_OFF); float* csm = (float*)((char*)MCS + REC_M_OFF);
            const bool lead = (it & 7) == 0; const bool do_n = lead && tid < 64;
            float C = 0.f, nn = 0.f, m = 0.f;
#pragma unroll 1
            for (int ch0 = 0; ch0 < NCHUNK; ch0 += GRP) {
                const float* up = MU + (size_t)(seq * NCHUNK + ch0) * 4096 + e; float* cp = MCS + (size_t)(seq * NCHUNK + ch0) * 4096 + e; const int item0 = seq * NCHUNK + ch0;
                float u[GRP], nu[GRP], Bv[GRP], mlv[GRP];
#pragma unroll
                for (int q = 0; q < GRP; ++q) { u[q] = up[(size_t)q * 4096]; Bv[q] = ub[item0 + q]; mlv[q] = um[item0 + q]; nu[q] = do_n ? un[(item0 + q) * 64 + tid] : 0.f; }
#pragma unroll
                for (int q = 0; q < GRP; ++q) {
                    cp[(size_t)q * 4096] = C; if (do_n) csn[(item0 + q) * 64 + tid] = nn; if (lead && tid == 0) csm[item0 + q] = m;
                    const float mn = fmaxf(Bv[q] + m, mlv[q]); const float a = __expf(Bv[q] + m - mn), bb = __expf(mlv[q] - mn);
                    C = a * C + bb * u[q]; nn = a * nn + bb * nu[q]; m = mn; }
            }
            c.out[O_CP + ((size_t)layer * 8 + seq) * 4096 + e] = C;
            if (lead && tid == 0) c.out[O_MP + layer * 8 + seq] = m;
            if (do_n) c.out[O_NP + ((size_t)layer * 8 + seq) * 64 + tid] = nn;
        } else {
            const int bh = seq - 8, d = e & 63, v = e >> 6; const float* dec = (const float*)((const char*)HU + REC_N_OFF);
            float S = 0.f;
#pragma unroll 1
            for (int ch0 = 0; ch0 < NCHUNK; ch0 += GRP) {
                const float* up = HU + (size_t)(bh * NCHUNK + ch0) * 4096 + e; float* sp = HSS + (size_t)(bh * NCHUNK + ch0) * 4096 + e; const float* dp = dec + (bh * NCHUNK + ch0) * 64 + d;
                float u[GRP], dd[GRP];
#pragma unroll
                for (int q = 0; q < GRP; ++q) { u[q] = up[(size_t)q * 4096]; dd[q] = dp[q * 64]; }
#pragma unroll
                for (int q = 0; q < GRP; ++q) { sp[(size_t)q * 4096] = S; S = dd[q] * S + u[q]; }
            }
            c.out[O_SP + ((size_t)layer * 8 + bh) * 4096 + d * 64 + v] = S;
        }
    }
}

DEVI void phase_mix_out(const Ctx& c0, int layer0, int qslot) {
    WorkQueue q; q.start(c0, (unsigned*)(c0.ws + WS_CTL) + CW_QUEUE + 64 * (2 * layer0 + 1) + 64 * 8 * qslot);
    for (;;) {
        const int it = q.pop(c0);
        if (it >= 1280) break;
        const Ctx c = relaunder(c0); int layer = layer0; asm volatile("" : "+s"(layer));
        float* MCS = (float*)(c.ws + WS_MCS); float* HSS = (float*)(c.ws + WS_HSS);
        q.prefetch(c);
        if (it < 512) { const int b = it >> 8, hh = (it >> 6) & 3, ch = it & 63; RecIO io{}; io.st_in = MCS + (size_t)it * 4096; io.n_in = (const float*)((const char*)MCS + REC_N_OFF) + it * 64; io.m_in = (const float*)((const char*)MCS + REC_M_OFF) + it;
            for (int rp = 0; rp < REP_OUT; ++rp) mlstm_chunk_out(c, layer, hh, (size_t)b * TSEQ + ch * 128, io.st_in, io.n_in, io.m_in); }
        else if (it < 1024) { const int i2 = it - 512, b = i2 >> 8, hh = (i2 >> 6) & 3, ch = i2 & 63; RecIO io{}; io.st_in = HSS + (size_t)i2 * 4096; io.native_in = true;
            for (int rp = 0; rp < REP_OUT; ++rp) hgrn_chunk_out(c, layer, hh, (size_t)b * TSEQ + ch * 128, io.st_in); }
        else if (it < 1152) { const int i2 = it - 1024, b = i2 >> 2, hh = i2 & 3; const size_t sidx = (size_t)(layer * DECB + b) * NH + hh; RecIO io{};
            io.st_in = c.in[I_MC] + sidx * 4096; io.n_in = c.in[I_MN] + sidx * 64; io.m_in = c.in[I_MM] + sidx;
            io.st_out = c.out + O_CS + sidx * 4096; io.n_out = c.out + O_NS + sidx * 64; io.m_out = c.out + O_MS + sidx;
            for (int rp = 0; rp < REP_SREC; ++rp) mlstm_item<true>(c, layer, hh, (size_t)NPR + b * DECT, DECT, io, 0.f); }
        else { const int i2 = it - 1152, b = i2 >> 2, hh = i2 & 3; const size_t sidx = (size_t)(layer * DECB + b) * NH + hh; RecIO io{};
            io.st_in = c.in[I_HS] + sidx * 4096; io.st_out = c.out + O_SS + sidx * 4096;
            for (int rp = 0; rp < REP_SREC; ++rp) hgrn_item<true>(c, layer, hh, (size_t)NPR + b * DECT, DECT, io); }
    }
}

DEVI void phase_final(const Ctx& c) {
    const int gw = c.bid * 8 + c.wave, NGW = c.G * 8; const bf16_t* x = c.X2(); const float* g = c.in[I_GFIN];
    f32x4 gv[4];
#pragma unroll
    for (int j = 0; j < 4; ++j) gv[j] = *(const f32x4*)(g + 256 * j + 4 * c.lane);
    for (int row0 = gw; row0 < NTOK; row0 += 3 * NGW) {
        u32x2 xb[3][4]; float rs[3];
#pragma unroll
        for (int r = 0; r < 3; ++r) { const int row = row0 + r * NGW < NTOK ? row0 + r * NGW : row0; const bf16_t* xr = x + (size_t)row * DM;
#pragma unroll
            for (int j = 0; j < 4; ++j) xb[r][j] = *(const u32x2*)(xr + 256 * j + 4 * c.lane);
            rs[r] = row_rs(c.SSQ(), row); }
        __builtin_amdgcn_sched_barrier(0);
#pragma unroll
        for (int r = 0; r < 3; ++r) { const int row = row0 + r * NGW; if (row < NTOK) {
            float* o = c.out + ((row < NPR) ? O_YP + (size_t)row * DM : O_YS + (size_t)(row - NPR) * DM);
#pragma unroll
            for (int j = 0; j < 4; ++j) { const f32x4 v = (f32x4){bflo(xb[r][j].x), bfhi(xb[r][j].x), bflo(xb[r][j].y), bfhi(xb[r][j].y)}; __builtin_nontemporal_store(v * rs[r] * gv[j], (f32x4*)(o + 256 * j + 4 * c.lane)); } } }
    }
}

#define XB_TMO      128
#define XB_XCNT(j)  (256  + 64 * (j))
#define XB_XSUB(j)  (1280 + 64 * (j))
#define XB_XGEN(j)  (2304 + 64 * (j))
#define XB_TOP      3328
#define XB_TOPGEN   3392
#define XCD_BAR_WORDS 3456
#define XB_SPIN_CAP (1u << 18)

__device__ __forceinline__ unsigned xb_ld(unsigned* p)              { return __hip_atomic_load(p, __ATOMIC_RELAXED, __HIP_MEMORY_SCOPE_AGENT); }
__device__ __forceinline__ unsigned xb_add(unsigned* p, unsigned v) { return __hip_atomic_fetch_add(p, v, __ATOMIC_RELAXED, __HIP_MEMORY_SCOPE_AGENT); }
__device__ __forceinline__ unsigned xb_xcc_id() { return (unsigned)__builtin_amdgcn_s_getreg((3 << 11) | 20) & 0xFu; }
#define XB_SPIN(cond, bar) do { unsigned _sp = 0; while (cond) { __builtin_amdgcn_s_sleep(1); \
    if ((++_sp & 255u) == 0u) { if (xb_ld(&(bar)[XB_TMO])) break; if (_sp > XB_SPIN_CAP) { atomicAdd(&(bar)[XB_TMO], 1u); break; } } } } while (0)

struct XcdBarrier {
    unsigned* bar; unsigned x;
    volatile LAS unsigned* st;
};

__device__ __forceinline__ XcdBarrier xcd_barrier_post(unsigned* bar, volatile LAS unsigned* st, bool leader) {
    XcdBarrier b; b.bar = bar; b.x = xb_xcc_id(); b.st = st;
    if (leader) (void)xb_add(&bar[XB_XCNT(b.x)], 1u);
    return b;
}
__device__ __forceinline__ void xcd_barrier_complete(unsigned* bar, unsigned x, unsigned& nloc, unsigned& nx) {
    const unsigned G = gridDim.x * gridDim.y * gridDim.z;
    unsigned sum, cnt, mine, sp = 0u;
    for (;;) {
        sum = 0u; cnt = 0u; mine = 0u;
#pragma unroll
        for (unsigned j = 0; j < 16; ++j) { const unsigned c = xb_ld(&bar[XB_XCNT(j)]); sum += c; cnt += (c > 0u) ? 1u : 0u; mine = (j == x) ? c : mine; }
        if (sum == G) break;
        __builtin_amdgcn_s_sleep(1);
        if ((++sp & 255u) == 0u) { if (xb_ld(&bar[XB_TMO])) break; if (sp > XB_SPIN_CAP) { atomicAdd(&bar[XB_TMO], 1u); break; } }
    }
    nloc = mine > 0u ? mine : 1u; nx = cnt > 0u ? cnt : 1u;
}

__device__ __forceinline__ void xcd_barrier(const XcdBarrier& b, bool leader) {
    asm volatile("s_waitcnt vmcnt(0)" ::: "memory");
    __syncthreads();
    if (leader) {
        unsigned* bar = b.bar;
        __builtin_amdgcn_s_waitcnt(0);
        unsigned nloc = b.st[0], nx = b.st[1];
        if (nloc == 0u) { xcd_barrier_complete(bar, b.x, nloc, nx); b.st[0] = nloc; b.st[1] = nx; }
        const unsigned old = xb_add(&bar[XB_XSUB(b.x)], 1u);
        const unsigned gen = old / nloc;
        if (old + 1u == (gen + 1u) * nloc) {
            __builtin_amdgcn_fence(__ATOMIC_RELEASE, "agent");
            asm volatile("s_waitcnt vmcnt(0)" ::: "memory");
            const unsigned og = xb_add(&bar[XB_TOP], 1u);
            const unsigned tg = og / nx;
            if (og + 1u == (tg + 1u) * nx) xb_add(&bar[XB_TOPGEN], 1u);
            else XB_SPIN(xb_ld(&bar[XB_TOPGEN]) == tg, bar);
            __builtin_amdgcn_fence(__ATOMIC_ACQUIRE, "agent");
            xb_add(&bar[XB_XGEN(b.x)], 1u);
            asm volatile("s_waitcnt vmcnt(0)" ::: "memory");
        } else {
            XB_SPIN(xb_ld(&bar[XB_XGEN(b.x)]) == gen, bar);
            __builtin_amdgcn_fence(__ATOMIC_ACQUIRE, "agent");
            asm volatile("s_waitcnt vmcnt(0)" ::: "memory");
        }
    }
    __syncthreads();
}

constexpr int PH_PER_LAYER = 9;
DEVI Ctx make_ctx(const Params& p, unsigned char* lds_raw, int wave0) {
    int tid_ = wave0 * 64 + lane_opaque(); asm volatile("" : "+v"(tid_));
    const __attribute__((address_space(4))) Params* kp = (const __attribute__((address_space(4))) Params*)__builtin_amdgcn_kernarg_segment_ptr(); asm volatile("" : "+s"(kp));
    const __attribute__((address_space(4))) ParamsDev* kd = (const __attribute__((address_space(4))) ParamsDev*)kp; Ctx c; c.in.p = kd->in; c.out = (float*)kd->out; c.ws = (unsigned char*)kd->ws; c.lds = (LAS unsigned char*)lds_raw; c.tid = tid_; c.lane = c.tid & 63; c.wave = __builtin_amdgcn_readfirstlane(c.tid >> 6); c.G = gridDim.x; c.bid = blockIdx.x;
    return c;
}
template <int SUB> DEVI void run_sub(const Ctx& c, const Params& p, int layer, int qslot = 0) {
    const bf16_t* xin_p = c.X2(); const bf16_t* xin_s = c.X2() + (size_t)NPR * DM;
    if constexpr (SUB == 1) { pg8::Gemm g{c.X2(), (const bf16_t*)(c.ws + WS_WIN) + (size_t)layer * NZ * DM, MPAD, NZ, DM}; pg8::StaticOrder S; S.init(MPAD, NZ, c.G, c.bid);
        EpiRowScaleBf16<0> E{c.Z(), NZ, c.SSQ(), c.lds + EPI_STG}; pg8::gemm_phase<EpiRowScaleBf16<0>, pg8::StaticOrder, true, true>(c.lds, g, S, E, c.tid);
        {
            const int nwg = (MPAD / 256) * (NZ / 256), full = nwg % c.G;
            const int i0 = layer == 0 ? CONV_ITEMS_WIN : CONV_ITEMS_PER_LAYER + CONV_ITEMS_WIN, i1 = layer == 0 ? CONV_ITEMS_PER_LAYER + CONV_ITEMS_WIN : 2 * CONV_ITEMS_PER_LAYER;
            if (full != 0 && c.bid >= full) convert_weights(c, i0, i1, (c.bid - full) * 8 + c.wave, (c.G - full) * 8);
            else if (full == 0) convert_weights(c, i0, i1, c.bid * 8 + c.wave, c.G * 8); } }
    else if constexpr (SUB == 2) phase_mix_local(c, layer, qslot);
    else if constexpr (SUB == 4) phase_mix_out(c, layer, qslot);
    else if constexpr (SUB == 5) { const bf16_t* wt = (const bf16_t*)(c.ws + WS_WOUT) + (size_t)layer * DM * DM;
        { SkEpiResidualNorm se{xin_s, c.X1() + (size_t)NPR * DM, c.SSQ() + (size_t)NPR * 16}; skinny_gemm(c, c.MIX() + (size_t)NPR * DM, wt, DM, DM, se); }
        pg8::Gemm g{c.MIX(), wt, NPR, DM, DM}; pg8::StaticOrder S; S.init(NPR, DM, c.G, c.bid);
        EpiResidualNorm E{xin_p, c.X1(), c.SSQ(), c.lds + EPI_STG}; pg8::gemm_phase<EpiResidualNorm, pg8::StaticOrder, true, true>(c.lds, g, S, E, c.tid); }
    else if constexpr (SUB == 7) { const bf16_t* wt = (const bf16_t*)(c.ws + WS_WUP) + (size_t)layer * FF * DM;
        { SkEpiRelu2 se{c.Hb() + (size_t)NPR * FF, c.SSQ() + (size_t)NPR * 16}; skinny_gemm(c, c.X1() + (size_t)NPR * DM, wt, FF, DM, se); }
        pg8::Gemm g{c.X1(), wt, NPR, FF, DM}; pg8::StaticOrder S; S.init(NPR, FF, c.G, c.bid);
        EpiRowScaleBf16<1> E{c.Hb(), FF, c.SSQ(), c.lds + EPI_STG}; pg8::gemm_phase<EpiRowScaleBf16<1>, pg8::StaticOrder, true, true>(c.lds, g, S, E, c.tid); }
    else if constexpr (SUB == 8) { const bf16_t* wt = (const bf16_t*)(c.ws + WS_WDN) + (size_t)layer * DM * FF;
        { SkEpiResidualNorm se{c.X1() + (size_t)NPR * DM, c.X2() + (size_t)NPR * DM, c.SSQ() + (size_t)NPR * 16}; skinny_gemm(c, c.Hb() + (size_t)NPR * FF, wt, DM, FF, se); }
        pg8::Gemm g{c.Hb(), wt, NPR, DM, FF}; pg8::StaticOrder S; S.init(NPR, DM, c.G, c.bid);
        EpiResidualNorm E{c.X1(), c.X2(), c.SSQ(), c.lds + EPI_STG}; pg8::gemm_phase<EpiResidualNorm, pg8::StaticOrder, true, true>(c.lds, g, S, E, c.tid); }
    else if constexpr (SUB == 9) phase_prologue(c);
    else phase_final(c);
}
template <int SUB> __global__ void __launch_bounds__(NTHREADS, 2) k_sub(Params p, int layer) {
    extern __shared__ __attribute__((aligned(16))) unsigned char lds_raw[];
    const Ctx c = make_ctx(p, lds_raw, __builtin_amdgcn_readfirstlane((int)threadIdx.x >> 6));
    run_sub<SUB>(c, p, layer);
}
template <int SUB> static void launch_sub(const Params& p, int layer, int grid, hipStream_t stream) {
    static bool attr_set = false;
    if (!attr_set) { (void)hipFuncSetAttribute((const void*)k_sub<SUB>, hipFuncAttributeMaxDynamicSharedMemorySize, LDS_BYTES); attr_set = true; }
    hipLaunchKernelGGL(k_sub<SUB>, dim3(grid), dim3(NTHREADS), LDS_BYTES, stream, p, layer);
}

#ifndef REP_A
#define REP_A 1
#endif
#ifndef REP_B
#define REP_B 1
#endif
#ifndef REP_C
#define REP_C 1
#endif
#ifndef REP_D
#define REP_D 1
#endif
#ifndef REP_G1
#define REP_G1 1
#endif
#ifndef REP_G2
#define REP_G2 1
#endif
#ifndef REP_G3
#define REP_G3 1
#endif
#ifndef REP_G4
#define REP_G4 1
#endif
#ifndef REP_ML
#define REP_ML 1
#endif
#ifndef REP_MO
#define REP_MO 1
#endif
#ifndef REP_BAR
#define REP_BAR 1
#endif
#define GRID_BAR() do { for (int rb_ = 0; rb_ < REP_BAR; ++rb_) { XcdBarrier b_; b_.bar = (unsigned*)(c.ws + WS_CTL); b_.x = xb_xcc_id(); b_.st = (volatile LAS unsigned*)(c.lds + LDS_BYTES - 64); xcd_barrier(b_, wave0 == 0 && lane_opaque() == 0); c = make_ctx(p, lds_raw, wave0); } } while (0)
__global__ void __launch_bounds__(NTHREADS, 2) mk_fwd(Params p) {
    extern __shared__ __attribute__((aligned(16))) unsigned char lds_raw[];
    const int wave0 = __builtin_amdgcn_readfirstlane((int)threadIdx.x >> 6);
    Ctx c = make_ctx(p, lds_raw, wave0);
    volatile LAS unsigned* st = (volatile LAS unsigned*)(c.lds + LDS_BYTES - 64);
    if (c.tid < 16) st[c.tid] = 0u;
    __syncthreads();
    (void)xcd_barrier_post((unsigned*)(c.ws + WS_CTL), st, c.tid == 0);
    c = make_ctx(p, lds_raw, wave0);
    if (p.ph_lo < 0) cg::this_grid().sync();
    for (int rep = 0; rep < REP_D; ++rep) run_sub<9>(c, p, 0);
    GRID_BAR();
#pragma unroll 1
    for (int layer = 0; layer < NLAYER; ++layer) {
        for (int rep = 0; rep < REP_A * REP_G1; ++rep) run_sub<1>(c, p, layer);
        GRID_BAR();
        for (int rep = 0; rep < REP_ML; ++rep) run_sub<2>(c, p, layer, rep);
        GRID_BAR();
        for (int rep = 0; rep < REP_MO; ++rep) run_sub<4>(c, p, layer, rep);
        GRID_BAR();
        for (int rep = 0; rep < REP_A * REP_G2; ++rep) run_sub<5>(c, p, layer);
        GRID_BAR();
        for (int rep = 0; rep < REP_A * REP_G3; ++rep) run_sub<7>(c, p, layer);
        GRID_BAR();
        for (int rep = 0; rep < REP_A * REP_G4; ++rep) run_sub<8>(c, p, layer);
        GRID_BAR();
    }
    for (int rep = 0; rep < REP_D; ++rep) run_sub<10>(c, p, 0);
}

extern "C" void kernel_launch(void* const* d_in, const int* in_sizes, int n_in, void* d_out, int out_size, void* d_ws, size_t ws_size, hipStream_t stream) {
    static int grid = 0;
    if (grid == 0) {
        if (n_in != N_IN || (size_t)out_size != O_END || ws_size < WS_END) { fprintf(stderr, "kernel_launch: unexpected shapes: n_in %d out %d (want %zu) ws %zu (want %zu)\n", n_in, out_size, (size_t)O_END, ws_size, (size_t)WS_END); grid = -1; return; }
        int dev = 0, cus = 0, per_cu = 0;
        (void)hipGetDevice(&dev); (void)hipDeviceGetAttribute(&cus, hipDeviceAttributeMultiprocessorCount, dev);
        if (hipFuncSetAttribute((const void*)mk_fwd, hipFuncAttributeMaxDynamicSharedMemorySize, LDS_BYTES) != hipSuccess) { fprintf(stderr, "kernel_launch: hipFuncSetAttribute failed\n"); grid = -1; return; }
        if (hipOccupancyMaxActiveBlocksPerMultiprocessor(&per_cu, (const void*)mk_fwd, NTHREADS, LDS_BYTES) != hipSuccess || per_cu < 1) { fprintf(stderr, "kernel_launch: occupancy query says %d blocks per CU\n", per_cu); (void)hipGetLastError(); grid = -1; return; }
        grid = (cus > 0 ? cus : 256);
    }
    if (grid < 0) return;
    (void)hipMemsetAsync((char*)d_ws + WS_CTL, 0, CTL_ZERO_BYTES, stream);
    Params p{};
    for (int i = 0; i < N_IN; ++i) p.in[i] = (const float*)d_in[i];
    p.out = (float*)d_out; p.ws = (unsigned char*)d_ws;
    void* args[] = {&p};
    const hipError_t e = hipLaunchCooperativeKernel((const void*)mk_fwd, dim3(grid), dim3(NTHREADS), args, LDS_BYTES, stream);
    if (e != hipSuccess) fprintf(stderr, "kernel_launch: cooperative launch failed: %s (grid %d)\n", hipGetErrorString(e), grid);
}
```
